# Optimizing an MI355X kernel written in HIP

```python
import math
import jax, jax.numpy as jnp
from jax import lax
import numpy as np

D_MODEL = 1024
BATCH = 2
SEQ = 8192
DEPTH = 1

N_META = 16
BLOCK = 128
WINDOW = 128
HEAD_DIM = 64
A_Q_HEADS = 8
A_KV_HEADS = 2
A_WIDTH = A_Q_HEADS * HEAD_DIM
B_HEADS = 4
B_V_DIM = 2 * HEAD_DIM
B_WIDTH = B_HEADS * B_V_DIM
RMS_EPS = 1e-6
NEG = -1e30

IN_SIZES = [
    A_Q_HEADS * HEAD_DIM,
    A_KV_HEADS * HEAD_DIM,
    A_KV_HEADS * HEAD_DIM,
    A_WIDTH,
    B_HEADS * 2 * HEAD_DIM,
    B_HEADS * 2 * HEAD_DIM,
    B_WIDTH,
    B_WIDTH,
    2 * D_MODEL,
]
IN_DIM = sum(IN_SIZES)
IN_SPLITS = [int(c) for c in np.cumsum(IN_SIZES)[:-1]]

kernel_name = "hybrid_gated_swa_sink_diffattn_alibi"


def rms_norm(x, g):
    xf = x.astype(jnp.float32)
    y = xf * lax.rsqrt(jnp.mean(xf * xf, axis=-1, keepdims=True) + RMS_EPS)
    return (y * g.astype(jnp.float32)).astype(x.dtype)


def alibi_slopes(n_heads):
    return jnp.exp2(-8.0 * jnp.arange(1, n_heads + 1, dtype=jnp.float32) / n_heads)


def sliding_window_gqa(q, k, v, qn, kn, sink, pos):
    b, lp = q.shape[:2]
    nb = lp // BLOCK
    grp = A_Q_HEADS // A_KV_HEADS
    scale = HEAD_DIM ** -0.5
    q = rms_norm(q, qn)
    k = rms_norm(k, kn)
    qb = q.reshape(b, nb, BLOCK, A_KV_HEADS, grp, HEAD_DIM)
    kb = k.reshape(b, nb, BLOCK, A_KV_HEADS, HEAD_DIM)
    vb = v.reshape(b, nb, BLOCK, A_KV_HEADS, HEAD_DIM)

    def with_prev(t):
        prev = jnp.pad(t, ((0, 0), (1, 0), (0, 0), (0, 0), (0, 0)))[:, :-1]
        return jnp.concatenate([prev, t], axis=2)

    kk, vv = with_prev(kb), with_prev(vb)
    qpos = pos.reshape(nb, BLOCK)
    kpos = jnp.concatenate([qpos - BLOCK, qpos], axis=1)
    dist = qpos[:, :, None] - kpos[:, None, :]
    valid = (dist >= 0) & (dist < WINDOW) & (kpos[:, None, :] >= 0)
    slopes = alibi_slopes(A_Q_HEADS).reshape(1, 1, A_KV_HEADS, grp, 1, 1)

    s = jnp.einsum('bnqkgd,bnskd->bnkgqs', qb, kk).astype(jnp.float32) * scale
    s = s - slopes * dist.astype(jnp.float32)[None, :, None, None]
    s = jnp.where(valid[None, :, None, None], s, NEG)
    snk = sink.astype(jnp.float32).reshape(1, 1, A_KV_HEADS, grp, 1, 1)
    m = jnp.maximum(jnp.max(s, axis=-1, keepdims=True), snk)
    p = jnp.exp(s - m)
    probs = p / (jnp.sum(p, axis=-1, keepdims=True) + jnp.exp(snk - m))
    o = jnp.einsum('bnkgqs,bnskd->bnqkgd', probs.astype(v.dtype), vv)
    return o.reshape(b, lp, A_WIDTH)


def diff_attention(q, k, v, qn, kn, lam, subln, lam_init, pos):
    b, lp = q.shape[:2]
    nb = lp // BLOCK
    scale = HEAD_DIM ** -0.5
    q = rms_norm(q, qn)
    k = rms_norm(k, kn)
    slopes = alibi_slopes(B_HEADS)[None, :, None, None, None]
    qblocks = jnp.moveaxis(q.reshape(b, nb, BLOCK, B_HEADS, 2, HEAD_DIM), 1, 0)
    qpos = pos.reshape(nb, BLOCK)

    def one_block(args):
        qb, qp = args
        s = jnp.einsum('bqhmd,bshmd->bhmqs', qb, k).astype(jnp.float32) * scale
        dist = qp[:, None] - pos[None, :]
        valid = (dist >= 0) & (pos[None, :] >= 0)
        s = jnp.where(valid, s - slopes * dist.astype(jnp.float32), NEG)
        a = jax.nn.softmax(s, axis=-1)
        w = a[:, :, 0] - lam * a[:, :, 1]
        return jnp.einsum('bhqs,bshd->bqhd', w.astype(v.dtype), v)

    o = lax.map(one_block, (qblocks, qpos))
    o = jnp.moveaxis(o, 0, 1).reshape(b, lp, B_HEADS, B_V_DIM)
    o = rms_norm(o, subln) * (1.0 - lam_init)
    return o.reshape(b, lp, B_WIDTH)


def setup_inputs(seed: int = 0) -> dict:
    key = jax.random.key(seed)
    ks = jax.random.split(key, 17)
    f32 = jnp.float32
    nrm = lambda k, shape, s: jax.random.normal(k, shape, f32) * s
    return {
        "x": nrm(ks[0], (BATCH, SEQ, D_MODEL), 1.0),
        "meta": nrm(ks[1], (N_META, D_MODEL), 1.0),
        "norm_g": 1.0 + nrm(ks[2], (DEPTH, D_MODEL), 0.05),
        "w_in": nrm(ks[3], (DEPTH, D_MODEL, IN_DIM), D_MODEL ** -0.5),
        "a_qn": 1.0 + nrm(ks[4], (DEPTH, HEAD_DIM), 0.05),
        "a_kn": 1.0 + nrm(ks[5], (DEPTH, HEAD_DIM), 0.05),
        "a_sink": nrm(ks[6], (DEPTH, A_Q_HEADS), 1.0),
        "b_qn": 1.0 + nrm(ks[7], (DEPTH, HEAD_DIM), 0.05),
        "b_kn": 1.0 + nrm(ks[8], (DEPTH, HEAD_DIM), 0.05),
        "b_lq1": nrm(ks[9], (DEPTH, HEAD_DIM), 0.1),
        "b_lk1": nrm(ks[10], (DEPTH, HEAD_DIM), 0.1),
        "b_lq2": nrm(ks[11], (DEPTH, HEAD_DIM), 0.1),
        "b_lk2": nrm(ks[12], (DEPTH, HEAD_DIM), 0.1),
        "b_subln": 1.0 + nrm(ks[13], (DEPTH, B_V_DIM), 0.05),
        "w_up_a": nrm(ks[14], (DEPTH, A_WIDTH, D_MODEL), A_WIDTH ** -0.5),
        "w_up_b": nrm(ks[15], (DEPTH, B_WIDTH, D_MODEL), B_WIDTH ** -0.5),
        "w_o": nrm(ks[16], (DEPTH, D_MODEL, D_MODEL), D_MODEL ** -0.5),
    }


def reference(x, meta, norm_g, w_in, a_qn, a_kn, a_sink, b_qn, b_kn, b_lq1, b_lk1, b_lq2, b_lk2,
              b_subln, w_up_a, w_up_b, w_o):
    b = x.shape[0]
    n_pad = BLOCK - N_META
    h = jnp.concatenate([
        jnp.zeros((b, n_pad, D_MODEL), x.dtype),
        jnp.broadcast_to(meta.astype(x.dtype)[None], (b, N_META, D_MODEL)),
        x,
    ], axis=1)
    lp = h.shape[1]
    pos = jnp.arange(lp, dtype=jnp.int32) - n_pad

    for l in range(DEPTH):
        lam_init = 0.8 - 0.6 * math.exp(-0.3 * l)
        u = rms_norm(h, norm_g[l])
        proj = u @ w_in[l]
        qa, ka, va, za, qb, kb, vb, zb, gl = jnp.split(proj, IN_SPLITS, axis=-1)

        ya = sliding_window_gqa(
            qa.reshape(b, lp, A_Q_HEADS, HEAD_DIM),
            ka.reshape(b, lp, A_KV_HEADS, HEAD_DIM),
            va.reshape(b, lp, A_KV_HEADS, HEAD_DIM),
            a_qn[l], a_kn[l], a_sink[l], pos)
        ya = ya * jax.nn.silu(za)

        lam = (jnp.exp(jnp.sum(b_lq1[l].astype(jnp.float32) * b_lk1[l].astype(jnp.float32)))
               - jnp.exp(jnp.sum(b_lq2[l].astype(jnp.float32) * b_lk2[l].astype(jnp.float32)))
               + lam_init)
        yb = diff_attention(
            qb.reshape(b, lp, B_HEADS, 2, HEAD_DIM),
            kb.reshape(b, lp, B_HEADS, 2, HEAD_DIM),
            vb.reshape(b, lp, B_HEADS, B_V_DIM),
            b_qn[l], b_kn[l], lam, b_subln[l], lam_init, pos)
        yb = yb * jax.nn.silu(zb)

        gates = jax.nn.sigmoid(gl.reshape(b, lp, 2, D_MODEL))
        mix = gates[:, :, 0] * (ya @ w_up_a[l]) + gates[:, :, 1] * (yb @ w_up_b[l])
        h = h + mix @ w_o[l]

    return h[:, BLOCK:]
```

```cpp
#include <hip/hip_cooperative_groups.h>
#include <hip/hip_runtime.h>
#include <cstdio>
#include <cstdint>
namespace pg8 {
#define PG8_LAS __attribute__((address_space(3)))
typedef unsigned short bf16_t;
typedef short bf16x8 __attribute__((ext_vector_type(8)));
typedef float f32x4 __attribute__((ext_vector_type(4)));
typedef unsigned u32x4 __attribute__((ext_vector_type(4)));
constexpr int BM = 256, BK = 64, HALF = 128, HTB = HALF * BK * 2  , STAGE_BYTES = 8 * HTB, NXCD = 8, WGM = 8;

__host__ __device__ __forceinline__ int lds_byte(int r, int c) { const int st = (r >> 4) * 2 + (c >> 5), rr = r & 15, cc = c & 31, ob = rr * 64 + cc * 2; return st * 1024 + (ob ^ (((ob >> 9) & 1) << 5)); }
__host__ __device__ __forceinline__ void stage_rc(int b, int& R, int& C) { const int st = b / 1024, sb = b % 1024, swz = sb ^ (((sb >> 9) & 1) << 5); R = (st >> 1) * 16 + swz / 64; C = (st & 1) * 32 + (swz % 64) / 2; }
__host__ __device__ __forceinline__ int perm32(int rho) { const int n = rho >> 4, i = rho & 15; return 8 * (i >> 2) + 4 * n + (i & 3); }

struct Unit { int pm, pn; };
struct Gemm { const bf16_t* A; const bf16_t* Bt; int M, N, K; };

struct StaticOrder {
    int nM, nN, nwg, G, c;
    __host__ __device__ void init(int M, int N, int G_, int c_) { nM = M / BM; nN = N / BM; nwg = nM * nN; G = G_; c = c_; }
    __host__ __device__ bool next(int i, Unit& u) const {
        const long L = (long)i * G + c; if (L >= nwg) return false;
        int wgid = (int)L; { const int q = nwg / NXCD, r = nwg % NXCD, xcd = wgid % NXCD, off = wgid / NXCD; wgid = (xcd < r ? xcd * (q + 1) : r * (q + 1) + (xcd - r) * q) + off; }
        const int nig = WGM * nN, gid = wgid / nig, fm = gid * WGM, gsz = (nM - fm) < WGM ? (nM - fm) : WGM;
        u.pm = fm + ((wgid % nig) % gsz); u.pn = (wgid % nig) / gsz; return true;
    }
    __device__ __forceinline__ void a_ready(const Unit&) const {}
    __device__ __forceinline__ void done(const Unit&) const {}
};

__device__ __forceinline__ unsigned cvt_pk_bf16(float lo, float hi) { unsigned r; asm volatile("v_cvt_pk_bf16_f32 %0, %1, %2" : "=v"(r) : "v"(lo), "v"(hi)); return r; }
typedef float f32x2 __attribute__((ext_vector_type(2)));
__device__ __forceinline__ f32x2 gelu_pk(f32x2 v) {
    const f32x2 av = __builtin_elementwise_abs(v), d = av * 0.2316418882f + 1.0f;
    f32x2 t; t.x = __builtin_amdgcn_rcpf(d.x); t.y = __builtin_amdgcn_rcpf(d.y);
    f32x2 q = t * 0.5307027145f + (-0.7265760135f); q = q * t + 0.7107068705f; q = q * t + (-0.142248368f); q = q * t + 0.127414796f; q = q * t;
    const f32x2 s = (v * v) * (-0.72134752044f);
    f32x2 e; e.x = __builtin_amdgcn_exp2f(s.x); e.y = __builtin_amdgcn_exp2f(s.y);
    const f32x2 m = v * (q * e), r = v - m;
    f32x2 o; o.x = v.x < 0.f ? m.x : r.x; o.y = v.y < 0.f ? m.y : r.y; return o;
}

template <int ACT  > struct EpiBf16 {
    static constexpr bool PERM = true, AFTER_DRAIN = false; static_assert(ACT == 0 || ACT == 1, "EpiBf16: ACT is 0 (none) or 1 (gelu_pk)");
    bf16_t* O; int ldc; const float* bias; int split_cols; size_t split_stride; float scale0;
    __device__ __forceinline__ void operator()(const f32x4 (&acc)[2][2][4][2], const Unit& u, int wr, int wc, int fr, int fq) const {
        const int row0 = u.pm * BM + wr * 64 + fr; int colt = u.pn * BM; bf16_t* base = O;
        float sc = 1.f; if (split_cols) { const int t = colt / split_cols; base += (size_t)t * split_stride; colt -= t * split_cols; if (t == 0) sc = scale0; }
        const int col0 = colt + wc * 32 + 8 * fq, bcol0 = u.pn * BM + wc * 32 + 8 * fq;
        f32x4 bv[2][2];
#pragma unroll
        for (int bj = 0; bj < 2; ++bj)
#pragma unroll
            for (int n = 0; n < 2; ++n) bv[bj][n] = bias ? *(const f32x4*)(bias + bcol0 + bj * HALF + 4 * n) : (f32x4){0.f, 0.f, 0.f, 0.f};
#pragma unroll
        for (int ai = 0; ai < 2; ++ai)
#pragma unroll
            for (int m = 0; m < 4; ++m) { bf16_t* rowp = base + (size_t)(row0 + ai * HALF + m * 16) * ldc + col0;
#pragma unroll
                for (int bj = 0; bj < 2; ++bj) { f32x4 v0 = acc[ai][bj][m][0] + bv[bj][0], v1 = acc[ai][bj][m][1] + bv[bj][1];
                    if (ACT == 1) { f32x2 a = gelu_pk((f32x2){v0[0], v0[1]}), b = gelu_pk((f32x2){v0[2], v0[3]}), c = gelu_pk((f32x2){v1[0], v1[1]}), d = gelu_pk((f32x2){v1[2], v1[3]});
                        v0 = (f32x4){a.x, a.y, b.x, b.y}; v1 = (f32x4){c.x, c.y, d.x, d.y}; }
                    v0 = v0 * sc; v1 = v1 * sc; u32x4 w; w.x = cvt_pk_bf16(v0[0], v0[1]); w.y = cvt_pk_bf16(v0[2], v0[3]); w.z = cvt_pk_bf16(v1[0], v1[1]); w.w = cvt_pk_bf16(v1[2], v1[3]);
                    *(u32x4*)(rowp + bj * HALF) = w; } }
    }
};

template <class Epi, class Sched, bool ALIGN_EPI = false, bool SP2 = false>
__device__ __forceinline__ void gemm_phase(PG8_LAS unsigned char* lds, const Gemm g, const Sched& S, const Epi& E) {
    const int tid = threadIdx.x, wid = __builtin_amdgcn_readfirstlane(tid >> 6), lane = tid & 63, wr = wid >> 2, wc = wid & 3, fr = lane & 15, fq = lane >> 4;
    const int K = g.K, nt = K / BK;
    unsigned voffA[2], voffB[2];
#pragma unroll
    for (int i = 0; i < 2; ++i) { int R, C; stage_rc(tid * 16 + i * 8192, R, C); const int Rb = Epi::PERM ? ((R & ~31) + perm32(R & 31)) : R;
        voffA[i] = (unsigned)(R * K + C) * 2u; voffB[i] = (unsigned)(Rb * K + C) * 2u; }
    const size_t kstep = (size_t)(BK * 2);
    const size_t hstep = (size_t)HALF * K * 2;
    const size_t tstep = 2 * hstep;
    const unsigned ldsw = (unsigned)wid * 1024u;
    const int aoff = lds_byte(wr * 64 + fr, fq * 8), boff = lds_byte(wc * 32 + fr, fq * 8);
#define PG8_SA(b, h) (((b) * 2 + (h)) * HTB)
#define PG8_SB(b, h) ((4 + (b) * 2 + (h)) * HTB)
#define PG8_STAGE(bufoff, gbase, voff) do { _Pragma("unroll") for (int _i = 0; _i < 2; ++_i) \
        __builtin_amdgcn_global_load_lds((const unsigned*)((const char*)(gbase) + (voff)[_i]), (PG8_LAS unsigned*)(lds + (bufoff) + ldsw + _i * 8192), 16, 0, 0); } while (0)
#define PG8_LDA(dst, b, h) do { _Pragma("unroll") for (int m = 0; m < 4; ++m) _Pragma("unroll") for (int k = 0; k < 2; ++k) dst[m][k] = *(const PG8_LAS bf16x8*)(lds + PG8_SA(b, h) + aoff + m * 2048 + k * 1024); } while (0)
#define PG8_LDB(dst, b, h) do { _Pragma("unroll") for (int n = 0; n < 2; ++n) _Pragma("unroll") for (int k = 0; k < 2; ++k) dst[n][k] = *(const PG8_LAS bf16x8*)(lds + PG8_SB(b, h) + boff + n * 2048 + k * 1024); } while (0)
#define PG8_MMA(ai, bj, At, Bt) do { __builtin_amdgcn_s_setprio(1); _Pragma("unroll") for (int m = 0; m < 4; ++m) _Pragma("unroll") for (int n = 0; n < 2; ++n) _Pragma("unroll") for (int k = 0; k < 2; ++k) \
        acc[ai][bj][m][n] = __builtin_amdgcn_mfma_f32_16x16x32_bf16(Bt[n][k], At[m][k], acc[ai][bj][m][n], 0, 0, 0); __builtin_amdgcn_s_setprio(0); } while (0)
#define PG8_WAIT_V(n) asm volatile("s_waitcnt vmcnt(" #n ")" ::: "memory")
#define PG8_WAIT_L(n) asm volatile("s_waitcnt lgkmcnt(" #n ")" ::: "memory")
#define PG8_BAR __builtin_amdgcn_s_barrier()
#define PG8_SCHED __builtin_amdgcn_sched_barrier(0)
    Unit cur, nxt; int ui = 0;
    if (!S.next(0, cur)) return;
    f32x4 acc[2][2][4][2];
#pragma unroll
    for (int a = 0; a < 2; ++a)
#pragma unroll
        for (int b = 0; b < 2; ++b)
#pragma unroll
            for (int m = 0; m < 4; ++m)
#pragma unroll
                for (int n = 0; n < 2; ++n) acc[a][b][m][n] = (f32x4){0.f, 0.f, 0.f, 0.f};
    bf16x8 At[4][2], B0[2][2], B1[2][2];
    const char* cA = (const char*)g.A + (size_t)cur.pm * tstep; const char* cB = (const char*)g.Bt + (size_t)cur.pn * tstep;
    S.a_ready(cur);
    if constexpr (SP2) {
        PG8_STAGE(PG8_SB(0, 0), cB, voffB); PG8_STAGE(PG8_SB(0, 1), cB + hstep, voffB); PG8_STAGE(PG8_SA(0, 0), cA, voffA); PG8_STAGE(PG8_SA(0, 1), cA + hstep, voffA);
        if (wr == 1) PG8_BAR;
        PG8_WAIT_V(2); PG8_BAR;
        PG8_STAGE(PG8_SB(1, 0), cB + kstep, voffB); PG8_STAGE(PG8_SA(1, 0), cA + kstep, voffA); PG8_STAGE(PG8_SB(1, 1), cB + hstep + kstep, voffB);
        PG8_WAIT_V(6); PG8_BAR;
    } else {
        PG8_STAGE(PG8_SB(0, 0), cB, voffB); PG8_STAGE(PG8_SA(0, 0), cA, voffA); PG8_STAGE(PG8_SB(0, 1), cB + hstep, voffB); PG8_STAGE(PG8_SA(0, 1), cA + hstep, voffA);
        if (wr == 1) PG8_BAR;
        PG8_WAIT_V(4); PG8_BAR;
        PG8_STAGE(PG8_SB(1, 0), cB + kstep, voffB); PG8_STAGE(PG8_SA(1, 0), cA + kstep, voffA); PG8_STAGE(PG8_SB(1, 1), cB + hstep + kstep, voffB);
        PG8_WAIT_V(6); PG8_BAR;
    }
    for (;;) {
        const bool has_next = S.next(ui + 1, nxt);
        const char* nA = has_next ? (const char*)g.A + (size_t)nxt.pm * tstep : cA; const char* nB = has_next ? (const char*)g.Bt + (size_t)nxt.pn * tstep : cB;
        for (int t = 0; t < nt; t += 2) {
            const bool last = (t == nt - 2);
            const char* a1 = cA + (size_t)(t + 1) * kstep;
            const char* a2 = last ? nA : cA + (size_t)(t + 2) * kstep; const char* b2 = last ? nB : cB + (size_t)(t + 2) * kstep;
            const char* a3 = a2 + kstep; const char* b3 = b2 + kstep;
            if (last && has_next) S.a_ready(nxt);
            if constexpr (SP2) {
            PG8_LDB(B0, 0, 0); PG8_LDB(B1, 0, 1); PG8_SCHED; PG8_LDA(At, 0, 0); PG8_STAGE(PG8_SA(1, 1), a1 + hstep, voffA);
            PG8_WAIT_V(8); PG8_WAIT_L(0); PG8_BAR; PG8_MMA(0, 0, At, B0); PG8_MMA(0, 1, At, B1); PG8_BAR; PG8_SCHED;
            PG8_LDA(At, 0, 1); PG8_STAGE(PG8_SB(0, 0), b2, voffB); PG8_STAGE(PG8_SB(0, 1), b2 + hstep, voffB); PG8_STAGE(PG8_SA(0, 0), a2, voffA);
            PG8_WAIT_V(8); PG8_WAIT_L(0); PG8_BAR; PG8_MMA(1, 0, At, B0); PG8_MMA(1, 1, At, B1); PG8_BAR; PG8_SCHED;
            PG8_LDB(B0, 1, 0); PG8_LDB(B1, 1, 1); PG8_SCHED; PG8_LDA(At, 1, 0); PG8_STAGE(PG8_SA(0, 1), a2 + hstep, voffA);
            PG8_WAIT_V(8); PG8_WAIT_L(0); PG8_BAR; PG8_MMA(0, 0, At, B0); PG8_MMA(0, 1, At, B1); PG8_BAR; PG8_SCHED;
            PG8_LDA(At, 1, 1); PG8_STAGE(PG8_SB(1, 0), b3, voffB); PG8_STAGE(PG8_SB(1, 1), b3 + hstep, voffB); PG8_STAGE(PG8_SA(1, 0), a3, voffA);
            PG8_WAIT_V(8); PG8_WAIT_L(0); PG8_BAR; PG8_MMA(1, 0, At, B0); PG8_MMA(1, 1, At, B1); PG8_BAR; PG8_SCHED;
            } else {
            PG8_LDB(B0, 0, 0); PG8_SCHED; PG8_LDA(At, 0, 0); PG8_STAGE(PG8_SA(1, 1), a1 + hstep, voffA);
            PG8_WAIT_L(8); PG8_BAR; PG8_WAIT_L(0); PG8_MMA(0, 0, At, B0); PG8_BAR; PG8_SCHED;
            PG8_LDB(B1, 0, 1); PG8_STAGE(PG8_SB(0, 0), b2, voffB);
            PG8_BAR; PG8_WAIT_L(0); PG8_MMA(0, 1, At, B1); PG8_BAR;
            PG8_LDA(At, 0, 1); PG8_STAGE(PG8_SA(0, 0), a2, voffA);
            PG8_BAR; PG8_WAIT_L(0); PG8_MMA(1, 0, At, B0); PG8_BAR; PG8_SCHED;
            PG8_STAGE(PG8_SB(0, 1), b2 + hstep, voffB);
            PG8_WAIT_V(6); PG8_BAR; PG8_MMA(1, 1, At, B1); PG8_BAR;
            PG8_LDB(B0, 1, 0); PG8_SCHED; PG8_LDA(At, 1, 0); PG8_STAGE(PG8_SA(0, 1), a2 + hstep, voffA);
            PG8_WAIT_L(8); PG8_BAR; PG8_WAIT_L(0); PG8_MMA(0, 0, At, B0); PG8_BAR; PG8_SCHED;
            PG8_LDB(B1, 1, 1); PG8_STAGE(PG8_SB(1, 0), b3, voffB);
            PG8_BAR; PG8_WAIT_L(0); PG8_MMA(0, 1, At, B1); PG8_BAR;
            PG8_LDA(At, 1, 1); PG8_STAGE(PG8_SA(1, 0), a3, voffA);
            PG8_BAR; PG8_WAIT_L(0); PG8_MMA(1, 0, At, B0); PG8_BAR; PG8_SCHED;
            PG8_STAGE(PG8_SB(1, 1), b3 + hstep, voffB);
            PG8_WAIT_V(6); PG8_BAR; PG8_MMA(1, 1, At, B1); PG8_BAR;
            }
        }
        if constexpr (ALIGN_EPI) { if (wr == 0) PG8_BAR; }
        if constexpr (!Epi::AFTER_DRAIN) { E(acc, cur, wr, wc, fr, fq); S.done(cur); }
        if (!has_next) break;
#pragma unroll
        for (int a = 0; a < 2; ++a)
#pragma unroll
            for (int b = 0; b < 2; ++b)
#pragma unroll
                for (int m = 0; m < 4; ++m)
#pragma unroll
                    for (int n = 0; n < 2; ++n) acc[a][b][m][n] = (f32x4){0.f, 0.f, 0.f, 0.f};
        cur = nxt; cA = nA; cB = nB; ++ui;
        if constexpr (ALIGN_EPI) { if (wr == 1) PG8_BAR; }
    }
    PG8_WAIT_V(0);
    if constexpr (!ALIGN_EPI) { if (wr == 0) PG8_BAR; }
    PG8_BAR;
    if constexpr (Epi::AFTER_DRAIN) { E.fused(acc, cur, wr, wc, fr, fq, lds, wid, lane); S.done(cur); }
#undef PG8_SA
#undef PG8_SB
#undef PG8_STAGE
#undef PG8_LDA
#undef PG8_LDB
#undef PG8_MMA
#undef PG8_WAIT_V
#undef PG8_WAIT_L
#undef PG8_BAR
#undef PG8_SCHED
}
}

#ifndef PG8_SP2
#define PG8_SP2 true
#endif
#ifndef PG8_ALIGN
#define PG8_ALIGN true
#endif

namespace cg = cooperative_groups;
#define LAS __attribute__((address_space(3)))
typedef unsigned short bf16_t;
typedef short bf16x8 __attribute__((ext_vector_type(8)));
typedef short s16x4 __attribute__((ext_vector_type(4)));
typedef float f32x4 __attribute__((ext_vector_type(4)));
typedef float f32x16 __attribute__((ext_vector_type(16)));
typedef unsigned u32x4 __attribute__((ext_vector_type(4)));
typedef unsigned u32x2 __attribute__((ext_vector_type(2)));
typedef float f32x2_t __attribute__((ext_vector_type(2)));
typedef __bf16 bf16x2_t __attribute__((ext_vector_type(2)));

#ifndef MK_SPLIT
#define MK_SPLIT 0
#endif

constexpr int NWAVES = 8;
constexpr int DM = 1024, SEQ = 8192, NBATCH = 2, LP = 8320, MTOK = 16384, M1 = 16640, NIN = 5376, PP = 3328, GW = 2048;
constexpr int AW = 512, BW = 512;
constexpr float RMS_EPS = 1e-6f, LOG2E = 1.4426950408889634f;
constexpr float QSCALE = 0.125f * LOG2E;
constexpr float LAM_INIT = 0.2f;

constexpr size_t MiB = 1u << 20;
constexpr size_t WS_WIN = 1 * MiB, WS_WUA = 12 * MiB, WS_WUB = 13 * MiB, WS_WO = 14 * MiB;
constexpr size_t WS_XN = 16 * MiB, WS_YA = 16 * MiB, WS_YB = 32 * MiB;
constexpr size_t WS_P = 49 * MiB, WS_T = 49 * MiB, WS_MIX = 113 * MiB;
constexpr size_t WS_G = 155 * MiB, WS_END = 219 * MiB;
static_assert(WS_XN + (size_t)M1 * DM * 2 <= WS_P && WS_P + (size_t)M1 * PP * 2 <= WS_G && WS_MIX + (size_t)MTOK * DM * 2 <= WS_G, "ws map");

constexpr int LDS_BYTES = 147456;

__device__ __forceinline__ unsigned f2bf(float f) { unsigned u = __builtin_bit_cast(unsigned, f); return (u + 0x7fffu + ((u >> 16) & 1u)) >> 16; }
__device__ __forceinline__ unsigned pk2(float lo, float hi) { f32x2_t v = {lo, hi}; bf16x2_t b = __builtin_convertvector(v, bf16x2_t); return __builtin_bit_cast(unsigned, b); }
__device__ __forceinline__ float bf2f(unsigned short u) { return __builtin_bit_cast(float, (unsigned)u << 16); }
__device__ __forceinline__ float bflo(unsigned u) { return __builtin_bit_cast(float, u << 16); }
__device__ __forceinline__ float bfhi(unsigned u) { return __builtin_bit_cast(float, u & 0xffff0000u); }
__device__ __forceinline__ float wave_sum(float v) {
#pragma unroll
    for (int o = 1; o < 64; o <<= 1) v += __shfl_xor(v, o);
    return v;
}
__device__ __forceinline__ float wave_max(float v) {
#pragma unroll
    for (int o = 1; o < 64; o <<= 1) v = fmaxf(v, __shfl_xor(v, o));
    return v;
}
__device__ __forceinline__ float fast_exp2(float x) { return __builtin_amdgcn_exp2f(x); }
__device__ __forceinline__ float sigmoidf_(float x) { return __builtin_amdgcn_rcpf(1.0f + fast_exp2(-x * LOG2E)); }

__device__ __forceinline__ int perm_in_col(int c) { const int pn = c >> 8, rem = c & 255, wc = rem >> 6, bj = (rem >> 5) & 1, j = rem & 31; return (pn << 8) + 128 * bj + 32 * wc + j; }

template <bool PERMCOL>
__device__ __forceinline__ void p0_transpose_item(const float* W, int K, int N, bf16_t* WT, LAS float* scr, int item, int lane) {
    const int nblk = N / 32, kb = item / nblk, nb = item % nblk, k0 = 64 * kb, n0 = 32 * nb;
#pragma unroll 8
    for (int i = 0; i < 32; ++i) { const int kk = 2 * i + (lane >> 5); scr[kk * 33 + (lane & 31)] = W[(size_t)(k0 + kk) * N + n0 + (lane & 31)]; }
    asm volatile("s_waitcnt lgkmcnt(0)" ::: "memory");
    const int c = lane & 7;
#pragma unroll
    for (int j = 0; j < 4; ++j) { const int n = (lane >> 3) + 8 * j; const LAS float* s = scr + (8 * c) * 33 + n;
        u32x4 o; o.x = pk2(s[0 * 33], s[1 * 33]); o.y = pk2(s[2 * 33], s[3 * 33]); o.z = pk2(s[4 * 33], s[5 * 33]); o.w = pk2(s[6 * 33], s[7 * 33]);
        const int drow = PERMCOL ? perm_in_col(n0 + n) : (n0 + n);
        *(u32x4*)(WT + (size_t)drow * K + k0 + 8 * c) = o; }
    asm volatile("s_waitcnt lgkmcnt(0)" ::: "memory");
}
__device__ __forceinline__ void rms_row_to_bf16(const float* xrow, const float* g, bf16_t* orow, int lane) {
    unsigned long long* o8 = (unsigned long long*)orow + lane;
    if (xrow == nullptr) {
#pragma unroll
        for (int j = 0; j < 4; ++j) o8[64 * j] = 0ull;
        return;
    }
    const f32x4* xr = (const f32x4*)xrow + lane; const f32x4* gr = (const f32x4*)g + lane;
    f32x4 v[4]; float s = 0.f;
#pragma unroll
    for (int j = 0; j < 4; ++j) { v[j] = xr[64 * j]; s += (v[j].x * v[j].x + v[j].y * v[j].y) + (v[j].z * v[j].z + v[j].w * v[j].w); }
    const float rstd = 1.0f / sqrtf(wave_sum(s) * (1.f / DM) + RMS_EPS);
#pragma unroll
    for (int j = 0; j < 4; ++j) { const f32x4 gg = gr[64 * j]; const f32x4 y = v[j] * rstd * gg;
        o8[64 * j] = (unsigned long long)pk2(y.x, y.y) | ((unsigned long long)pk2(y.z, y.w) << 32); }
}

struct EpiIn {
    static constexpr bool PERM = true, AFTER_DRAIN = false;
    bf16_t* P; bf16_t* G; const float* aqn; const float* akn; const float* bqn; const float* bkn;
    __device__ __forceinline__ void operator()(const f32x4 (&acc)[2][2][4][2], const pg8::Unit& u, int wr, int wc, int fr, int fq) const {
        const int c64 = u.pn * 4 + wc;
        const float* gp = nullptr; float gscale = 1.f;
        if (c64 < 8) { gp = aqn; gscale = QSCALE; } else if (c64 < 10) gp = akn; else if (c64 >= 20 && c64 < 28) { gp = bqn; gscale = QSCALE; } else if (c64 >= 28 && c64 < 36) gp = bkn;
        const int mode = gp ? 1 : (((c64 >= 12 && c64 < 20) || (c64 >= 44 && c64 < 52)) ? 2 : (c64 >= 52 ? 3 : 0));
        f32x4 gv[2][2];
#pragma unroll
        for (int bj = 0; bj < 2; ++bj)
#pragma unroll
            for (int n = 0; n < 2; ++n) gv[bj][n] = gp ? *(const f32x4*)(gp + 32 * bj + 8 * fq + 4 * n) * gscale : (f32x4){1.f, 1.f, 1.f, 1.f};
        const bool meta = (u.pm >= 64);
#pragma unroll
        for (int ai = 0; ai < 2; ++ai)
#pragma unroll
            for (int m = 0; m < 4; ++m) {
                const int r = u.pm * 256 + ai * 128 + wr * 64 + m * 16 + fr;
                f32x4 v[2][2];
#pragma unroll
                for (int bj = 0; bj < 2; ++bj)
#pragma unroll
                    for (int n = 0; n < 2; ++n) v[bj][n] = acc[ai][bj][m][n];
                if (mode == 1) {
                    float ss = 0.f;
#pragma unroll
                    for (int bj = 0; bj < 2; ++bj)
#pragma unroll
                        for (int n = 0; n < 2; ++n) { const f32x4 x = v[bj][n]; ss += (x[0] * x[0] + x[1] * x[1]) + (x[2] * x[2] + x[3] * x[3]); }
                    ss += __shfl_xor(ss, 16); ss += __shfl_xor(ss, 32);
                    const float rs = 1.0f / sqrtf(ss * (1.f / 64.f) + RMS_EPS);
#pragma unroll
                    for (int bj = 0; bj < 2; ++bj)
#pragma unroll
                        for (int n = 0; n < 2; ++n) v[bj][n] = v[bj][n] * rs * gv[bj][n];
                } else if (mode == 2) {
#pragma unroll
                    for (int bj = 0; bj < 2; ++bj)
#pragma unroll
                        for (int n = 0; n < 2; ++n)
#pragma unroll
                            for (int e = 0; e < 4; ++e) v[bj][n][e] = v[bj][n][e] * sigmoidf_(v[bj][n][e]);
                } else if (mode == 3) {
#pragma unroll
                    for (int bj = 0; bj < 2; ++bj)
#pragma unroll
                        for (int n = 0; n < 2; ++n)
#pragma unroll
                            for (int e = 0; e < 4; ++e) v[bj][n][e] = sigmoidf_(v[bj][n][e]);
                }
#pragma unroll
                for (int bj = 0; bj < 2; ++bj) {
                    u32x4 w; w.x = pk2(v[bj][0][0], v[bj][0][1]); w.y = pk2(v[bj][0][2], v[bj][0][3]); w.z = pk2(v[bj][1][0], v[bj][1][1]); w.w = pk2(v[bj][1][2], v[bj][1][3]);
                    if (c64 < 52) {
                        const int col = c64 * 64 + 32 * bj + 8 * fq;
                        if (!meta) { const int prow = r + 128 * ((r >> 13) + 1); *(u32x4*)(P + (size_t)prow * PP + col) = w; }
                        else { const int i = r - MTOK; if (i < 128) { const int tp = (i + 112) & 127; *(u32x4*)(P + (size_t)tp * PP + col) = w; *(u32x4*)(P + (size_t)(LP + tp) * PP + col) = w; } }
                    } else if (!meta) {
                        *(u32x4*)(G + (size_t)r * GW + (c64 - 52) * 64 + 32 * bj + 8 * fq) = w;
                    }
                }
            }
    }
};

struct EpiUpA {
    static constexpr bool PERM = true, AFTER_DRAIN = false;
    const bf16_t* G; float* T;
    __device__ __forceinline__ void operator()(const f32x4 (&acc)[2][2][4][2], const pg8::Unit& u, int wr, int wc, int fr, int fq) const {
#pragma unroll
        for (int ai = 0; ai < 2; ++ai)
#pragma unroll
            for (int m = 0; m < 4; ++m) { const int r = u.pm * 256 + ai * 128 + wr * 64 + m * 16 + fr;
#pragma unroll
                for (int bj = 0; bj < 2; ++bj) { const int c0 = u.pn * 256 + 128 * bj + 32 * wc + 8 * fq;
                    const u32x4 g = *(const u32x4*)(G + (size_t)r * GW + c0);
                    f32x4 a = acc[ai][bj][m][0], b = acc[ai][bj][m][1];
                    a[0] *= bflo(g.x); a[1] *= bfhi(g.x); a[2] *= bflo(g.y); a[3] *= bfhi(g.y); b[0] *= bflo(g.z); b[1] *= bfhi(g.z); b[2] *= bflo(g.w); b[3] *= bfhi(g.w);
                    float* tp = T + (size_t)r * DM + c0; *(f32x4*)tp = a; *(f32x4*)(tp + 4) = b; } }
    }
};
struct EpiUpB {
    static constexpr bool PERM = true, AFTER_DRAIN = false;
    const bf16_t* G; const float* T; bf16_t* MIX;
    __device__ __forceinline__ void operator()(const f32x4 (&acc)[2][2][4][2], const pg8::Unit& u, int wr, int wc, int fr, int fq) const {
#pragma unroll
        for (int ai = 0; ai < 2; ++ai)
#pragma unroll
            for (int m = 0; m < 4; ++m) { const int r = u.pm * 256 + ai * 128 + wr * 64 + m * 16 + fr;
#pragma unroll
                for (int bj = 0; bj < 2; ++bj) { const int c0 = u.pn * 256 + 128 * bj + 32 * wc + 8 * fq;
                    const u32x4 g = *(const u32x4*)(G + (size_t)r * GW + DM + c0);
                    const float* tp = T + (size_t)r * DM + c0; const f32x4 ta = *(const f32x4*)tp, tb = *(const f32x4*)(tp + 4);
                    f32x4 a = acc[ai][bj][m][0], b = acc[ai][bj][m][1];
                    a[0] = ta[0] + a[0] * bflo(g.x); a[1] = ta[1] + a[1] * bfhi(g.x); a[2] = ta[2] + a[2] * bflo(g.y); a[3] = ta[3] + a[3] * bfhi(g.y);
                    b[0] = tb[0] + b[0] * bflo(g.z); b[1] = tb[1] + b[1] * bfhi(g.z); b[2] = tb[2] + b[2] * bflo(g.w); b[3] = tb[3] + b[3] * bfhi(g.w);
                    u32x4 w; w.x = pk2(a[0], a[1]); w.y = pk2(a[2], a[3]); w.z = pk2(b[0], b[1]); w.w = pk2(b[2], b[3]);
                    *(u32x4*)(MIX + (size_t)r * DM + c0) = w; } }
    }
};
struct EpiOut {
    static constexpr bool PERM = true, AFTER_DRAIN = false;
    const float* X; float* O;
    __device__ __forceinline__ void operator()(const f32x4 (&acc)[2][2][4][2], const pg8::Unit& u, int wr, int wc, int fr, int fq) const {
#pragma unroll
        for (int ai = 0; ai < 2; ++ai)
#pragma unroll
            for (int m = 0; m < 4; ++m) { const int r = u.pm * 256 + ai * 128 + wr * 64 + m * 16 + fr;
#pragma unroll
                for (int bj = 0; bj < 2; ++bj) { const int c0 = u.pn * 256 + 128 * bj + 32 * wc + 8 * fq;
                    const float* xp = X + (size_t)r * DM + c0; float* op = O + (size_t)r * DM + c0;
                    *(f32x4*)op = *(const f32x4*)xp + acc[ai][bj][m][0]; *(f32x4*)(op + 4) = *(const f32x4*)(xp + 4) + acc[ai][bj][m][1]; } }
    }
};

#define MFMA32(a, b, c) __builtin_amdgcn_mfma_f32_32x32x16_bf16(a, b, c, 0, 0, 0)
typedef short v4i16_t __attribute__((ext_vector_type(4)));
__device__ __forceinline__ int crow(int r, int hi) { return (r & 3) + 8 * (r >> 2) + 4 * hi; }
__device__ __forceinline__ s16x4 vtr(const LAS unsigned char* p) { return __builtin_bit_cast(s16x4, __builtin_amdgcn_ds_read_tr16_b64_v4i16((LAS v4i16_t*)p)); }
__device__ __forceinline__ bf16x8 cat8(s16x4 lo, s16x4 hi) { return (bf16x8){lo[0], lo[1], lo[2], lo[3], hi[0], hi[1], hi[2], hi[3]}; }
__device__ __forceinline__ bf16x8 pack8(const f32x16& p, int b) {
    u32x4 w; w.x = pk2(p[b], p[b + 1]); w.y = pk2(p[b + 2], p[b + 3]); w.z = pk2(p[b + 4], p[b + 5]); w.w = pk2(p[b + 6], p[b + 7]); return __builtin_bit_cast(bf16x8, w); }
constexpr int ATT_SCR = 65536;

__device__ __forceinline__ void attn_b_unit(const bf16_t* __restrict__ P, bf16_t* __restrict__ YB, const float* __restrict__ subln, float kmax, float lam, int b, int h, int qb, LAS unsigned char* lds) {
    const int tid = threadIdx.x, lane = tid & 63, r32 = lane & 31, hi = lane >> 5; const int w = __builtin_amdgcn_readfirstlane(tid >> 6);
    const int map = w >> 2, wq = w & 3;
    const size_t rowbase = (size_t)b * LP;
    const float slope2 = exp2f(-2.0f * (float)(h + 1)) * LOG2E;
    const bf16_t* k0src = P + (rowbase + lane) * PP + 1792 + h * 128 + w * 8;
    const bf16_t* k1src = k0src + 64;
    const int vrow0 = tid >> 4, vc = tid & 15;
    const bf16_t* vsrc = P + (rowbase + vrow0) * PP + 2304 + h * 128 + vc * 8;
    const int kdst = w * 1024 + lane * 16;
    const int vdst = 16384 + (vc >> 2) * 4096 + vrow0 * 64 + (vc & 3) * 16;
    const int qt = 128 * qb + 32 * wq + r32;
    bf16x8 qr[4];
    { const bf16_t* qp = P + (rowbase + qt) * PP + 1280 + h * 128 + map * 64 + 8 * hi;
#pragma unroll
      for (int d0 = 0; d0 < 4; ++d0) qr[d0] = *(const bf16x8*)(qp + 16 * d0); }
    float qss = 0.f;
#pragma unroll
    for (int d0 = 0; d0 < 4; ++d0)
#pragma unroll
        for (int e = 0; e < 8; ++e) { const float f = bf2f((unsigned short)qr[d0][e]); qss += f * f; }
    qss += __shfl_xor(qss, 32);
    const float mrow = sqrtf(qss) * kmax;
    f32x16 base;
#pragma unroll
    for (int r = 0; r < 16; ++r) base[r] = -slope2 * (float)(r32 - crow(r, hi)) - mrow;
    f32x16 o[4];
#pragma unroll
    for (int d = 0; d < 4; ++d) o[d] = f32x16{};
    float lsum = 0.f;
    const int tlast = 2 * qb + 1;
    { const size_t go = (size_t)64 * PP;
      const u32x4 a = *(const u32x4*)(k0src + go), c = *(const u32x4*)(k1src + go), d = *(const u32x4*)(vsrc + go), e = *(const u32x4*)(vsrc + go + (size_t)32 * PP);
      *(LAS u32x4*)(lds + kdst) = a; *(LAS u32x4*)(lds + 8192 + kdst) = c; *(LAS u32x4*)(lds + vdst) = d; *(LAS u32x4*)(lds + vdst + 2048) = e; }
    __syncthreads();
    const int vlane = ((lane >> 4) & 1) * 32 + (lane & 3) * 8 + (4 * hi + ((lane & 15) >> 2)) * 64;
    for (int t = 1; t <= tlast; ++t) {
        const int bo = ((t - 1) & 1) * 32768;
        u32x4 na, nc, nd, ne; const bool more = (t < tlast);
        if (more) { const size_t go = (size_t)(t + 1) * 64 * PP;
            na = *(const u32x4*)(k0src + go); nc = *(const u32x4*)(k1src + go); nd = *(const u32x4*)(vsrc + go); ne = *(const u32x4*)(vsrc + go + (size_t)32 * PP); }
        const float tb = slope2 * (float)(64 * t - (128 * qb + 32 * wq));
        f32x16 s0, s1;
#pragma unroll
        for (int r = 0; r < 16; ++r) { s0[r] = base[r] + tb; s1[r] = base[r] + (tb + 32.f * slope2); }
        const LAS unsigned char* kb = lds + bo + map * 8192 + hi * 1024 + r32 * 16;
#pragma unroll
        for (int d0 = 0; d0 < 4; ++d0) {
            const bf16x8 k0 = *(const LAS bf16x8*)(kb + d0 * 2048), k1 = *(const LAS bf16x8*)(kb + d0 * 2048 + 512);
            s0 = MFMA32(k0, qr[d0], s0); s1 = MFMA32(k1, qr[d0], s1); }
#pragma unroll
        for (int r = 0; r < 16; ++r) { s0[r] = fast_exp2(s0[r]); s1[r] = fast_exp2(s1[r]); }
        if (t == 1 || t >= 2 * qb) {
#pragma unroll
            for (int r = 0; r < 16; ++r) { const int k0t = 64 * t + crow(r, hi), k1t = k0t + 32;
                if (k0t > qt || k0t < 112) s0[r] = 0.f; if (k1t > qt || k1t < 112) s1[r] = 0.f; }
        }
        { float a = 0.f;
#pragma unroll
          for (int r = 0; r < 16; ++r) a += s0[r] + s1[r];
          lsum += a; }
        const bf16x8 pw0 = pack8(s0, 0), pw1 = pack8(s0, 8), pw2 = pack8(s1, 0), pw3 = pack8(s1, 8);
        const LAS unsigned char* vb = lds + bo + 16384 + vlane;
#pragma unroll
        for (int d0 = 0; d0 < 4; ++d0) {
            o[d0] = MFMA32(pw0, cat8(vtr(vb + d0 * 4096), vtr(vb + d0 * 4096 + 512)), o[d0]);
            o[d0] = MFMA32(pw1, cat8(vtr(vb + d0 * 4096 + 1024), vtr(vb + d0 * 4096 + 1536)), o[d0]);
            o[d0] = MFMA32(pw2, cat8(vtr(vb + d0 * 4096 + 2048), vtr(vb + d0 * 4096 + 2560)), o[d0]);
            o[d0] = MFMA32(pw3, cat8(vtr(vb + d0 * 4096 + 3072), vtr(vb + d0 * 4096 + 3584)), o[d0]);
        }
        if (more) { const int bn = (t & 1) * 32768;
            *(LAS u32x4*)(lds + bn + kdst) = na; *(LAS u32x4*)(lds + bn + 8192 + kdst) = nc; *(LAS u32x4*)(lds + bn + vdst) = nd; *(LAS u32x4*)(lds + bn + vdst + 2048) = ne; }
        __syncthreads();
    }
    lsum += __shfl_xor(lsum, 32);
    LAS float* scr = (LAS float*)(lds + ATT_SCR) + w * 32;
    { float inv = 1.0f / lsum; if (map == 1) inv *= lam; if (hi == 0) scr[r32] = inv; }
    float rl[16];
#pragma unroll
    for (int r = 0; r < 16; ++r) rl[r] = scr[crow(r, hi)];
#pragma unroll
    for (int d0 = 0; d0 < 4; ++d0)
#pragma unroll
        for (int r = 0; r < 16; ++r) o[d0][r] *= rl[r];
    LAS float* X = (LAS float*)lds;
    if (map == 1) {
#pragma unroll
        for (int d0 = 0; d0 < 4; ++d0)
#pragma unroll
            for (int r = 0; r < 16; ++r) X[((wq * 4 + d0) * 16 + r) * 64 + lane] = o[d0][r];
    }
    __syncthreads();
    if (map == 0) {
        float rn[16];
#pragma unroll
        for (int r = 0; r < 16; ++r) { float ss = 0.f;
#pragma unroll
            for (int d0 = 0; d0 < 4; ++d0) { o[d0][r] -= X[((wq * 4 + d0) * 16 + r) * 64 + lane]; ss += o[d0][r] * o[d0][r]; }
            ss += __shfl_xor(ss, 1); ss += __shfl_xor(ss, 2); ss += __shfl_xor(ss, 4); ss += __shfl_xor(ss, 8); ss += __shfl_xor(ss, 16);
            rn[r] = (1.0f - LAM_INIT) / sqrtf(ss * (1.f / 128.f) + RMS_EPS); }
#pragma unroll
        for (int d0 = 0; d0 < 4; ++d0) { const int col = h * 128 + 32 * d0 + r32; const float sg = subln[32 * d0 + r32];
#pragma unroll
            for (int r = 0; r < 16; ++r) { const int tq = 128 * qb + 32 * wq + crow(r, hi);
                const float z = bf2f(P[(rowbase + tq) * PP + 2816 + col]);
                YB[((size_t)b * SEQ + (tq - 128)) * BW + col] = (bf16_t)f2bf(o[d0][r] * rn[r] * sg * z); } }
    }
    __syncthreads();
}

__device__ __forceinline__ void attn_a_unit(const bf16_t* __restrict__ P, bf16_t* __restrict__ YA, const float* __restrict__ sink, float kmax, int b, int kvh, int qb, LAS unsigned char* lds) {
    const int tid = threadIdx.x, lane = tid & 63, r32 = lane & 31, hi = lane >> 5; const int w = __builtin_amdgcn_readfirstlane(tid >> 6);
    const size_t rowbase = (size_t)b * LP; const int kt0 = 128 * (qb - 1);
    { u32x4 kk[4], vv[4];
#pragma unroll
      for (int j = 0; j < 4; ++j) { kk[j] = *(const u32x4*)(P + (rowbase + kt0 + 64 * j + lane) * PP + 512 + kvh * 64 + w * 8);
                                    vv[j] = *(const u32x4*)(P + (rowbase + kt0 + 64 * j + (tid >> 3)) * PP + 640 + kvh * 64 + (tid & 7) * 8); }
#pragma unroll
      for (int j = 0; j < 4; ++j) { *(LAS u32x4*)(lds + j * 8192 + w * 1024 + lane * 16) = kk[j];
                                    *(LAS u32x4*)(lds + 32768 + j * 8192 + ((tid & 7) >> 2) * 4096 + (tid >> 3) * 64 + (tid & 3) * 16) = vv[j]; } }
    __syncthreads();
    const int g = w >> 1, hq = kvh * 4 + g;
    const float slope2 = exp2f(-(float)(hq + 1)) * LOG2E, sink2 = sink[hq] * LOG2E;
    const int vlane = ((lane >> 4) & 1) * 32 + (lane & 3) * 8 + (4 * hi + ((lane & 15) >> 2)) * 64;
    LAS float* scr = (LAS float*)(lds + ATT_SCR) + w * 32;
    for (int sub = 0; sub < 2; ++sub) {
        const int q0 = 64 * (w & 1) + 32 * sub; const int qrel = 128 + q0 + r32;
        bf16x8 qr[4];
        { const bf16_t* qp = P + (rowbase + kt0 + qrel) * PP + hq * 64 + 8 * hi;
#pragma unroll
          for (int d0 = 0; d0 < 4; ++d0) qr[d0] = *(const bf16x8*)(qp + 16 * d0); }
        float qss = 0.f;
#pragma unroll
        for (int d0 = 0; d0 < 4; ++d0)
#pragma unroll
            for (int e = 0; e < 8; ++e) { const float f = bf2f((unsigned short)qr[d0][e]); qss += f * f; }
        qss += __shfl_xor(qss, 32);
        const float cref = fmaxf(sqrtf(qss) * kmax, sink2);
        f32x16 o[2]; o[0] = f32x16{}; o[1] = f32x16{}; float lsum = 0.f;
        for (int jj = 0; jj < 3; ++jj) { const int j = (w & 1) + jj;
            f32x16 s0, s1;
#pragma unroll
            for (int r = 0; r < 16; ++r) { const int d0_ = qrel - (64 * j + crow(r, hi)); s0[r] = -slope2 * (float)d0_ - cref; s1[r] = -slope2 * (float)(d0_ - 32) - cref; }
            const LAS unsigned char* kb = lds + j * 8192 + hi * 1024 + r32 * 16;
#pragma unroll
            for (int d0 = 0; d0 < 4; ++d0) {
                const bf16x8 k0 = *(const LAS bf16x8*)(kb + d0 * 2048), k1 = *(const LAS bf16x8*)(kb + d0 * 2048 + 512);
                s0 = MFMA32(k0, qr[d0], s0); s1 = MFMA32(k1, qr[d0], s1); }
#pragma unroll
            for (int r = 0; r < 16; ++r) { const int kr = 64 * j + crow(r, hi); const int da = qrel - kr, db = da - 32;
                const float e0 = fast_exp2(s0[r]), e1 = fast_exp2(s1[r]);
                s0[r] = (da >= 0 && da < 128 && kt0 + kr >= 112) ? e0 : 0.f;
                s1[r] = (db >= 0 && db < 128 && kt0 + kr + 32 >= 112) ? e1 : 0.f; }
            { float a = 0.f;
#pragma unroll
              for (int r = 0; r < 16; ++r) a += s0[r] + s1[r];
              lsum += a; }
            const bf16x8 pw0 = pack8(s0, 0), pw1 = pack8(s0, 8), pw2 = pack8(s1, 0), pw3 = pack8(s1, 8);
            const LAS unsigned char* vb = lds + 32768 + j * 8192 + vlane;
#pragma unroll
            for (int d0 = 0; d0 < 2; ++d0) {
                o[d0] = MFMA32(pw0, cat8(vtr(vb + d0 * 4096), vtr(vb + d0 * 4096 + 512)), o[d0]);
                o[d0] = MFMA32(pw1, cat8(vtr(vb + d0 * 4096 + 1024), vtr(vb + d0 * 4096 + 1536)), o[d0]);
                o[d0] = MFMA32(pw2, cat8(vtr(vb + d0 * 4096 + 2048), vtr(vb + d0 * 4096 + 2560)), o[d0]);
                o[d0] = MFMA32(pw3, cat8(vtr(vb + d0 * 4096 + 3072), vtr(vb + d0 * 4096 + 3584)), o[d0]);
            }
        }
        lsum += __shfl_xor(lsum, 32);
        { const float inv = 1.0f / (lsum + fast_exp2(sink2 - cref)); if (hi == 0) scr[r32] = inv; }
        float rl[16];
#pragma unroll
        for (int r = 0; r < 16; ++r) rl[r] = scr[crow(r, hi)];
#pragma unroll
        for (int d0 = 0; d0 < 2; ++d0) { const int col = hq * 64 + 32 * d0 + r32;
#pragma unroll
            for (int r = 0; r < 16; ++r) { const int tq = kt0 + 128 + q0 + crow(r, hi);
                const float z = bf2f(P[(rowbase + tq) * PP + 768 + col]);
                YA[((size_t)b * SEQ + (tq - 128)) * AW + col] = (bf16_t)f2bf(o[d0][r] * rl[r] * z); } }
    }
    __syncthreads();
}

struct Args { const float* in[17]; float* out; unsigned char* ws; int ph_lo, ph_hi; };

__global__ void __launch_bounds__(NWAVES * 64, 2) hybrid_fwd(Args args) {
    extern __shared__ __attribute__((aligned(16))) unsigned char lds_raw[];
    LAS unsigned char* lds = (LAS unsigned char*)lds_raw;
    cg::grid_group grid = cg::this_grid();
    const int tid = threadIdx.x, lane = tid & 63; const int wave = __builtin_amdgcn_readfirstlane(tid >> 6);
    const int G = gridDim.x; const int bx = blockIdx.x; const int vcu = (G % 8 == 0) ? (bx % 8) * (G / 8) + bx / 8 : bx;
    unsigned char* ws = args.ws;
    bf16_t* WinT = (bf16_t*)(ws + WS_WIN); bf16_t* WuaT = (bf16_t*)(ws + WS_WUA); bf16_t* WubT = (bf16_t*)(ws + WS_WUB); bf16_t* WoT = (bf16_t*)(ws + WS_WO);
    bf16_t* XN = (bf16_t*)(ws + WS_XN); bf16_t* YA = (bf16_t*)(ws + WS_YA); bf16_t* YB = (bf16_t*)(ws + WS_YB);
    bf16_t* Pb = (bf16_t*)(ws + WS_P); float* T = (float*)(ws + WS_T); bf16_t* MIX = (bf16_t*)(ws + WS_MIX); bf16_t* Gt = (bf16_t*)(ws + WS_G);
    const int lo = args.ph_lo, hi = args.ph_hi;
#define IN(k) (lo <= (k) && (k) < hi)
#define SEAM(k) do { if (IN(k) && IN((k) + 1)) grid.sync(); } while (0)

    if (IN(0)) {
        LAS float* scr = (LAS float*)(lds + wave * 16384);
        const int gw = vcu * NWAVES + wave, NGW = G * NWAVES;
        constexpr int I_IN = (DM / 64) * (NIN / 32), I_UP = (AW / 64) * (DM / 32), I_O = (DM / 64) * (DM / 32);
        constexpr int NITEMS = I_IN + 2 * I_UP + I_O;
        for (int it = gw; it < NITEMS; it += NGW) {
            int r = it;
            if (r < I_IN) { p0_transpose_item<true>(args.in[3], DM, NIN, WinT, scr, r, lane); continue; } r -= I_IN;
            if (r < I_UP) { p0_transpose_item<false>(args.in[14], AW, DM, WuaT, scr, r, lane); continue; } r -= I_UP;
            if (r < I_UP) { p0_transpose_item<false>(args.in[15], BW, DM, WubT, scr, r, lane); continue; } r -= I_UP;
            p0_transpose_item<false>(args.in[16], DM, DM, WoT, scr, r, lane);
        }
        for (int m = gw; m < M1; m += NGW) {
            const float* src = (m < MTOK) ? args.in[0] + (size_t)m * DM : ((m < MTOK + 16) ? args.in[1] + (size_t)(m - MTOK) * DM : nullptr);
            rms_row_to_bf16(src, args.in[2], XN + (size_t)m * DM, lane);
        }
    }
    SEAM(0);
    if (IN(1)) {
        pg8::Gemm g{XN, WinT, M1, NIN, DM}; pg8::StaticOrder S; S.init(M1, NIN, G, bx);
        EpiIn E{Pb, Gt, args.in[4], args.in[5], args.in[7], args.in[8]};
        pg8::gemm_phase<EpiIn, pg8::StaticOrder, PG8_ALIGN, PG8_SP2>(lds, g, S, E);
    }
    SEAM(1);
    if (IN(2)) {
        const float kmaxB = 8.0f * 1.02f * wave_max(fabsf(args.in[8][lane]));
        const float kmaxA = 8.0f * 1.02f * wave_max(fabsf(args.in[5][lane]));
        const float lam = __expf(wave_sum(args.in[9][lane] * args.in[10][lane])) - __expf(wave_sum(args.in[11][lane] * args.in[12][lane])) + LAM_INIT;
        for (int pu = vcu; pu < 256; pu += G) {
            const int bh = pu >> 5, s = pu & 31;
            attn_b_unit(Pb, YB, args.in[13], kmaxB, lam, bh >> 2, bh & 3, 64 - s, lds);
            attn_b_unit(Pb, YB, args.in[13], kmaxB, lam, bh >> 2, bh & 3, 1 + s, lds);
        }
        for (int au = vcu; au < 256; au += G) {
            const int bk = au >> 6;
            attn_a_unit(Pb, YA, args.in[6], kmaxA, bk >> 1, bk & 1, 1 + (au & 63), lds);
        }
    }
    SEAM(2);
    if (IN(3)) {
        { pg8::Gemm g{YA, WuaT, MTOK, DM, AW}; pg8::StaticOrder S; S.init(MTOK, DM, G, bx); EpiUpA E{Gt, T};
          pg8::gemm_phase<EpiUpA, pg8::StaticOrder, PG8_ALIGN, PG8_SP2>(lds, g, S, E); }
        { pg8::Gemm g{YB, WubT, MTOK, DM, BW}; pg8::StaticOrder S; S.init(MTOK, DM, G, bx); EpiUpB E{Gt, T, MIX};
          pg8::gemm_phase<EpiUpB, pg8::StaticOrder, PG8_ALIGN, PG8_SP2>(lds, g, S, E); }
    }
    SEAM(3);
    if (IN(4)) {
        pg8::Gemm g{MIX, WoT, MTOK, DM, DM}; pg8::StaticOrder S; S.init(MTOK, DM, G, bx); EpiOut E{args.in[0], args.out};
        pg8::gemm_phase<EpiOut, pg8::StaticOrder, PG8_ALIGN, PG8_SP2>(lds, g, S, E);
    }
#undef IN
#undef SEAM
}

extern "C" void kernel_launch(void* const* d_in, const int* in_sizes, int n_in, void* d_out, int out_size, void* d_ws, size_t ws_size, hipStream_t stream) {
    static int grid = 0;
    if (grid == 0) {
        if (n_in != 17 || ws_size < WS_END) { fprintf(stderr, "kernel_launch: unexpected inputs (n_in %d, ws %zu)\n", n_in, ws_size); grid = -1; return; }
        int dev = 0, cus = 0, per_cu = 0;
        hipGetDevice(&dev); hipDeviceGetAttribute(&cus, hipDeviceAttributeMultiprocessorCount, dev);
        if (hipFuncSetAttribute((const void*)hybrid_fwd, hipFuncAttributeMaxDynamicSharedMemorySize, LDS_BYTES) != hipSuccess) { fprintf(stderr, "kernel_launch: hipFuncSetAttribute failed\n"); grid = -1; return; }
        if (hipOccupancyMaxActiveBlocksPerMultiprocessor(&per_cu, (const void*)hybrid_fwd, NWAVES * 64, LDS_BYTES) != hipSuccess || per_cu < 1) { fprintf(stderr, "kernel_launch: occupancy query says %d\n", per_cu); per_cu = 1; }
        (void)hipGetLastError();
        grid = cus * 1;
        if (grid <= 0) grid = 256;
    }
    if (grid < 0) return;
    Args a{};
    for (int i = 0; i < 17; ++i) a.in[i] = (const float*)d_in[i];
    a.out = (float*)d_out; a.ws = (unsigned char*)d_ws;
#if MK_SPLIT
    for (int p = 0; p < 5; ++p) { a.ph_lo = p; a.ph_hi = p + 1; void* kargs[] = {&a};
        hipError_t e = hipLaunchCooperativeKernel((const void*)hybrid_fwd, dim3(grid), dim3(NWAVES * 64), kargs, LDS_BYTES, stream);
        if (e != hipSuccess) fprintf(stderr, "kernel_launch: launch %d failed: %s\n", p, hipGetErrorString(e)); }
#else
    a.ph_lo = 0; a.ph_hi = 5; void* kargs[] = {&a};
    hipError_t e = hipLaunchCooperativeKernel((const void*)hybrid_fwd, dim3(grid), dim3(NWAVES * 64), kargs, LDS_BYTES, stream);
    if (e != hipSuccess) fprintf(stderr, "kernel_launch: cooperative launch failed: %s (grid %d)\n", hipGetErrorString(e), grid);
#endif
}
```

```cpp
#include <hip/hip_cooperative_groups.h>
#include <hip/hip_runtime.h>
#include <cstdio>
#include <cstdint>
namespace pg8 {
#define PG8_LAS __attribute__((address_space(3)))
typedef unsigned short bf16_t;
typedef short bf16x8 __attribute__((ext_vector_type(8)));
typedef float f32x4 __attribute__((ext_vector_type(4)));
typedef unsigned u32x4 __attribute__((ext_vector_type(4)));
constexpr int BM = 256, BK = 64, HALF = 128, HTB = HALF * BK * 2  , STAGE_BYTES = 8 * HTB, NXCD = 8, WGM = 8;

__host__ __device__ __forceinline__ int lds_byte(int r, int c) { const int st = (r >> 4) * 2 + (c >> 5), rr = r & 15, cc = c & 31, ob = rr * 64 + cc * 2; return st * 1024 + (ob ^ (((ob >> 9) & 1) << 5)); }
__host__ __device__ __forceinline__ void stage_rc(int b, int& R, int& C) { const int st = b / 1024, sb = b % 1024, swz = sb ^ (((sb >> 9) & 1) << 5); R = (st >> 1) * 16 + swz / 64; C = (st & 1) * 32 + (swz % 64) / 2; }
__host__ __device__ __forceinline__ int perm32(int rho) { const int n = rho >> 4, i = rho & 15; return 8 * (i >> 2) + 4 * n + (i & 3); }

struct Unit { int pm, pn, seg; };
struct Gemm { const bf16_t* A; const bf16_t* Bt; int M, N, K; const bf16_t* A2; const bf16_t* Bt2; };

struct StaticOrder {
    int nM, nN, nwg, G, c;
    __host__ __device__ void init(int M, int N, int G_, int c_) { nM = M / BM; nN = N / BM; nwg = nM * nN; G = G_; c = c_; }
    __host__ __device__ bool next(int i, Unit& u) const {
        const long L = (long)i * G + c; if (L >= nwg) return false;
        int wgid = (int)L; { const int q = nwg / NXCD, r = nwg % NXCD, xcd = wgid % NXCD, off = wgid / NXCD; wgid = (xcd < r ? xcd * (q + 1) : r * (q + 1) + (xcd - r) * q) + off; }
        const int nig = WGM * nN, gid = wgid / nig, fm = gid * WGM, gsz = (nM - fm) < WGM ? (nM - fm) : WGM;
        u.pm = fm + ((wgid % nig) % gsz); u.pn = (wgid % nig) / gsz; u.seg = 0; return true;
    }
    __device__ __forceinline__ void a_ready(const Unit&) const {}
    __device__ __forceinline__ void done(const Unit&) const {}
};

struct InOrder { int G, c, i0, lim;
    static constexpr int NNG = 832, NMETA = 13, NGATE = 512, NUNITS = NNG + NMETA + NGATE;
    __host__ __device__ bool next(int i, Unit& u) const {
        const int L = (i + i0) * G + c; if (L >= lim) return false;
        u.seg = 0;
        if (L < NNG) { const int x = L & 7, k = L >> 3; u.pn = k >> 3; u.pm = x + 8 * (k & 7); }
        else if (L < NNG + NMETA) { u.pm = 64; u.pn = L - NNG; }
        else { const int L2 = L - (NNG + NMETA) + 5; const int x = L2 & 7; int k = L2 >> 3; if (k == 64) k = 0; u.pn = 13 + (k >> 3); u.pm = x + 8 * (k & 7); }
        return true;
    }
    __device__ __forceinline__ void a_ready(const Unit&) const {}
    __device__ __forceinline__ void done(const Unit&) const {}
};
struct StaticOrder2 { StaticOrder base;
    __host__ __device__ void init(int M, int N, int G_, int c_) { base.init(M, N, G_, c_); }
    __host__ __device__ bool next(int i, Unit& u) const { if (!base.next(i >> 1, u)) return false; u.seg = i & 1; return true; }
    __device__ __forceinline__ void a_ready(const Unit&) const {}
    __device__ __forceinline__ void done(const Unit&) const {}
};
__device__ __forceinline__ unsigned cvt_pk_bf16(float lo, float hi) { unsigned r; asm volatile("v_cvt_pk_bf16_f32 %0, %1, %2" : "=v"(r) : "v"(lo), "v"(hi)); return r; }
typedef float f32x2 __attribute__((ext_vector_type(2)));
__device__ __forceinline__ f32x2 gelu_pk(f32x2 v) {
    const f32x2 av = __builtin_elementwise_abs(v), d = av * 0.2316418882f + 1.0f;
    f32x2 t; t.x = __builtin_amdgcn_rcpf(d.x); t.y = __builtin_amdgcn_rcpf(d.y);
    f32x2 q = t * 0.5307027145f + (-0.7265760135f); q = q * t + 0.7107068705f; q = q * t + (-0.142248368f); q = q * t + 0.127414796f; q = q * t;
    const f32x2 s = (v * v) * (-0.72134752044f);
    f32x2 e; e.x = __builtin_amdgcn_exp2f(s.x); e.y = __builtin_amdgcn_exp2f(s.y);
    const f32x2 m = v * (q * e), r = v - m;
    f32x2 o; o.x = v.x < 0.f ? m.x : r.x; o.y = v.y < 0.f ? m.y : r.y; return o;
}

template <int ACT  > struct EpiBf16 {
    static constexpr bool PERM = true, AFTER_DRAIN = false, TWO_SEG = false, INIT_ACC = false; static_assert(ACT == 0 || ACT == 1, "EpiBf16: ACT is 0 (none) or 1 (gelu_pk)");
    bf16_t* O; int ldc; const float* bias; int split_cols; size_t split_stride; float scale0;
    __device__ __forceinline__ void operator()(const f32x4 (&acc)[2][2][4][2], const Unit& u, int wr, int wc, int fr, int fq) const {
        const int row0 = u.pm * BM + wr * 64 + fr; int colt = u.pn * BM; bf16_t* base = O;
        float sc = 1.f; if (split_cols) { const int t = colt / split_cols; base += (size_t)t * split_stride; colt -= t * split_cols; if (t == 0) sc = scale0; }
        const int col0 = colt + wc * 32 + 8 * fq, bcol0 = u.pn * BM + wc * 32 + 8 * fq;
        f32x4 bv[2][2];
#pragma unroll
        for (int bj = 0; bj < 2; ++bj)
#pragma unroll
            for (int n = 0; n < 2; ++n) bv[bj][n] = bias ? *(const f32x4*)(bias + bcol0 + bj * HALF + 4 * n) : (f32x4){0.f, 0.f, 0.f, 0.f};
#pragma unroll
        for (int ai = 0; ai < 2; ++ai)
#pragma unroll
            for (int m = 0; m < 4; ++m) { bf16_t* rowp = base + (size_t)(row0 + ai * HALF + m * 16) * ldc + col0;
#pragma unroll
                for (int bj = 0; bj < 2; ++bj) { f32x4 v0 = acc[ai][bj][m][0] + bv[bj][0], v1 = acc[ai][bj][m][1] + bv[bj][1];
                    if (ACT == 1) { f32x2 a = gelu_pk((f32x2){v0[0], v0[1]}), b = gelu_pk((f32x2){v0[2], v0[3]}), c = gelu_pk((f32x2){v1[0], v1[1]}), d = gelu_pk((f32x2){v1[2], v1[3]});
                        v0 = (f32x4){a.x, a.y, b.x, b.y}; v1 = (f32x4){c.x, c.y, d.x, d.y}; }
                    v0 = v0 * sc; v1 = v1 * sc; u32x4 w; w.x = cvt_pk_bf16(v0[0], v0[1]); w.y = cvt_pk_bf16(v0[2], v0[3]); w.z = cvt_pk_bf16(v1[0], v1[1]); w.w = cvt_pk_bf16(v1[2], v1[3]);
                    *(u32x4*)(rowp + bj * HALF) = w; } }
    }
};

template <class Epi, class Sched, bool ALIGN_EPI = false, bool SP2 = false>
__device__ __forceinline__ void gemm_phase(PG8_LAS unsigned char* lds, const Gemm g, const Sched& S, const Epi& E) {
    const int tid = threadIdx.x, wid = __builtin_amdgcn_readfirstlane(tid >> 6), lane = tid & 63, wr = wid >> 2, wc = wid & 3, fr = lane & 15, fq = lane >> 4;
    const int K = g.K, nt = K / BK;
    unsigned voffA[2], voffB[2];
#pragma unroll
    for (int i = 0; i < 2; ++i) { int R, C; stage_rc(tid * 16 + i * 8192, R, C); const int Rb = Epi::PERM ? ((R & ~31) + perm32(R & 31)) : R;
        voffA[i] = (unsigned)(R * K + C) * 2u; voffB[i] = (unsigned)(Rb * K + C) * 2u; }
    const size_t kstep = (size_t)(BK * 2);
    const size_t hstep = (size_t)HALF * K * 2;
    const size_t tstep = 2 * hstep;
    const unsigned ldsw = (unsigned)wid * 1024u;
    const int aoff = lds_byte(wr * 64 + fr, fq * 8), boff = lds_byte(wc * 32 + fr, fq * 8);
#define PG8_SA(b, h) (((b) * 2 + (h)) * HTB)
#define PG8_SB(b, h) ((4 + (b) * 2 + (h)) * HTB)
#define PG8_STAGE(bufoff, gbase, voff) do { _Pragma("unroll") for (int _i = 0; _i < 2; ++_i) \
        __builtin_amdgcn_global_load_lds((const unsigned*)((const char*)(gbase) + (voff)[_i]), (PG8_LAS unsigned*)(lds + (bufoff) + ldsw + _i * 8192), 16, 0, 0); } while (0)
#define PG8_LDA(dst, b, h) do { _Pragma("unroll") for (int m = 0; m < 4; ++m) _Pragma("unroll") for (int k = 0; k < 2; ++k) dst[m][k] = *(const PG8_LAS bf16x8*)(lds + PG8_SA(b, h) + aoff + m * 2048 + k * 1024); } while (0)
#define PG8_LDB(dst, b, h) do { _Pragma("unroll") for (int n = 0; n < 2; ++n) _Pragma("unroll") for (int k = 0; k < 2; ++k) dst[n][k] = *(const PG8_LAS bf16x8*)(lds + PG8_SB(b, h) + boff + n * 2048 + k * 1024); } while (0)
#define PG8_MMA(ai, bj, At, Bt) do { __builtin_amdgcn_s_setprio(1); _Pragma("unroll") for (int m = 0; m < 4; ++m) _Pragma("unroll") for (int n = 0; n < 2; ++n) _Pragma("unroll") for (int k = 0; k < 2; ++k) \
        acc[ai][bj][m][n] = __builtin_amdgcn_mfma_f32_16x16x32_bf16(Bt[n][k], At[m][k], acc[ai][bj][m][n], 0, 0, 0); __builtin_amdgcn_s_setprio(0); } while (0)
#define PG8_WAIT_V(n) asm volatile("s_waitcnt vmcnt(" #n ")" ::: "memory")
#define PG8_WAIT_L(n) asm volatile("s_waitcnt lgkmcnt(" #n ")" ::: "memory")
#define PG8_BAR __builtin_amdgcn_s_barrier()
#define PG8_SCHED __builtin_amdgcn_sched_barrier(0)
    Unit cur, nxt; int ui = 0;
    if (!S.next(0, cur)) return;
    f32x4 acc[2][2][4][2];
    if constexpr (Epi::INIT_ACC) E.init(acc, cur, wr, wc, fr, fq);
    else
#pragma unroll
    for (int a = 0; a < 2; ++a)
#pragma unroll
        for (int b = 0; b < 2; ++b)
#pragma unroll
            for (int m = 0; m < 4; ++m)
#pragma unroll
                for (int n = 0; n < 2; ++n) acc[a][b][m][n] = (f32x4){0.f, 0.f, 0.f, 0.f};
    bf16x8 At[4][2], B0[2][2], B1[2][2];
    const char* cA = (const char*)(cur.seg ? g.A2 : g.A) + (size_t)cur.pm * tstep; const char* cB = (const char*)(cur.seg ? g.Bt2 : g.Bt) + (size_t)cur.pn * tstep;
    S.a_ready(cur);
    if constexpr (SP2) {
        PG8_STAGE(PG8_SB(0, 0), cB, voffB); PG8_STAGE(PG8_SB(0, 1), cB + hstep, voffB); PG8_STAGE(PG8_SA(0, 0), cA, voffA); PG8_STAGE(PG8_SA(0, 1), cA + hstep, voffA);
        if (wr == 1) PG8_BAR;
        PG8_WAIT_V(2); PG8_BAR;
        PG8_STAGE(PG8_SB(1, 0), cB + kstep, voffB); PG8_STAGE(PG8_SA(1, 0), cA + kstep, voffA); PG8_STAGE(PG8_SB(1, 1), cB + hstep + kstep, voffB);
        PG8_WAIT_V(6); PG8_BAR;
    } else {
        PG8_STAGE(PG8_SB(0, 0), cB, voffB); PG8_STAGE(PG8_SA(0, 0), cA, voffA); PG8_STAGE(PG8_SB(0, 1), cB + hstep, voffB); PG8_STAGE(PG8_SA(0, 1), cA + hstep, voffA);
        if (wr == 1) PG8_BAR;
        PG8_WAIT_V(4); PG8_BAR;
        PG8_STAGE(PG8_SB(1, 0), cB + kstep, voffB); PG8_STAGE(PG8_SA(1, 0), cA + kstep, voffA); PG8_STAGE(PG8_SB(1, 1), cB + hstep + kstep, voffB);
        PG8_WAIT_V(6); PG8_BAR;
    }
    for (;;) {
        const bool has_next = S.next(ui + 1, nxt);
        const char* nA = has_next ? (const char*)(nxt.seg ? g.A2 : g.A) + (size_t)nxt.pm * tstep : cA; const char* nB = has_next ? (const char*)(nxt.seg ? g.Bt2 : g.Bt) + (size_t)nxt.pn * tstep : cB;
        for (int t = 0; t < nt; t += 2) {
            const bool last = (t == nt - 2);
            const char* a1 = cA + (size_t)(t + 1) * kstep;
            const char* a2 = last ? nA : cA + (size_t)(t + 2) * kstep; const char* b2 = last ? nB : cB + (size_t)(t + 2) * kstep;
            const char* a3 = a2 + kstep; const char* b3 = b2 + kstep;
            if (last && has_next) S.a_ready(nxt);
            if constexpr (SP2) {
            PG8_LDB(B0, 0, 0); PG8_LDB(B1, 0, 1); PG8_SCHED; PG8_LDA(At, 0, 0); PG8_STAGE(PG8_SA(1, 1), a1 + hstep, voffA);
            PG8_WAIT_V(8); PG8_WAIT_L(0); PG8_BAR; PG8_MMA(0, 0, At, B0); PG8_MMA(0, 1, At, B1); PG8_BAR; PG8_SCHED;
            PG8_LDA(At, 0, 1); PG8_STAGE(PG8_SB(0, 0), b2, voffB); PG8_STAGE(PG8_SB(0, 1), b2 + hstep, voffB); PG8_STAGE(PG8_SA(0, 0), a2, voffA);
            PG8_WAIT_V(8); PG8_WAIT_L(0); PG8_BAR; PG8_MMA(1, 0, At, B0); PG8_MMA(1, 1, At, B1); PG8_BAR; PG8_SCHED;
            PG8_LDB(B0, 1, 0); PG8_LDB(B1, 1, 1); PG8_SCHED; PG8_LDA(At, 1, 0); PG8_STAGE(PG8_SA(0, 1), a2 + hstep, voffA);
            PG8_WAIT_V(8); PG8_WAIT_L(0); PG8_BAR; PG8_MMA(0, 0, At, B0); PG8_MMA(0, 1, At, B1); PG8_BAR; PG8_SCHED;
            PG8_LDA(At, 1, 1); PG8_STAGE(PG8_SB(1, 0), b3, voffB); PG8_STAGE(PG8_SB(1, 1), b3 + hstep, voffB); PG8_STAGE(PG8_SA(1, 0), a3, voffA);
            PG8_WAIT_V(8); PG8_WAIT_L(0); PG8_BAR; PG8_MMA(1, 0, At, B0); PG8_MMA(1, 1, At, B1); PG8_BAR; PG8_SCHED;
            } else {
            PG8_LDB(B0, 0, 0); PG8_SCHED; PG8_LDA(At, 0, 0); PG8_STAGE(PG8_SA(1, 1), a1 + hstep, voffA);
            PG8_WAIT_L(8); PG8_BAR; PG8_WAIT_L(0); PG8_MMA(0, 0, At, B0); PG8_BAR; PG8_SCHED;
            PG8_LDB(B1, 0, 1); PG8_STAGE(PG8_SB(0, 0), b2, voffB);
            PG8_BAR; PG8_WAIT_L(0); PG8_MMA(0, 1, At, B1); PG8_BAR;
            PG8_LDA(At, 0, 1); PG8_STAGE(PG8_SA(0, 0), a2, voffA);
            PG8_BAR; PG8_WAIT_L(0); PG8_MMA(1, 0, At, B0); PG8_BAR; PG8_SCHED;
            PG8_STAGE(PG8_SB(0, 1), b2 + hstep, voffB);
            PG8_WAIT_V(6); PG8_BAR; PG8_MMA(1, 1, At, B1); PG8_BAR;
            PG8_LDB(B0, 1, 0); PG8_SCHED; PG8_LDA(At, 1, 0); PG8_STAGE(PG8_SA(0, 1), a2 + hstep, voffA);
            PG8_WAIT_L(8); PG8_BAR; PG8_WAIT_L(0); PG8_MMA(0, 0, At, B0); PG8_BAR; PG8_SCHED;
            PG8_LDB(B1, 1, 1); PG8_STAGE(PG8_SB(1, 0), b3, voffB);
            PG8_BAR; PG8_WAIT_L(0); PG8_MMA(0, 1, At, B1); PG8_BAR;
            PG8_LDA(At, 1, 1); PG8_STAGE(PG8_SA(1, 0), a3, voffA);
            PG8_BAR; PG8_WAIT_L(0); PG8_MMA(1, 0, At, B0); PG8_BAR; PG8_SCHED;
            PG8_STAGE(PG8_SB(1, 1), b3 + hstep, voffB);
            PG8_WAIT_V(6); PG8_BAR; PG8_MMA(1, 1, At, B1); PG8_BAR;
            }
        }
        if constexpr (ALIGN_EPI) { if (wr == 0) PG8_BAR; }
        bool keep = false;
        if constexpr (Epi::TWO_SEG) { if (cur.seg == 0) { E.mid(acc, cur, wr, wc, fr, fq); keep = true; } }
        if (!keep) if constexpr (!Epi::AFTER_DRAIN) { E(acc, cur, wr, wc, fr, fq); S.done(cur); }
        if (!has_next) break;
        if constexpr (Epi::INIT_ACC) { if (!keep) E.init(acc, nxt, wr, wc, fr, fq); }
        else if (!keep)
#pragma unroll
        for (int a = 0; a < 2; ++a)
#pragma unroll
            for (int b = 0; b < 2; ++b)
#pragma unroll
                for (int m = 0; m < 4; ++m)
#pragma unroll
                    for (int n = 0; n < 2; ++n) acc[a][b][m][n] = (f32x4){0.f, 0.f, 0.f, 0.f};
        cur = nxt; cA = nA; cB = nB; ++ui;
        if constexpr (ALIGN_EPI) { if (wr == 1) PG8_BAR; }
    }
    PG8_WAIT_V(0);
    if constexpr (!ALIGN_EPI) { if (wr == 0) PG8_BAR; }
    PG8_BAR;
    if constexpr (Epi::AFTER_DRAIN) { E.fused(acc, cur, wr, wc, fr, fq, lds, wid, lane); S.done(cur); }
#undef PG8_SA
#undef PG8_SB
#undef PG8_STAGE
#undef PG8_LDA
#undef PG8_LDB
#undef PG8_MMA
#undef PG8_WAIT_V
#undef PG8_WAIT_L
#undef PG8_BAR
#undef PG8_SCHED
}
}

#ifndef PG8_SP2
#define PG8_SP2 true
#endif
#ifndef PG8_ALIGN
#define PG8_ALIGN true
#endif

namespace cg = cooperative_groups;
#define LAS __attribute__((address_space(3)))
typedef unsigned short bf16_t;
typedef short bf16x8 __attribute__((ext_vector_type(8)));
typedef short s16x4 __attribute__((ext_vector_type(4)));
typedef float f32x4 __attribute__((ext_vector_type(4)));
typedef float f32x16 __attribute__((ext_vector_type(16)));
typedef unsigned u32x4 __attribute__((ext_vector_type(4)));
typedef unsigned u32x2 __attribute__((ext_vector_type(2)));
typedef float f32x2_t __attribute__((ext_vector_type(2)));
typedef __bf16 bf16x2_t __attribute__((ext_vector_type(2)));

#ifndef MK_SPLIT
#define MK_SPLIT 0
#endif

constexpr int NWAVES = 8;
constexpr int DM = 1024, SEQ = 8192, NBATCH = 2, LP = 8320, MTOK = 16384, M1 = 16640, NIN = 5376, PP = 3328, GW = 2048;
constexpr int AW = 512, BW = 512;
constexpr float RMS_EPS = 1e-6f, LOG2E = 1.4426950408889634f;
constexpr float QSCALE = 0.125f * LOG2E;
constexpr float LAM_INIT = 0.2f;

constexpr size_t MiB = 1u << 20;
constexpr size_t WS_WIN = 1 * MiB, WS_WUA = 12 * MiB, WS_WUB = 13 * MiB, WS_WO = 14 * MiB;
constexpr size_t WS_XN = 16 * MiB, WS_YA = 16 * MiB, WS_YB = 32 * MiB;
constexpr size_t WS_P = 49 * MiB, WS_T = 49 * MiB, WS_MIX = 113 * MiB;
constexpr size_t WS_G = 155 * MiB, WS_END = 219 * MiB;
static_assert(WS_XN + (size_t)M1 * DM * 2 <= WS_P && WS_P + (size_t)M1 * PP * 2 <= WS_G && WS_MIX + (size_t)MTOK * DM * 2 <= WS_G, "ws map");

constexpr int LDS_BYTES = 147456;

__device__ __forceinline__ unsigned f2bf(float f) { unsigned u = __builtin_bit_cast(unsigned, f); return (u + 0x7fffu + ((u >> 16) & 1u)) >> 16; }
__device__ __forceinline__ unsigned pk2(float lo, float hi) { f32x2_t v = {lo, hi}; bf16x2_t b = __builtin_convertvector(v, bf16x2_t); return __builtin_bit_cast(unsigned, b); }
__device__ __forceinline__ float bf2f(unsigned short u) { return __builtin_bit_cast(float, (unsigned)u << 16); }
__device__ __forceinline__ float bflo(unsigned u) { return __builtin_bit_cast(float, u << 16); }
__device__ __forceinline__ float bfhi(unsigned u) { return __builtin_bit_cast(float, u & 0xffff0000u); }
__device__ __forceinline__ float wave_sum(float v) {
#pragma unroll
    for (int o = 1; o < 64; o <<= 1) v += __shfl_xor(v, o);
    return v;
}
__device__ __forceinline__ float wave_max(float v) {
#pragma unroll
    for (int o = 1; o < 64; o <<= 1) v = fmaxf(v, __shfl_xor(v, o));
    return v;
}
__device__ __forceinline__ float fast_exp2(float x) { return __builtin_amdgcn_exp2f(x); }
__device__ __forceinline__ float sigmoidf_(float x) { return __builtin_amdgcn_rcpf(1.0f + fast_exp2(-x * LOG2E)); }

__device__ __forceinline__ int perm_in_col(int c) { const int pn = c >> 8, rem = c & 255, wc = rem >> 6, bj = (rem >> 5) & 1, j = rem & 31; return (pn << 8) + 128 * bj + 32 * wc + j; }

template <bool PERMCOL>
__device__ __forceinline__ void p0_transpose_item(const float* W, int K, int N, bf16_t* WT, LAS float* scr, int item, int lane) {
    const int nblk = N / 32, kb = item / nblk, nb = item % nblk, k0 = 64 * kb, n0 = 32 * nb;
#pragma unroll 8
    for (int i = 0; i < 32; ++i) { const int kk = 2 * i + (lane >> 5); scr[kk * 33 + (lane & 31)] = __builtin_nontemporal_load(W + (size_t)(k0 + kk) * N + n0 + (lane & 31)); }
    asm volatile("s_waitcnt lgkmcnt(0)" ::: "memory");
    const int c = lane & 7;
#pragma unroll
    for (int j = 0; j < 4; ++j) { const int n = (lane >> 3) + 8 * j; const LAS float* s = scr + (8 * c) * 33 + n;
        u32x4 o; o.x = pk2(s[0 * 33], s[1 * 33]); o.y = pk2(s[2 * 33], s[3 * 33]); o.z = pk2(s[4 * 33], s[5 * 33]); o.w = pk2(s[6 * 33], s[7 * 33]);
        const int drow = PERMCOL ? perm_in_col(n0 + n) : (n0 + n);
        *(u32x4*)(WT + (size_t)drow * K + k0 + 8 * c) = o; }
    asm volatile("s_waitcnt lgkmcnt(0)" ::: "memory");
}
__device__ __forceinline__ void rms_rows2_to_bf16(const float* x0, const float* x1, const float* g, bf16_t* o0, bf16_t* o1, int lane) {
    const f32x4 z4 = {0.f, 0.f, 0.f, 0.f};
    f32x4 v0[4], v1[4];
#pragma unroll
    for (int j = 0; j < 4; ++j) { v0[j] = x0 ? __builtin_nontemporal_load((const f32x4*)x0 + lane + 64 * j) : z4; v1[j] = x1 ? __builtin_nontemporal_load((const f32x4*)x1 + lane + 64 * j) : z4; }
    float s0 = 0.f, s1 = 0.f;
#pragma unroll
    for (int j = 0; j < 4; ++j) { s0 += (v0[j].x * v0[j].x + v0[j].y * v0[j].y) + (v0[j].z * v0[j].z + v0[j].w * v0[j].w); s1 += (v1[j].x * v1[j].x + v1[j].y * v1[j].y) + (v1[j].z * v1[j].z + v1[j].w * v1[j].w); }
#pragma unroll
    for (int o = 1; o < 64; o <<= 1) { s0 += __shfl_xor(s0, o); s1 += __shfl_xor(s1, o); }
    const float r0 = 1.0f / sqrtf(s0 * (1.f / DM) + RMS_EPS), r1 = 1.0f / sqrtf(s1 * (1.f / DM) + RMS_EPS);
    unsigned long long* p0 = (unsigned long long*)o0 + lane; unsigned long long* p1 = (unsigned long long*)o1 + lane;
#pragma unroll
    for (int j = 0; j < 4; ++j) { const f32x4 gg = ((const f32x4*)g)[lane + 64 * j]; const f32x4 y0 = v0[j] * r0 * gg, y1 = v1[j] * r1 * gg;
        p0[64 * j] = (unsigned long long)pk2(y0.x, y0.y) | ((unsigned long long)pk2(y0.z, y0.w) << 32);
        if (o1) p1[64 * j] = (unsigned long long)pk2(y1.x, y1.y) | ((unsigned long long)pk2(y1.z, y1.w) << 32); }
}

struct EpiIn {
    static constexpr bool PERM = true, AFTER_DRAIN = false, TWO_SEG = false, INIT_ACC = false;
    bf16_t* P; bf16_t* G; const float* aqn; const float* akn; const float* bqn; const float* bkn;
    __device__ __forceinline__ void operator()(const f32x4 (&acc)[2][2][4][2], const pg8::Unit& u, int wr, int wc, int fr, int fq) const {
        const int c64 = u.pn * 4 + wc;
        const float* gp = nullptr; float gscale = 1.f;
        if (c64 < 8) { gp = aqn; gscale = QSCALE; } else if (c64 < 10) gp = akn; else if (c64 >= 20 && c64 < 28) { gp = bqn; gscale = QSCALE; } else if (c64 >= 28 && c64 < 36) gp = bkn;
        const int mode = gp ? 1 : (((c64 >= 12 && c64 < 20) || (c64 >= 44 && c64 < 52)) ? 2 : (c64 >= 52 ? 3 : 0));
        f32x4 gv[2][2];
#pragma unroll
        for (int bj = 0; bj < 2; ++bj)
#pragma unroll
            for (int n = 0; n < 2; ++n) gv[bj][n] = gp ? *(const f32x4*)(gp + 32 * bj + 8 * fq + 4 * n) * gscale : (f32x4){1.f, 1.f, 1.f, 1.f};
        const bool meta = (u.pm >= 64);
#pragma unroll
        for (int ai = 0; ai < 2; ++ai)
#pragma unroll
            for (int m = 0; m < 4; ++m) {
                const int r = u.pm * 256 + ai * 128 + wr * 64 + m * 16 + fr;
                f32x4 v[2][2];
#pragma unroll
                for (int bj = 0; bj < 2; ++bj)
#pragma unroll
                    for (int n = 0; n < 2; ++n) v[bj][n] = acc[ai][bj][m][n];
                if (mode == 1) {
                    float ss = 0.f;
#pragma unroll
                    for (int bj = 0; bj < 2; ++bj)
#pragma unroll
                        for (int n = 0; n < 2; ++n) { const f32x4 x = v[bj][n]; ss += (x[0] * x[0] + x[1] * x[1]) + (x[2] * x[2] + x[3] * x[3]); }
                    ss += __shfl_xor(ss, 16); ss += __shfl_xor(ss, 32);
                    const float rs = 1.0f / sqrtf(ss * (1.f / 64.f) + RMS_EPS);
#pragma unroll
                    for (int bj = 0; bj < 2; ++bj)
#pragma unroll
                        for (int n = 0; n < 2; ++n) v[bj][n] = v[bj][n] * rs * gv[bj][n];
                } else if (mode == 2) {
#pragma unroll
                    for (int bj = 0; bj < 2; ++bj)
#pragma unroll
                        for (int n = 0; n < 2; ++n)
#pragma unroll
                            for (int e = 0; e < 4; ++e) v[bj][n][e] = v[bj][n][e] * sigmoidf_(v[bj][n][e]);
                } else if (mode == 3) {
#pragma unroll
                    for (int bj = 0; bj < 2; ++bj)
#pragma unroll
                        for (int n = 0; n < 2; ++n)
#pragma unroll
                            for (int e = 0; e < 4; ++e) v[bj][n][e] = sigmoidf_(v[bj][n][e]);
                }
#pragma unroll
                for (int bj = 0; bj < 2; ++bj) {
                    u32x4 w; w.x = pk2(v[bj][0][0], v[bj][0][1]); w.y = pk2(v[bj][0][2], v[bj][0][3]); w.z = pk2(v[bj][1][0], v[bj][1][1]); w.w = pk2(v[bj][1][2], v[bj][1][3]);
                    if (c64 < 52) {
                        const int col = c64 * 64 + 32 * bj + 8 * fq;
                        if (!meta) { const int prow = r + 128 * ((r >> 13) + 1); *(u32x4*)(P + (size_t)prow * PP + col) = w; }
                        else { const int i = r - MTOK; if (i < 128) { const int tp = (i + 112) & 127; *(u32x4*)(P + (size_t)tp * PP + col) = w; *(u32x4*)(P + (size_t)(LP + tp) * PP + col) = w; } }
                    } else if (!meta) {
                        __builtin_nontemporal_store(w, (u32x4*)(G + (size_t)r * GW + (c64 - 52) * 64 + 32 * bj + 8 * fq));
                    }
                }
            }
    }
};

struct EpiUp {
    static constexpr bool PERM = true, AFTER_DRAIN = false, TWO_SEG = true, INIT_ACC = false;
    const bf16_t* G; bf16_t* MIX;
    __device__ __forceinline__ void mid(f32x4 (&acc)[2][2][4][2], const pg8::Unit& u, int wr, int wc, int fr, int fq) const {
#pragma unroll
        for (int ai = 0; ai < 2; ++ai)
#pragma unroll
            for (int m = 0; m < 4; ++m) { const int r = u.pm * 256 + ai * 128 + wr * 64 + m * 16 + fr;
#pragma unroll
                for (int bj = 0; bj < 2; ++bj) { const int c0 = u.pn * 256 + 128 * bj + 32 * wc + 8 * fq;
                    const u32x4 ga = *(const u32x4*)(G + (size_t)r * GW + c0), gb = *(const u32x4*)(G + (size_t)r * GW + DM + c0);
                    f32x4& a = acc[ai][bj][m][0]; f32x4& b = acc[ai][bj][m][1];
#define RAT(x, y) ((x) * __builtin_amdgcn_rcpf(fmaxf((y), 1e-30f)))
                    a[0] *= RAT(bflo(ga.x), bflo(gb.x)); a[1] *= RAT(bfhi(ga.x), bfhi(gb.x)); a[2] *= RAT(bflo(ga.y), bflo(gb.y)); a[3] *= RAT(bfhi(ga.y), bfhi(gb.y));
                    b[0] *= RAT(bflo(ga.z), bflo(gb.z)); b[1] *= RAT(bfhi(ga.z), bfhi(gb.z)); b[2] *= RAT(bflo(ga.w), bflo(gb.w)); b[3] *= RAT(bfhi(ga.w), bfhi(gb.w));
#undef RAT
                } }
    }
    __device__ __forceinline__ void operator()(const f32x4 (&acc)[2][2][4][2], const pg8::Unit& u, int wr, int wc, int fr, int fq) const {
#pragma unroll
        for (int ai = 0; ai < 2; ++ai)
#pragma unroll
            for (int m = 0; m < 4; ++m) { const int r = u.pm * 256 + ai * 128 + wr * 64 + m * 16 + fr;
#pragma unroll
                for (int bj = 0; bj < 2; ++bj) { const int c0 = u.pn * 256 + 128 * bj + 32 * wc + 8 * fq;
                    const u32x4 g = *(const u32x4*)(G + (size_t)r * GW + DM + c0);
                    const f32x4 a = acc[ai][bj][m][0], b = acc[ai][bj][m][1];
                    u32x4 w; w.x = pk2(a[0] * bflo(g.x), a[1] * bfhi(g.x)); w.y = pk2(a[2] * bflo(g.y), a[3] * bfhi(g.y)); w.z = pk2(b[0] * bflo(g.z), b[1] * bfhi(g.z)); w.w = pk2(b[2] * bflo(g.w), b[3] * bfhi(g.w));
                    *(u32x4*)(MIX + (size_t)r * DM + c0) = w; } }
    }
};
struct EpiOut {
    static constexpr bool PERM = true, AFTER_DRAIN = false, TWO_SEG = false, INIT_ACC = true;
    const float* X; float* O;
    __device__ __forceinline__ void init(f32x4 (&acc)[2][2][4][2], const pg8::Unit& u, int wr, int wc, int fr, int fq) const {
#pragma unroll
        for (int ai = 0; ai < 2; ++ai)
#pragma unroll
            for (int m = 0; m < 4; ++m) { const int r = u.pm * 256 + ai * 128 + wr * 64 + m * 16 + fr;
#pragma unroll
                for (int bj = 0; bj < 2; ++bj) { const float* xp = X + (size_t)r * DM + u.pn * 256 + 128 * bj + 32 * wc + 8 * fq;
                    acc[ai][bj][m][0] = __builtin_nontemporal_load((const f32x4*)xp); acc[ai][bj][m][1] = __builtin_nontemporal_load((const f32x4*)(xp + 4)); } }
    }
    __device__ __forceinline__ void operator()(const f32x4 (&acc)[2][2][4][2], const pg8::Unit& u, int wr, int wc, int fr, int fq) const {
#pragma unroll
        for (int ai = 0; ai < 2; ++ai)
#pragma unroll
            for (int m = 0; m < 4; ++m) { const int r = u.pm * 256 + ai * 128 + wr * 64 + m * 16 + fr;
#pragma unroll
                for (int bj = 0; bj < 2; ++bj) { float* op = O + (size_t)r * DM + u.pn * 256 + 128 * bj + 32 * wc + 8 * fq;
                    __builtin_nontemporal_store(acc[ai][bj][m][0], (f32x4*)op); __builtin_nontemporal_store(acc[ai][bj][m][1], (f32x4*)(op + 4)); } }
    }
};

#define MFMA32(a, b, c) __builtin_amdgcn_mfma_f32_32x32x16_bf16(a, b, c, 0, 0, 0)
#define SBAR() __builtin_amdgcn_sched_barrier(0)
typedef short v4i16_t __attribute__((ext_vector_type(4)));
__device__ __forceinline__ int crow(int r, int hi) { return (r & 3) + 8 * (r >> 2) + 4 * hi; }
__device__ __forceinline__ s16x4 vtr(const LAS unsigned char* p) { return __builtin_bit_cast(s16x4, __builtin_amdgcn_ds_read_tr16_b64_v4i16((LAS v4i16_t*)p)); }
__device__ __forceinline__ bf16x8 cat8(s16x4 lo, s16x4 hi) { return (bf16x8){lo[0], lo[1], lo[2], lo[3], hi[0], hi[1], hi[2], hi[3]}; }
__device__ __forceinline__ bf16x8 pack8(const f32x16& p, int b) {
    u32x4 w; w.x = pk2(p[b], p[b + 1]); w.y = pk2(p[b + 2], p[b + 3]); w.z = pk2(p[b + 4], p[b + 5]); w.w = pk2(p[b + 6], p[b + 7]); return __builtin_bit_cast(bf16x8, w); }
constexpr int ATT_SCR = 98304;

#define B_QK_INIT(N0, N1, T) do { float sl_ = slope2; asm volatile("" : "+v"(sl_));     \
    const float tb_ = sl_ * (float)(64 * (T) - (128 * qb + 32 * wq)) + abase; \
    _Pragma("unroll") for (int r = 0; r < 16; ++r) { N0[r] = fmaf(sl_, (float)((r & 3) + 8 * (r >> 2)), tb_); N1[r] = fmaf(sl_, (float)((r & 3) + 8 * (r >> 2) + 32), tb_); } } while (0)
#define B_EXP4(C, B) do { C[B] = fast_exp2(C[B]); C[B + 1] = fast_exp2(C[B + 1]); C[B + 2] = fast_exp2(C[B + 2]); C[B + 3] = fast_exp2(C[B + 3]); } while (0)
#define B_STEP(C0, C1, N0, N1, T) do { \
    const int t_ = (T); const bool has1 = (t_ + 1 <= t1), has2 = (t_ + 2 <= t1), has3 = (t_ + 3 <= t1); \
    const int r0_ = (t_ - t0) % 3, r1_ = (r0_ == 2) ? 0 : r0_ + 1, r2_ = (r1_ == 2) ? 0 : r1_ + 1;     \
    if (has3) { const size_t go = (size_t)(t_ + 3) * 64 * PP; const int kn_ = r0_ * 16384 + w * 1024; GLDS16(k0src + go, lds + kn_); GLDS16(k1src + go, lds + kn_ + 8192); } \
    if (has2) { const size_t go = (size_t)(t_ + 2) * 64 * PP; const int vn_ = 49152 + r2_ * 16384 + vdw; GLDS16(vsrc + go, lds + vn_); GLDS16(vsrc + go + 64, lds + vn_ + 8192); } \
    if (has1) { \
        const LAS unsigned char* kb = lds + r1_ * 16384 + map * 8192; \
        bf16x8 kf[8]; \
        _Pragma("unroll") for (int d0 = 0; d0 < 4; ++d0) { kf[2 * d0] = *(const LAS bf16x8*)(kb + koff[d0]); kf[2 * d0 + 1] = *(const LAS bf16x8*)(kb + koff[d0] + 4096); } \
        B_QK_INIT(N0, N1, t_ + 1); \
        SBAR(); \
        N0 = MFMA32(kf[0], qr[0], N0); B_EXP4(C0, 0); SBAR(); \
        N1 = MFMA32(kf[1], qr[0], N1); B_EXP4(C1, 0); SBAR(); \
        N0 = MFMA32(kf[2], qr[1], N0); B_EXP4(C0, 4); SBAR(); \
        N1 = MFMA32(kf[3], qr[1], N1); B_EXP4(C1, 4); SBAR(); \
        N0 = MFMA32(kf[4], qr[2], N0); B_EXP4(C0, 8); SBAR(); \
        N1 = MFMA32(kf[5], qr[2], N1); B_EXP4(C1, 8); SBAR(); \
        N0 = MFMA32(kf[6], qr[3], N0); B_EXP4(C0, 12); SBAR(); \
        N1 = MFMA32(kf[7], qr[3], N1); B_EXP4(C1, 12); SBAR(); \
    } else { \
        _Pragma("unroll") for (int r = 0; r < 16; ++r) { C0[r] = fast_exp2(C0[r]); C1[r] = fast_exp2(C1[r]); } \
    } \
    const LAS unsigned char* vb = lds + 49152 + r0_ * 16384 + vlane; \
    s16x4 va[8], vc[8];                                             \
    _Pragma("unroll") for (int d = 0; d < 4; ++d) { va[2 * d] = vtr(vb + d * 4096); va[2 * d + 1] = vtr(vb + d * 4096 + 512); } \
    if (t_ == 1 || t_ >= 2 * qb) {                                  \
        _Pragma("unroll") for (int r = 0; r < 16; ++r) { const int k0t = 64 * t_ + crow(r, hi), k1t = k0t + 32; \
            if (k0t > qt || k0t < 112) C0[r] = 0.f; if (k1t > qt || k1t < 112) C1[r] = 0.f; } \
    } \
      \
    const bf16x8 pw0 = pack8(C0, 0); \
    _Pragma("unroll") for (int d = 0; d < 4; ++d) { vc[2 * d] = vtr(vb + d * 4096 + 1024); vc[2 * d + 1] = vtr(vb + d * 4096 + 1536); } \
    SBAR(); \
    o[0] = MFMA32(pw0, cat8(va[0], va[1]), o[0]); o[1] = MFMA32(pw0, cat8(va[2], va[3]), o[1]); \
    o[2] = MFMA32(pw0, cat8(va[4], va[5]), o[2]); o[3] = MFMA32(pw0, cat8(va[6], va[7]), o[3]); \
    const bf16x8 pw1 = pack8(C0, 8); \
    float a_ = ((C0[0] + C0[1]) + (C0[2] + C0[3])) + ((C0[4] + C0[5]) + (C0[6] + C0[7])); \
    SBAR(); \
    _Pragma("unroll") for (int d = 0; d < 4; ++d) { va[2 * d] = vtr(vb + d * 4096 + 2048); va[2 * d + 1] = vtr(vb + d * 4096 + 2560); } \
    o[0] = MFMA32(pw1, cat8(vc[0], vc[1]), o[0]); o[1] = MFMA32(pw1, cat8(vc[2], vc[3]), o[1]); \
    o[2] = MFMA32(pw1, cat8(vc[4], vc[5]), o[2]); o[3] = MFMA32(pw1, cat8(vc[6], vc[7]), o[3]); \
    const bf16x8 pw2 = pack8(C1, 0); \
    a_ += ((C0[8] + C0[9]) + (C0[10] + C0[11])) + ((C0[12] + C0[13]) + (C0[14] + C0[15])); \
    SBAR(); \
    _Pragma("unroll") for (int d = 0; d < 4; ++d) { vc[2 * d] = vtr(vb + d * 4096 + 3072); vc[2 * d + 1] = vtr(vb + d * 4096 + 3584); } \
    o[0] = MFMA32(pw2, cat8(va[0], va[1]), o[0]); o[1] = MFMA32(pw2, cat8(va[2], va[3]), o[1]); \
    o[2] = MFMA32(pw2, cat8(va[4], va[5]), o[2]); o[3] = MFMA32(pw2, cat8(va[6], va[7]), o[3]); \
    const bf16x8 pw3 = pack8(C1, 8); \
    a_ += ((C1[0] + C1[1]) + (C1[2] + C1[3])) + ((C1[4] + C1[5]) + (C1[6] + C1[7])); \
    SBAR(); \
    o[0] = MFMA32(pw3, cat8(vc[0], vc[1]), o[0]); o[1] = MFMA32(pw3, cat8(vc[2], vc[3]), o[1]); \
    o[2] = MFMA32(pw3, cat8(vc[4], vc[5]), o[2]); o[3] = MFMA32(pw3, cat8(vc[6], vc[7]), o[3]); \
    a_ += ((C1[8] + C1[9]) + (C1[10] + C1[11])) + ((C1[12] + C1[13]) + (C1[14] + C1[15])); \
    lsum += a_; \
    SBAR(); \
      \
      \
    if (has3 && has2) asm volatile("s_waitcnt vmcnt(4) lgkmcnt(0)\n\ts_barrier" ::: "memory"); \
    else asm volatile("s_waitcnt vmcnt(0) lgkmcnt(0)\n\ts_barrier" ::: "memory"); \
} while (0)

__device__ __forceinline__ void attn_b_core(const bf16_t* __restrict__ P, float kmax, int b, int h, int qb, int t0, int t1, LAS unsigned char* lds, f32x16 (&o)[4], float& lsum) {
    int tid = threadIdx.x; asm volatile("" : "+v"(tid));
    const int lane = tid & 63, r32 = lane & 31, hi = lane >> 5; const int w = __builtin_amdgcn_readfirstlane(tid >> 6);
    const int map = w >> 2, wq = w & 3;
    const size_t rowbase = (size_t)b * LP;
    const float slope2 = exp2f(-2.0f * (float)(h + 1)) * LOG2E;
    const int krow = 8 * w + (lane >> 3);
    const bf16_t* k0src = P + (rowbase + krow) * PP + 1792 + h * 128 + (((lane & 7) ^ ((krow >> 1) & 7)) << 3);
    const bf16_t* k1src = k0src + 64;
    const bf16_t* vsrc = P + (rowbase + 16 * (w & 3) + (lane >> 2)) * PP + 2304 + h * 128 + (w >> 2) * 32 + (lane & 3) * 8;
    const int vdw = (w >> 2) * 4096 + (w & 3) * 1024;
    int koff[4];
#pragma unroll
    for (int d0 = 0; d0 < 4; ++d0) koff[d0] = r32 * 128 + ((((2 * d0 + hi) ^ ((r32 >> 1) & 7))) << 4);
#define GLDS16(gp, lp) __builtin_amdgcn_global_load_lds((const unsigned*)(gp), (LAS unsigned*)(lp), 16, 0, 0)
    const int qt = 128 * qb + 32 * wq + r32;
    bf16x8 qr[4];
    { const bf16_t* qp = P + (rowbase + qt) * PP + 1280 + h * 128 + map * 64 + 8 * hi;
#pragma unroll
      for (int d0 = 0; d0 < 4; ++d0) qr[d0] = *(const bf16x8*)(qp + 16 * d0); }
    float qss = 0.f;
#pragma unroll
    for (int d0 = 0; d0 < 4; ++d0)
#pragma unroll
        for (int e = 0; e < 8; ++e) { const float f = bf2f((unsigned short)qr[d0][e]); qss += f * f; }
    qss += __shfl_xor(qss, 32);
    const float mrow = sqrtf(qss) * kmax;
    const float abase = -slope2 * (float)(r32 - 4 * hi) - mrow;
#pragma unroll
    for (int d = 0; d < 4; ++d) o[d] = f32x16{};
    lsum = 0.f;
    const int vlane = ((lane >> 4) & 1) * 32 + (lane & 3) * 8 + (4 * hi + ((lane & 15) >> 2)) * 64;
    { const size_t go = (size_t)t0 * 64 * PP, g1 = (size_t)64 * PP;
      GLDS16(k0src + go, lds + w * 1024); GLDS16(k1src + go, lds + 8192 + w * 1024); GLDS16(vsrc + go, lds + 49152 + vdw); GLDS16(vsrc + go + 64, lds + 49152 + vdw + 8192);
      if (t0 + 1 <= t1) { GLDS16(k0src + go + g1, lds + 16384 + w * 1024); GLDS16(k1src + go + g1, lds + 16384 + 8192 + w * 1024);
                          GLDS16(vsrc + go + g1, lds + 49152 + 16384 + vdw); GLDS16(vsrc + go + g1 + 64, lds + 49152 + 16384 + vdw + 8192); }
      if (t0 + 2 <= t1) { GLDS16(k0src + go + 2 * g1, lds + 32768 + w * 1024); GLDS16(k1src + go + 2 * g1, lds + 32768 + 8192 + w * 1024); } }
    asm volatile("s_waitcnt vmcnt(0)" ::: "memory");
    __syncthreads();
    f32x16 sA0, sA1, sB0, sB1;
    { const LAS unsigned char* kb = lds + map * 8192;
      B_QK_INIT(sA0, sA1, t0);
#pragma unroll
      for (int d0 = 0; d0 < 4; ++d0) { const bf16x8 k0 = *(const LAS bf16x8*)(kb + koff[d0]), k1 = *(const LAS bf16x8*)(kb + koff[d0] + 4096);
          sA0 = MFMA32(k0, qr[d0], sA0); sA1 = MFMA32(k1, qr[d0], sA1); } }
    __syncthreads();
    for (int t = t0; t <= t1; t += 2) {
        B_STEP(sA0, sA1, sB0, sB1, t);
        if (t + 1 <= t1) B_STEP(sB0, sB1, sA0, sA1, t + 1);
    }
}
#undef B_STEP
#undef GLDS16
#undef B_EXP4
#undef B_QK_INIT
__device__ __forceinline__ void attn_b_finalize(const bf16_t* __restrict__ P, bf16_t* __restrict__ YB, const float* __restrict__ subln, float lam, int b, int h, int qb, LAS unsigned char* lds, f32x16 (&o)[4], float lsum) {
    int tid = threadIdx.x; asm volatile("" : "+v"(tid));
    const int lane = tid & 63, r32 = lane & 31, hi = lane >> 5; const int w = __builtin_amdgcn_readfirstlane(tid >> 6);
    const int map = w >> 2, wq = w & 3;
    const size_t rowbase = (size_t)b * LP;
    lsum += __shfl_xor(lsum, 32);
    LAS float* scr = (LAS float*)(lds + ATT_SCR) + w * 32;
    { float inv = 1.0f / lsum; if (map == 1) inv *= lam; if (hi == 0) scr[r32] = inv; }
    float rl[16];
#pragma unroll
    for (int r = 0; r < 16; ++r) rl[r] = scr[crow(r, hi)];
#pragma unroll
    for (int d0 = 0; d0 < 4; ++d0)
#pragma unroll
        for (int r = 0; r < 16; ++r) o[d0][r] *= rl[r];
    LAS float* X = (LAS float*)lds;
    if (map == 1) {
#pragma unroll
        for (int d0 = 0; d0 < 4; ++d0)
#pragma unroll
            for (int r = 0; r < 16; ++r) X[((wq * 4 + d0) * 16 + r) * 64 + lane] = o[d0][r];
    }
    __syncthreads();
    LAS unsigned short* Y = (LAS unsigned short*)(lds + 65536);
    if (map == 0) {
        float rn[16];
#pragma unroll
        for (int r = 0; r < 16; ++r) { float ss = 0.f;
#pragma unroll
            for (int d0 = 0; d0 < 4; ++d0) { o[d0][r] -= X[((wq * 4 + d0) * 16 + r) * 64 + lane]; ss += o[d0][r] * o[d0][r]; }
            ss += __shfl_xor(ss, 1); ss += __shfl_xor(ss, 2); ss += __shfl_xor(ss, 4); ss += __shfl_xor(ss, 8); ss += __shfl_xor(ss, 16);
            rn[r] = (1.0f - LAM_INIT) / sqrtf(ss * (1.f / 128.f) + RMS_EPS); }
#pragma unroll
        for (int d0 = 0; d0 < 4; ++d0) { const float sg = subln[32 * d0 + r32];
#pragma unroll
            for (int r = 0; r < 16; ++r) Y[(32 * wq + crow(r, hi)) * 128 + 32 * d0 + r32] = (unsigned short)f2bf(o[d0][r] * rn[r] * sg); }
    }
    __syncthreads();
    { u32x4 yv[4], zv[4];
#pragma unroll
      for (int i = 0; i < 4; ++i) { const int x = tid + 512 * i, row = x >> 4, c = x & 15;
          yv[i] = *(const LAS u32x4*)(Y + row * 128 + c * 8);
          zv[i] = *(const u32x4*)(P + (rowbase + 128 * qb + row) * PP + 2816 + h * 128 + c * 8); }
#pragma unroll
      for (int i = 0; i < 4; ++i) { const int x = tid + 512 * i, row = x >> 4, c = x & 15;
          u32x4 ov; ov.x = pk2(bflo(yv[i].x) * bflo(zv[i].x), bfhi(yv[i].x) * bfhi(zv[i].x)); ov.y = pk2(bflo(yv[i].y) * bflo(zv[i].y), bfhi(yv[i].y) * bfhi(zv[i].y));
          ov.z = pk2(bflo(yv[i].z) * bflo(zv[i].z), bfhi(yv[i].z) * bfhi(zv[i].z)); ov.w = pk2(bflo(yv[i].w) * bflo(zv[i].w), bfhi(yv[i].w) * bfhi(zv[i].w));
          *(u32x4*)(YB + ((size_t)b * SEQ + 128 * (qb - 1) + row) * BW + h * 128 + c * 8) = ov; } }
    __syncthreads();
}

__device__ __forceinline__ void attn_a_unit(const bf16_t* __restrict__ P, bf16_t* __restrict__ YA, const float* __restrict__ sink, float kmax, int b, int kvh, int qb, LAS unsigned char* lds) {
    int tid = threadIdx.x; asm volatile("" : "+v"(tid));
    const int lane = tid & 63, r32 = lane & 31, hi = lane >> 5; const int w = __builtin_amdgcn_readfirstlane(tid >> 6);
    const size_t rowbase = (size_t)b * LP; const int kt0 = 128 * (qb - 1);
    { u32x4 kk[4], vv[4];
#pragma unroll
      for (int j = 0; j < 4; ++j) { kk[j] = *(const u32x4*)(P + (rowbase + kt0 + 64 * j + lane) * PP + 512 + kvh * 64 + w * 8);
                                    vv[j] = *(const u32x4*)(P + (rowbase + kt0 + 64 * j + (tid >> 3)) * PP + 640 + kvh * 64 + (tid & 7) * 8); }
#pragma unroll
      for (int j = 0; j < 4; ++j) { *(LAS u32x4*)(lds + j * 8192 + w * 1024 + lane * 16) = kk[j];
                                    *(LAS u32x4*)(lds + 32768 + j * 8192 + ((tid & 7) >> 2) * 4096 + (tid >> 3) * 64 + (tid & 3) * 16) = vv[j]; } }
    __syncthreads();
    const int g = w >> 1, hq = kvh * 4 + g;
    const float slope2 = exp2f(-(float)(hq + 1)) * LOG2E, sink2 = sink[hq] * LOG2E;
    const int vlane = ((lane >> 4) & 1) * 32 + (lane & 3) * 8 + (4 * hi + ((lane & 15) >> 2)) * 64;
    LAS float* scr = (LAS float*)(lds + ATT_SCR) + w * 32;
    for (int sub = 0; sub < 2; ++sub) {
        const int q0 = 64 * (w & 1) + 32 * sub; const int qrel = 128 + q0 + r32;
        bf16x8 qr[4];
        { const bf16_t* qp = P + (rowbase + kt0 + qrel) * PP + hq * 64 + 8 * hi;
#pragma unroll
          for (int d0 = 0; d0 < 4; ++d0) qr[d0] = *(const bf16x8*)(qp + 16 * d0); }
        float qss = 0.f;
#pragma unroll
        for (int d0 = 0; d0 < 4; ++d0)
#pragma unroll
            for (int e = 0; e < 8; ++e) { const float f = bf2f((unsigned short)qr[d0][e]); qss += f * f; }
        qss += __shfl_xor(qss, 32);
        const float cref = fmaxf(sqrtf(qss) * kmax, sink2);
        f32x16 o[2]; o[0] = f32x16{}; o[1] = f32x16{}; float lsum = 0.f;
        for (int jj = 0; jj < 3; ++jj) { const int j = (w & 1) + jj;
            f32x16 s0, s1;
#pragma unroll
            for (int r = 0; r < 16; ++r) { const int d0_ = qrel - (64 * j + crow(r, hi)); s0[r] = -slope2 * (float)d0_ - cref; s1[r] = -slope2 * (float)(d0_ - 32) - cref; }
            const LAS unsigned char* kb = lds + j * 8192 + hi * 1024 + r32 * 16;
#pragma unroll
            for (int d0 = 0; d0 < 4; ++d0) {
                const bf16x8 k0 = *(const LAS bf16x8*)(kb + d0 * 2048), k1 = *(const LAS bf16x8*)(kb + d0 * 2048 + 512);
                s0 = MFMA32(k0, qr[d0], s0); s1 = MFMA32(k1, qr[d0], s1); }
#pragma unroll
            for (int r = 0; r < 16; ++r) { const int kr = 64 * j + crow(r, hi); const int da = qrel - kr, db = da - 32;
                const float e0 = fast_exp2(s0[r]), e1 = fast_exp2(s1[r]);
                s0[r] = (da >= 0 && da < 128 && kt0 + kr >= 112) ? e0 : 0.f;
                s1[r] = (db >= 0 && db < 128 && kt0 + kr + 32 >= 112) ? e1 : 0.f; }
            { float a = 0.f;
#pragma unroll
              for (int r = 0; r < 16; ++r) a += s0[r] + s1[r];
              lsum += a; }
            const bf16x8 pw0 = pack8(s0, 0), pw1 = pack8(s0, 8), pw2 = pack8(s1, 0), pw3 = pack8(s1, 8);
            const LAS unsigned char* vb = lds + 32768 + j * 8192 + vlane;
#pragma unroll
            for (int d0 = 0; d0 < 2; ++d0) {
                o[d0] = MFMA32(pw0, cat8(vtr(vb + d0 * 4096), vtr(vb + d0 * 4096 + 512)), o[d0]);
                o[d0] = MFMA32(pw1, cat8(vtr(vb + d0 * 4096 + 1024), vtr(vb + d0 * 4096 + 1536)), o[d0]);
                o[d0] = MFMA32(pw2, cat8(vtr(vb + d0 * 4096 + 2048), vtr(vb + d0 * 4096 + 2560)), o[d0]);
                o[d0] = MFMA32(pw3, cat8(vtr(vb + d0 * 4096 + 3072), vtr(vb + d0 * 4096 + 3584)), o[d0]);
            }
        }
        lsum += __shfl_xor(lsum, 32);
        { const float inv = 1.0f / (lsum + fast_exp2(sink2 - cref)); if (hi == 0) scr[r32] = inv; }
        float rl[16];
#pragma unroll
        for (int r = 0; r < 16; ++r) rl[r] = scr[crow(r, hi)];
        LAS unsigned short* Yw = (LAS unsigned short*)(lds + 65536) + w * 2048;
#pragma unroll
        for (int d0 = 0; d0 < 2; ++d0)
#pragma unroll
            for (int r = 0; r < 16; ++r) Yw[crow(r, hi) * 64 + 32 * d0 + r32] = (unsigned short)f2bf(o[d0][r] * rl[r]);
        { u32x4 yv[4], zv[4];
#pragma unroll
          for (int i = 0; i < 4; ++i) { const int row = i * 8 + (lane >> 3), c = lane & 7;
              yv[i] = *(const LAS u32x4*)(Yw + row * 64 + c * 8);
              zv[i] = *(const u32x4*)(P + (rowbase + kt0 + 128 + q0 + row) * PP + 768 + hq * 64 + c * 8); }
#pragma unroll
          for (int i = 0; i < 4; ++i) { const int row = i * 8 + (lane >> 3), c = lane & 7;
              u32x4 ov; ov.x = pk2(bflo(yv[i].x) * bflo(zv[i].x), bfhi(yv[i].x) * bfhi(zv[i].x)); ov.y = pk2(bflo(yv[i].y) * bflo(zv[i].y), bfhi(yv[i].y) * bfhi(zv[i].y));
              ov.z = pk2(bflo(yv[i].z) * bflo(zv[i].z), bfhi(yv[i].z) * bfhi(zv[i].z)); ov.w = pk2(bflo(yv[i].w) * bflo(zv[i].w), bfhi(yv[i].w) * bfhi(zv[i].w));
              *(u32x4*)(YA + ((size_t)b * SEQ + kt0 + q0 + row) * AW + hq * 64 + c * 8) = ov; } }
    }
    __syncthreads();
}

constexpr size_t WS_SLOT = 219 * MiB; constexpr int SLOT_BYTES = 133120, SLOT_MAX = 280;
constexpr int TAB_OFF = 102400;
constexpr int CW_QUEUE = 8192;
__device__ __forceinline__ void unit_decode(int j, int& b, int& h, int& qb) { h = 3 - (j >> 7); const int jj = j & 127; qb = 64 - (jj >> 1); b = jj & 1; }
__device__ __forceinline__ int b_window(int h, float mmax) {
    const float slope2 = exp2f(-2.0f * (float)(h + 1)) * LOG2E;
    const float need = 24.0f + 2.0f * mmax + log2f(1.0f / (slope2 * 0.69314718f));
    const float d = ceilf(need / slope2) + 1.0f;
    return d > 1.0e6f ? 1000000 : (int)d;
}
__device__ __forceinline__ int b_tmin(int qb, int dh) { const int k = 128 * qb - dh; return k < 128 ? 1 : (k >> 6); }
__device__ __forceinline__ void b_store_partial(unsigned char* ws, int slot, const f32x16 (&o)[4], float lsum) {
    int tid = threadIdx.x; asm volatile("" : "+v"(tid));
    const int lane = tid & 63; const int w = __builtin_amdgcn_readfirstlane(tid >> 6);
    float* S = (float*)(ws + WS_SLOT + (size_t)slot * SLOT_BYTES);
#pragma unroll
    for (int d0 = 0; d0 < 4; ++d0)
#pragma unroll
        for (int r = 0; r < 16; ++r) S[((w * 4 + d0) * 16 + r) * 64 + lane] = o[d0][r];
    S[32768 + w * 64 + lane] = lsum;
}
__device__ __forceinline__ void b_load_partials(const unsigned char* ws, int slot0, int nc, f32x16 (&o)[4], float& lsum) {
    int tid = threadIdx.x; asm volatile("" : "+v"(tid));
    const int lane = tid & 63; const int w = __builtin_amdgcn_readfirstlane(tid >> 6);
#pragma unroll
    for (int d = 0; d < 4; ++d) o[d] = f32x16{};
    lsum = 0.f;
    for (int c = 0; c < nc; ++c) { const float* S = (const float*)(ws + WS_SLOT + (size_t)(slot0 + c) * SLOT_BYTES);
#pragma unroll
        for (int d0 = 0; d0 < 4; ++d0)
#pragma unroll
            for (int r = 0; r < 16; ++r) o[d0][r] += S[((w * 4 + d0) * 16 + r) * 64 + lane];
        lsum += S[32768 + w * 64 + lane]; }
}

#define GAS __attribute__((address_space(1)))
typedef GAS unsigned gu32;
typedef GAS unsigned long long gu64;
#define RLX_AGENT __ATOMIC_RELAXED, __HIP_MEMORY_SCOPE_AGENT
#define LDS_WAIT() asm volatile("s_waitcnt lgkmcnt(0)" ::: "memory")
#define VM_WAIT() asm volatile("s_waitcnt vmcnt(0)" ::: "memory")
__device__ __forceinline__ unsigned long long rt() { return __builtin_amdgcn_s_memrealtime(); }
#define XB_TMO      128
#define XB_XCNT(j)  (256  + 64 * (j))
#define XB_XSUB(j)  (1280 + 64 * (j))
#define XB_XGEN(j)  (2304 + 64 * (j))
#define XB_TOP      3328
#define XB_TOPGEN   3392
#define XCD_BAR_WORDS 3456
#define XB_SPIN_CAP (1u << 18)

__device__ __forceinline__ unsigned xb_ld(unsigned* p)              { return __hip_atomic_load(p, __ATOMIC_RELAXED, __HIP_MEMORY_SCOPE_AGENT); }
__device__ __forceinline__ unsigned xb_add(unsigned* p, unsigned v) { return __hip_atomic_fetch_add(p, v, __ATOMIC_RELAXED, __HIP_MEMORY_SCOPE_AGENT); }
__device__ __forceinline__ unsigned xb_xcc_id() { return (unsigned)__builtin_amdgcn_s_getreg((3 << 11) | 20) & 0xFu; }
#define XB_SPIN(cond, bar) do { unsigned _sp = 0; while (cond) { __builtin_amdgcn_s_sleep(1); \
    if ((++_sp & 255u) == 0u) { if (xb_ld(&(bar)[XB_TMO])) break; if (_sp > XB_SPIN_CAP) { atomicAdd(&(bar)[XB_TMO], 1u); break; } } } } while (0)

struct XcdBarrier {
    unsigned* bar; unsigned x;
    volatile LAS unsigned* st;
};

__device__ __forceinline__ XcdBarrier xcd_barrier_post(unsigned* bar, volatile LAS unsigned* st) {
    XcdBarrier b; b.bar = bar; b.x = xb_xcc_id(); b.st = st;
    if (threadIdx.x == 0) (void)xb_add(&bar[XB_XCNT(b.x)], 1u);
    return b;
}
__device__ __forceinline__ void xcd_barrier_complete(unsigned* bar, unsigned x, unsigned& nloc, unsigned& nx) {
    const unsigned G = gridDim.x * gridDim.y * gridDim.z;
    unsigned sum, cnt, mine, sp = 0u;
    for (;;) {
        sum = 0u; cnt = 0u; mine = 0u;
#pragma unroll
        for (unsigned j = 0; j < 16; ++j) { const unsigned c = xb_ld(&bar[XB_XCNT(j)]); sum += c; cnt += (c > 0u) ? 1u : 0u; mine = (j == x) ? c : mine; }
        if (sum == G) break;
        __builtin_amdgcn_s_sleep(1);
        if ((++sp & 255u) == 0u) { if (xb_ld(&bar[XB_TMO])) break; if (sp > XB_SPIN_CAP) { atomicAdd(&bar[XB_TMO], 1u); break; } }
    }
    nloc = mine > 0u ? mine : 1u; nx = cnt > 0u ? cnt : 1u;
}

__device__ __forceinline__ void xcd_barrier(const XcdBarrier& b) {
    asm volatile("s_waitcnt vmcnt(0)" ::: "memory");
    __syncthreads();
    if (threadIdx.x == 0) {
        unsigned* bar = b.bar;
        __builtin_amdgcn_s_waitcnt(0);
        unsigned nloc = b.st[0], nx = b.st[1];
        if (nloc == 0u) { xcd_barrier_complete(bar, b.x, nloc, nx); b.st[0] = nloc; b.st[1] = nx; }
        const unsigned old = xb_add(&bar[XB_XSUB(b.x)], 1u);
        const unsigned gen = old / nloc;
        if (old + 1u == (gen + 1u) * nloc) {
            __builtin_amdgcn_fence(__ATOMIC_RELEASE, "agent");
            asm volatile("s_waitcnt vmcnt(0)" ::: "memory");
            const unsigned og = xb_add(&bar[XB_TOP], 1u);
            const unsigned tg = og / nx;
            if (og + 1u == (tg + 1u) * nx) xb_add(&bar[XB_TOPGEN], 1u);
            else XB_SPIN(xb_ld(&bar[XB_TOPGEN]) == tg, bar);
            __builtin_amdgcn_fence(__ATOMIC_ACQUIRE, "agent");
            xb_add(&bar[XB_XGEN(b.x)], 1u);
            asm volatile("s_waitcnt vmcnt(0)" ::: "memory");
        } else {
            XB_SPIN(xb_ld(&bar[XB_XGEN(b.x)]) == gen, bar);
            __builtin_amdgcn_fence(__ATOMIC_ACQUIRE, "agent");
            asm volatile("s_waitcnt vmcnt(0)" ::: "memory");
        }
    }
    __syncthreads();
}

struct Args { const float* in[17]; float* out; unsigned char* ws; int ph_lo, ph_hi; };

__global__ void __launch_bounds__(NWAVES * 64, 2) hybrid_fwd(Args args) {
    extern __shared__ __attribute__((aligned(16))) unsigned char lds_raw[];
    LAS unsigned char* lds = (LAS unsigned char*)lds_raw;
    cg::grid_group grid = cg::this_grid();
    const int tid = threadIdx.x, lane = tid & 63; const int wave = __builtin_amdgcn_readfirstlane(tid >> 6);
    const int G = gridDim.x; const int bx = blockIdx.x; const int vcu = (G % 8 == 0) ? (bx % 8) * (G / 8) + bx / 8 : bx;
    unsigned char* ws = args.ws;
    bf16_t* WinT = (bf16_t*)(ws + WS_WIN); bf16_t* WuaT = (bf16_t*)(ws + WS_WUA); bf16_t* WubT = (bf16_t*)(ws + WS_WUB); bf16_t* WoT = (bf16_t*)(ws + WS_WO);
    bf16_t* XN = (bf16_t*)(ws + WS_XN);
    bf16_t* YA = (bf16_t*)args.out; bf16_t* YB = YA + (size_t)MTOK * AW;
    bf16_t* Pb = (bf16_t*)(ws + WS_P); float* T = (float*)(ws + WS_T); bf16_t* MIX = (bf16_t*)(ws + WS_MIX); bf16_t* Gt = (bf16_t*)(ws + WS_G);
    const int lo = args.ph_lo, hi = args.ph_hi;
    volatile LAS unsigned* bst = (volatile LAS unsigned*)(lds + 131072 + 352);
    if (tid < 2) bst[tid] = 0u;
    __syncthreads();
    XcdBarrier bar = xcd_barrier_post((unsigned*)ws + 4096, bst);
    if (hi > 1000) grid.sync();
#define IN(k) (lo <= (k) && (k) < hi)
#define SEAM(k) do { if (IN(k) && IN((k) + 1)) xcd_barrier(bar); } while (0)

    if (IN(0)) {
        LAS float* scr = (LAS float*)(lds + wave * 16384);
        const int gw = vcu * NWAVES + wave, NGW = G * NWAVES;
        constexpr int I_IN = (DM / 64) * (NIN / 32), I_UP = (AW / 64) * (DM / 32), I_O = (DM / 64) * (DM / 32);
        constexpr int NITEMS = I_IN + 2 * I_UP + I_O;
        for (int it = gw; it < NITEMS; it += NGW) {
            int r = it;
            if (r < I_IN) { p0_transpose_item<true>(args.in[3], DM, NIN, WinT, scr, r, lane); continue; } r -= I_IN;
            if (r < I_UP) { p0_transpose_item<false>(args.in[14], AW, DM, WuaT, scr, r, lane); continue; } r -= I_UP;
            if (r < I_UP) { p0_transpose_item<false>(args.in[15], BW, DM, WubT, scr, r, lane); continue; } r -= I_UP;
            p0_transpose_item<false>(args.in[16], DM, DM, WoT, scr, r, lane);
        }
        for (int m = gw; m < M1; m += 2 * NGW) {
            const int m2 = m + NGW; const bool has2 = (m2 < M1);
            const float* s0 = (m < MTOK) ? args.in[0] + (size_t)m * DM : ((m < MTOK + 16) ? args.in[1] + (size_t)(m - MTOK) * DM : nullptr);
            const float* s1 = !has2 ? nullptr : (m2 < MTOK) ? args.in[0] + (size_t)m2 * DM : ((m2 < MTOK + 16) ? args.in[1] + (size_t)(m2 - MTOK) * DM : nullptr);
            rms_rows2_to_bf16(s0, s1, args.in[2], XN + (size_t)m * DM, has2 ? XN + (size_t)m2 * DM : nullptr, lane);
        }
    }
    SEAM(0);
    const int p1_full = pg8::InOrder::NUNITS / G;
    const bool p1_split = (p1_full * G >= pg8::InOrder::NNG + pg8::InOrder::NMETA) && (pg8::InOrder::NUNITS % G != 0);
    if (IN(1)) {
        pg8::Gemm g{XN, WinT, M1, NIN, DM}; pg8::InOrder S{G, bx, 0, p1_split ? p1_full * G : pg8::InOrder::NUNITS};
        EpiIn E{Pb, Gt, args.in[4], args.in[5], args.in[7], args.in[8]};
        pg8::gemm_phase<EpiIn, pg8::InOrder, PG8_ALIGN, PG8_SP2>(lds, g, S, E);
    }
    SEAM(1);
    if (IN(2) && p1_split) {
        pg8::Gemm g{XN, WinT, M1, NIN, DM}; pg8::InOrder S{G, bx, p1_full, pg8::InOrder::NUNITS};
        EpiIn E{Pb, Gt, args.in[4], args.in[5], args.in[7], args.in[8]};
        pg8::gemm_phase<EpiIn, pg8::InOrder, PG8_ALIGN, PG8_SP2>(lds, g, S, E);
    }
    if (IN(2)) {
#define SCAL(x) __builtin_bit_cast(float, __builtin_amdgcn_readfirstlane(__builtin_bit_cast(int, (x))))
        const float knB = wave_max(fabsf(args.in[8][lane])), qnB = wave_max(fabsf(args.in[7][lane]));
        const float kmaxB = SCAL(8.0f * 1.02f * knB);
        const float kmaxA = SCAL(8.0f * 1.02f * wave_max(fabsf(args.in[5][lane])));
        const float lam = SCAL(__expf(wave_sum(args.in[9][lane] * args.in[10][lane])) - __expf(wave_sum(args.in[11][lane] * args.in[12][lane])) + LAM_INIT);
        const float mmaxB = SCAL(qnB * LOG2E * 1.02f * kmaxB);
        LAS int* incl = (LAS int*)(lds + TAB_OFF); LAS int* sincl = incl + 512; LAS int* order = sincl + 512; LAS int* keys = order + 512; LAS int* misc = keys + 512;
        int C = 1 << 20, myn, mync;
        { int ub, uh, uqb; unit_decode(tid, ub, uh, uqb); myn = 2 * uqb + 2 - b_tmin(uqb, b_window(uh, mmaxB)); }
        {
#pragma unroll 1
            for (int ci = 0; ci < 7; ++ci) {
                const int cd = ci < 4 ? 44 + 4 * ci : (ci == 4 ? 64 : (ci == 5 ? 88 : 176));
                const int nc_ = (myn + cd - 1) / cd;
                int v = nc_ > 1 ? nc_ : 0;
#pragma unroll
                for (int o_ = 1; o_ < 64; o_ <<= 1) v += __shfl_xor(v, o_);
                if (lane == 0) misc[8 + wave] = v;
                __syncthreads();
                int tot = 0;
#pragma unroll
                for (int k = 0; k < 8; ++k) tot += misc[8 + k];
                __syncthreads();
                if (tot <= SLOT_MAX) { C = cd; break; }
            }
        }
        {
            mync = (myn + C - 1) / C;
            const int myper = (myn + mync - 1) / mync, mykey = myper * 512 + (511 - tid);
            keys[tid] = mykey;
            __syncthreads();
            int rank = 0;
            for (int k = 0; k < 128; ++k) { const u32x4 kv = ((const LAS u32x4*)keys)[k]; rank += ((int)kv.x > mykey ? 1 : 0) + ((int)kv.y > mykey ? 1 : 0) + ((int)kv.z > mykey ? 1 : 0) + ((int)kv.w > mykey ? 1 : 0); }
            order[rank] = tid; incl[rank] = mync; sincl[rank] = mync > 1 ? mync : 0;
            __syncthreads();
            for (int d = 1; d < 512; d <<= 1) { const int a = tid >= d ? incl[tid - d] : 0, c = tid >= d ? sincl[tid - d] : 0; __syncthreads(); incl[tid] += a; sincl[tid] += c; __syncthreads(); }
        }
        const int NI = incl[511];
        unsigned* qctr = (unsigned*)ws + CW_QUEUE;
        for (;;) {
            if (tid == 0) misc[0] = (int)__hip_atomic_fetch_add(qctr, 1u, __ATOMIC_RELAXED, __HIP_MEMORY_SCOPE_AGENT);
            __syncthreads();
            const int it = misc[0];
            __syncthreads();
            if (it >= NI + 256) break;
            if (it < NI) {
                int lo_ = 0, hi_ = 511;
                while (lo_ < hi_) { const int mid = (lo_ + hi_) >> 1; if (incl[mid] > it) hi_ = mid; else lo_ = mid + 1; }
                const int p = lo_, jn = incl[p] - (p ? incl[p - 1] : 0), c = it - (incl[p] - jn);
                int ub, uh, uqb; unit_decode(order[p], ub, uh, uqb);
                const int tmin = b_tmin(uqb, b_window(uh, mmaxB)), n = 2 * uqb + 2 - tmin, per = (n + jn - 1) / jn;
                const int t0 = tmin + c * per, t1 = min(t0 + per - 1, 2 * uqb + 1);
                f32x16 o[4]; float lsum;
                attn_b_core(Pb, kmaxB, ub, uh, uqb, t0, t1, lds, o, lsum);
                if (jn == 1) attn_b_finalize(Pb, YB, args.in[13], lam, ub, uh, uqb, lds, o, lsum);
                else b_store_partial(ws, sincl[p] - jn + c, o, lsum);
            } else {
                const int au = it - NI, bk = au >> 6;
                attn_a_unit(Pb, YA, args.in[6], kmaxA, bk >> 1, bk & 1, 1 + (au & 63), lds);
            }
        }
        if (sincl[511] > 0) {
            xcd_barrier(bar);
            for (int p = bx; p < 512; p += G) {
                const int jn = incl[p] - (p ? incl[p - 1] : 0);
                if (jn > 1) { int ub, uh, uqb; unit_decode(order[p], ub, uh, uqb);
                    f32x16 o[4]; float lsum;
                    b_load_partials(ws, sincl[p] - jn, jn, o, lsum);
                    attn_b_finalize(Pb, YB, args.in[13], lam, ub, uh, uqb, lds, o, lsum); }
            }
        }
    }
    SEAM(2);
    if (IN(3)) {
        pg8::Gemm g{YA, WuaT, MTOK, DM, AW, YB, WubT}; pg8::StaticOrder2 S; S.init(MTOK, DM, G, bx); EpiUp E{Gt, MIX};
        pg8::gemm_phase<EpiUp, pg8::StaticOrder2, PG8_ALIGN, PG8_SP2>(lds, g, S, E);
    }
    SEAM(3);
    if (IN(4)) {
        pg8::Gemm g{MIX, WoT, MTOK, DM, DM}; pg8::StaticOrder S; S.init(MTOK, DM, G, bx); EpiOut E{args.in[0], args.out};
        pg8::gemm_phase<EpiOut, pg8::StaticOrder, PG8_ALIGN, PG8_SP2>(lds, g, S, E);
    }
#undef IN
#undef SEAM
}

extern "C" void kernel_launch(void* const* d_in, const int* in_sizes, int n_in, void* d_out, int out_size, void* d_ws, size_t ws_size, hipStream_t stream) {
    static int grid = 0;
    if (grid == 0) {
        if (n_in != 17 || ws_size < WS_END) { fprintf(stderr, "kernel_launch: unexpected inputs (n_in %d, ws %zu)\n", n_in, ws_size); grid = -1; return; }
        int dev = 0, cus = 0, per_cu = 0;
        hipGetDevice(&dev); hipDeviceGetAttribute(&cus, hipDeviceAttributeMultiprocessorCount, dev);
        if (hipFuncSetAttribute((const void*)hybrid_fwd, hipFuncAttributeMaxDynamicSharedMemorySize, LDS_BYTES) != hipSuccess) { fprintf(stderr, "kernel_launch: hipFuncSetAttribute failed\n"); grid = -1; return; }
        if (hipOccupancyMaxActiveBlocksPerMultiprocessor(&per_cu, (const void*)hybrid_fwd, NWAVES * 64, LDS_BYTES) != hipSuccess || per_cu < 1) { fprintf(stderr, "kernel_launch: occupancy query says %d\n", per_cu); per_cu = 1; }
        (void)hipGetLastError();
        grid = cus * 1;
        if (grid <= 0) grid = 256;
    }
    if (grid < 0) return;
    if (hipMemsetAsync(d_ws, 0, 65536, stream) != hipSuccess) { fprintf(stderr, "kernel_launch: memset failed\n"); return; }
    Args a{};
    for (int i = 0; i < 17; ++i) a.in[i] = (const float*)d_in[i];
    a.out = (float*)d_out; a.ws = (unsigned char*)d_ws;
#if MK_SPLIT
    for (int p = 0; p < 5; ++p) { a.ph_lo = p; a.ph_hi = p + 1; void* kargs[] = {&a};
        hipError_t e = hipLaunchCooperativeKernel((const void*)hybrid_fwd, dim3(grid), dim3(NWAVES * 64), kargs, LDS_BYTES, stream);
        if (e != hipSuccess) fprintf(stderr, "kernel_launch: launch %d failed: %s\n", p, hipGetErrorString(e)); }
#else
    a.ph_lo = 0; a.ph_hi = 5; void* kargs[] = {&a};
    hipError_t e = hipLaunchCooperativeKernel((const void*)hybrid_fwd, dim3(grid), dim3(NWAVES * 64), kargs, LDS_BYTES, stream);
    if (e != hipSuccess) fprintf(stderr, "kernel_launch: cooperative launch failed: %s (grid %d)\n", hipGetErrorString(e), grid);
#endif
}
```

```cpp
#include <hip/hip_cooperative_groups.h>
#include <hip/hip_runtime.h>
#include <cstdio>
#include <cstdint>
namespace pg8 {
#define PG8_LAS __attribute__((address_space(3)))
typedef unsigned short bf16_t;
typedef short bf16x8 __attribute__((ext_vector_type(8)));
typedef float f32x4 __attribute__((ext_vector_type(4)));
typedef unsigned u32x4 __attribute__((ext_vector_type(4)));
constexpr int BM = 256, BK = 64, HALF = 128, HTB = HALF * BK * 2  , STAGE_BYTES = 8 * HTB, NXCD = 8, WGM = 8;

__host__ __device__ __forceinline__ int lds_byte(int r, int c) { const int st = (r >> 4) * 2 + (c >> 5), rr = r & 15, cc = c & 31, ob = rr * 64 + cc * 2; return st * 1024 + (ob ^ (((ob >> 9) & 1) << 5)); }
__host__ __device__ __forceinline__ void stage_rc(int b, int& R, int& C) { const int st = b / 1024, sb = b % 1024, swz = sb ^ (((sb >> 9) & 1) << 5); R = (st >> 1) * 16 + swz / 64; C = (st & 1) * 32 + (swz % 64) / 2; }
__host__ __device__ __forceinline__ int perm32(int rho) { const int n = rho >> 4, i = rho & 15; return 8 * (i >> 2) + 4 * n + (i & 3); }

struct Unit { int pm, pn, seg; };
struct Gemm { const bf16_t* A; const bf16_t* Bt; int M, N, K; const bf16_t* A2; const bf16_t* Bt2; };

struct StaticOrder {
    int nM, nN, nwg, G, c;
    __host__ __device__ void init(int M, int N, int G_, int c_) { nM = M / BM; nN = N / BM; nwg = nM * nN; G = G_; c = c_; }
    __host__ __device__ bool next(int i, Unit& u) const {
        const long L = (long)i * G + c; if (L >= nwg) return false;
        int wgid = (int)L; { const int q = nwg / NXCD, r = nwg % NXCD, xcd = wgid % NXCD, off = wgid / NXCD; wgid = (xcd < r ? xcd * (q + 1) : r * (q + 1) + (xcd - r) * q) + off; }
        const int nig = WGM * nN, gid = wgid / nig, fm = gid * WGM, gsz = (nM - fm) < WGM ? (nM - fm) : WGM;
        u.pm = fm + ((wgid % nig) % gsz); u.pn = (wgid % nig) / gsz; u.seg = 0; return true;
    }
    __device__ __forceinline__ void a_ready(const Unit&) const {}
    __device__ __forceinline__ void done(const Unit&) const {}
};

struct InOrder { int G, c, i0, lim;
    static constexpr int NNG = 832, NMETA = 13, NGATE = 512, NUNITS = NNG + NMETA + NGATE;
    __host__ __device__ bool next(int i, Unit& u) const {
        const int L = (i + i0) * G + c; if (L >= lim) return false;
        u.seg = 0;
        if (L < NNG) { const int x = L & 7, k = L >> 3; u.pn = k >> 3; u.pm = x + 8 * (k & 7); }
        else if (L < NNG + NMETA) { u.pm = 64; u.pn = L - NNG; }
        else { const int L2 = L - (NNG + NMETA) + 5; const int x = L2 & 7; int k = L2 >> 3; if (k == 64) k = 0; u.pn = 13 + (k >> 3); u.pm = x + 8 * (k & 7); }
        return true;
    }
    __device__ __forceinline__ void a_ready(const Unit&) const {}
    __device__ __forceinline__ void done(const Unit&) const {}
};
struct StaticOrder2 { StaticOrder base;
    __host__ __device__ void init(int M, int N, int G_, int c_) { base.init(M, N, G_, c_); }
    __host__ __device__ bool next(int i, Unit& u) const { if (!base.next(i >> 1, u)) return false; u.seg = i & 1; return true; }
    __device__ __forceinline__ void a_ready(const Unit&) const {}
    __device__ __forceinline__ void done(const Unit&) const {}
};
__device__ __forceinline__ unsigned cvt_pk_bf16(float lo, float hi) { unsigned r; asm volatile("v_cvt_pk_bf16_f32 %0, %1, %2" : "=v"(r) : "v"(lo), "v"(hi)); return r; }
typedef float f32x2 __attribute__((ext_vector_type(2)));
__device__ __forceinline__ f32x2 gelu_pk(f32x2 v) {
    const f32x2 av = __builtin_elementwise_abs(v), d = av * 0.2316418882f + 1.0f;
    f32x2 t; t.x = __builtin_amdgcn_rcpf(d.x); t.y = __builtin_amdgcn_rcpf(d.y);
    f32x2 q = t * 0.5307027145f + (-0.7265760135f); q = q * t + 0.7107068705f; q = q * t + (-0.142248368f); q = q * t + 0.127414796f; q = q * t;
    const f32x2 s = (v * v) * (-0.72134752044f);
    f32x2 e; e.x = __builtin_amdgcn_exp2f(s.x); e.y = __builtin_amdgcn_exp2f(s.y);
    const f32x2 m = v * (q * e), r = v - m;
    f32x2 o; o.x = v.x < 0.f ? m.x : r.x; o.y = v.y < 0.f ? m.y : r.y; return o;
}

template <int ACT  > struct EpiBf16 {
    static constexpr bool PERM = true, AFTER_DRAIN = false, TWO_SEG = false, INIT_ACC = false; static_assert(ACT == 0 || ACT == 1, "EpiBf16: ACT is 0 (none) or 1 (gelu_pk)");
    bf16_t* O; int ldc; const float* bias; int split_cols; size_t split_stride; float scale0;
    __device__ __forceinline__ void operator()(const f32x4 (&acc)[2][2][4][2], const Unit& u, int wr, int wc, int fr, int fq) const {
        const int row0 = u.pm * BM + wr * 64 + fr; int colt = u.pn * BM; bf16_t* base = O;
        float sc = 1.f; if (split_cols) { const int t = colt / split_cols; base += (size_t)t * split_stride; colt -= t * split_cols; if (t == 0) sc = scale0; }
        const int col0 = colt + wc * 32 + 8 * fq, bcol0 = u.pn * BM + wc * 32 + 8 * fq;
        f32x4 bv[2][2];
#pragma unroll
        for (int bj = 0; bj < 2; ++bj)
#pragma unroll
            for (int n = 0; n < 2; ++n) bv[bj][n] = bias ? *(const f32x4*)(bias + bcol0 + bj * HALF + 4 * n) : (f32x4){0.f, 0.f, 0.f, 0.f};
#pragma unroll
        for (int ai = 0; ai < 2; ++ai)
#pragma unroll
            for (int m = 0; m < 4; ++m) { bf16_t* rowp = base + (size_t)(row0 + ai * HALF + m * 16) * ldc + col0;
#pragma unroll
                for (int bj = 0; bj < 2; ++bj) { f32x4 v0 = acc[ai][bj][m][0] + bv[bj][0], v1 = acc[ai][bj][m][1] + bv[bj][1];
                    if (ACT == 1) { f32x2 a = gelu_pk((f32x2){v0[0], v0[1]}), b = gelu_pk((f32x2){v0[2], v0[3]}), c = gelu_pk((f32x2){v1[0], v1[1]}), d = gelu_pk((f32x2){v1[2], v1[3]});
                        v0 = (f32x4){a.x, a.y, b.x, b.y}; v1 = (f32x4){c.x, c.y, d.x, d.y}; }
                    v0 = v0 * sc; v1 = v1 * sc; u32x4 w; w.x = cvt_pk_bf16(v0[0], v0[1]); w.y = cvt_pk_bf16(v0[2], v0[3]); w.z = cvt_pk_bf16(v1[0], v1[1]); w.w = cvt_pk_bf16(v1[2], v1[3]);
                    *(u32x4*)(rowp + bj * HALF) = w; } }
    }
};

template <class Epi, class Sched, bool ALIGN_EPI = false, bool SP2 = false>
__device__ __forceinline__ void gemm_phase(PG8_LAS unsigned char* lds, const Gemm g, const Sched& S, const Epi& E) {
    const int tid = threadIdx.x, wid = __builtin_amdgcn_readfirstlane(tid >> 6), lane = tid & 63, wr = wid >> 2, wc = wid & 3, fr = lane & 15, fq = lane >> 4;
    const int K = g.K, nt = K / BK;
    unsigned voffA[2], voffB[2];
#pragma unroll
    for (int i = 0; i < 2; ++i) { int R, C; stage_rc(tid * 16 + i * 8192, R, C); const int Rb = Epi::PERM ? ((R & ~31) + perm32(R & 31)) : R;
        voffA[i] = (unsigned)(R * K + C) * 2u; voffB[i] = (unsigned)(Rb * K + C) * 2u; }
    const size_t kstep = (size_t)(BK * 2);
    const size_t hstep = (size_t)HALF * K * 2;
    const size_t tstep = 2 * hstep;
    const unsigned ldsw = (unsigned)wid * 1024u;
    const int aoff = lds_byte(wr * 64 + fr, fq * 8), boff = lds_byte(wc * 32 + fr, fq * 8);
#define PG8_SA(b, h) (((b) * 2 + (h)) * HTB)
#define PG8_SB(b, h) ((4 + (b) * 2 + (h)) * HTB)
#define PG8_STAGE(bufoff, gbase, voff) do { _Pragma("unroll") for (int _i = 0; _i < 2; ++_i) \
        __builtin_amdgcn_global_load_lds((const unsigned*)((const char*)(gbase) + (voff)[_i]), (PG8_LAS unsigned*)(lds + (bufoff) + ldsw + _i * 8192), 16, 0, 0); } while (0)
#define PG8_LDA(dst, b, h) do { _Pragma("unroll") for (int m = 0; m < 4; ++m) _Pragma("unroll") for (int k = 0; k < 2; ++k) dst[m][k] = *(const PG8_LAS bf16x8*)(lds + PG8_SA(b, h) + aoff + m * 2048 + k * 1024); } while (0)
#define PG8_LDB(dst, b, h) do { _Pragma("unroll") for (int n = 0; n < 2; ++n) _Pragma("unroll") for (int k = 0; k < 2; ++k) dst[n][k] = *(const PG8_LAS bf16x8*)(lds + PG8_SB(b, h) + boff + n * 2048 + k * 1024); } while (0)
#define PG8_MMA(ai, bj, At, Bt) do { __builtin_amdgcn_s_setprio(1); _Pragma("unroll") for (int m = 0; m < 4; ++m) _Pragma("unroll") for (int n = 0; n < 2; ++n) _Pragma("unroll") for (int k = 0; k < 2; ++k) \
        acc[ai][bj][m][n] = __builtin_amdgcn_mfma_f32_16x16x32_bf16(Bt[n][k], At[m][k], acc[ai][bj][m][n], 0, 0, 0); __builtin_amdgcn_s_setprio(0); } while (0)
#define PG8_WAIT_V(n) asm volatile("s_waitcnt vmcnt(" #n ")" ::: "memory")
#define PG8_WAIT_L(n) asm volatile("s_waitcnt lgkmcnt(" #n ")" ::: "memory")
#define PG8_BAR __builtin_amdgcn_s_barrier()
#define PG8_SCHED __builtin_amdgcn_sched_barrier(0)
    Unit cur, nxt; int ui = 0;
    if (!S.next(0, cur)) return;
    f32x4 acc[2][2][4][2];
    if constexpr (Epi::INIT_ACC) E.init(acc, cur, wr, wc, fr, fq);
    else
#pragma unroll
    for (int a = 0; a < 2; ++a)
#pragma unroll
        for (int b = 0; b < 2; ++b)
#pragma unroll
            for (int m = 0; m < 4; ++m)
#pragma unroll
                for (int n = 0; n < 2; ++n) acc[a][b][m][n] = (f32x4){0.f, 0.f, 0.f, 0.f};
    bf16x8 At[4][2], B0[2][2], B1[2][2];
    const char* cA = (const char*)(cur.seg ? g.A2 : g.A) + (size_t)cur.pm * tstep; const char* cB = (const char*)(cur.seg ? g.Bt2 : g.Bt) + (size_t)cur.pn * tstep;
    S.a_ready(cur);
    if constexpr (SP2) {
        PG8_STAGE(PG8_SB(0, 0), cB, voffB); PG8_STAGE(PG8_SB(0, 1), cB + hstep, voffB); PG8_STAGE(PG8_SA(0, 0), cA, voffA); PG8_STAGE(PG8_SA(0, 1), cA + hstep, voffA);
        if (wr == 1) PG8_BAR;
        PG8_WAIT_V(2); PG8_BAR;
        PG8_STAGE(PG8_SB(1, 0), cB + kstep, voffB); PG8_STAGE(PG8_SA(1, 0), cA + kstep, voffA); PG8_STAGE(PG8_SB(1, 1), cB + hstep + kstep, voffB);
        PG8_WAIT_V(6); PG8_BAR;
    } else {
        PG8_STAGE(PG8_SB(0, 0), cB, voffB); PG8_STAGE(PG8_SA(0, 0), cA, voffA); PG8_STAGE(PG8_SB(0, 1), cB + hstep, voffB); PG8_STAGE(PG8_SA(0, 1), cA + hstep, voffA);
        if (wr == 1) PG8_BAR;
        PG8_WAIT_V(4); PG8_BAR;
        PG8_STAGE(PG8_SB(1, 0), cB + kstep, voffB); PG8_STAGE(PG8_SA(1, 0), cA + kstep, voffA); PG8_STAGE(PG8_SB(1, 1), cB + hstep + kstep, voffB);
        PG8_WAIT_V(6); PG8_BAR;
    }
    for (;;) {
        const bool has_next = S.next(ui + 1, nxt);
        const char* nA = has_next ? (const char*)(nxt.seg ? g.A2 : g.A) + (size_t)nxt.pm * tstep : cA; const char* nB = has_next ? (const char*)(nxt.seg ? g.Bt2 : g.Bt) + (size_t)nxt.pn * tstep : cB;
        for (int t = 0; t < nt; t += 2) {
            const bool last = (t == nt - 2);
            const char* a1 = cA + (size_t)(t + 1) * kstep;
            const char* a2 = last ? nA : cA + (size_t)(t + 2) * kstep; const char* b2 = last ? nB : cB + (size_t)(t + 2) * kstep;
            const char* a3 = a2 + kstep; const char* b3 = b2 + kstep;
            if (last && has_next) S.a_ready(nxt);
            if constexpr (SP2) {
            PG8_LDB(B0, 0, 0); PG8_LDB(B1, 0, 1); PG8_SCHED; PG8_LDA(At, 0, 0); PG8_STAGE(PG8_SA(1, 1), a1 + hstep, voffA);
            PG8_WAIT_V(8); PG8_WAIT_L(0); PG8_BAR; PG8_MMA(0, 0, At, B0); PG8_MMA(0, 1, At, B1); PG8_BAR; PG8_SCHED;
            PG8_LDA(At, 0, 1); PG8_STAGE(PG8_SB(0, 0), b2, voffB); PG8_STAGE(PG8_SB(0, 1), b2 + hstep, voffB); PG8_STAGE(PG8_SA(0, 0), a2, voffA);
            PG8_WAIT_V(8); PG8_WAIT_L(0); PG8_BAR; PG8_MMA(1, 0, At, B0); PG8_MMA(1, 1, At, B1); PG8_BAR; PG8_SCHED;
            PG8_LDB(B0, 1, 0); PG8_LDB(B1, 1, 1); PG8_SCHED; PG8_LDA(At, 1, 0); PG8_STAGE(PG8_SA(0, 1), a2 + hstep, voffA);
            PG8_WAIT_V(8); PG8_WAIT_L(0); PG8_BAR; PG8_MMA(0, 0, At, B0); PG8_MMA(0, 1, At, B1); PG8_BAR; PG8_SCHED;
            PG8_LDA(At, 1, 1); PG8_STAGE(PG8_SB(1, 0), b3, voffB); PG8_STAGE(PG8_SB(1, 1), b3 + hstep, voffB); PG8_STAGE(PG8_SA(1, 0), a3, voffA);
            PG8_WAIT_V(8); PG8_WAIT_L(0); PG8_BAR; PG8_MMA(1, 0, At, B0); PG8_MMA(1, 1, At, B1); PG8_BAR; PG8_SCHED;
            } else {
            PG8_LDB(B0, 0, 0); PG8_SCHED; PG8_LDA(At, 0, 0); PG8_STAGE(PG8_SA(1, 1), a1 + hstep, voffA);
            PG8_WAIT_L(8); PG8_BAR; PG8_WAIT_L(0); PG8_MMA(0, 0, At, B0); PG8_BAR; PG8_SCHED;
            PG8_LDB(B1, 0, 1); PG8_STAGE(PG8_SB(0, 0), b2, voffB);
            PG8_BAR; PG8_WAIT_L(0); PG8_MMA(0, 1, At, B1); PG8_BAR;
            PG8_LDA(At, 0, 1); PG8_STAGE(PG8_SA(0, 0), a2, voffA);
            PG8_BAR; PG8_WAIT_L(0); PG8_MMA(1, 0, At, B0); PG8_BAR; PG8_SCHED;
            PG8_STAGE(PG8_SB(0, 1), b2 + hstep, voffB);
            PG8_WAIT_V(6); PG8_BAR; PG8_MMA(1, 1, At, B1); PG8_BAR;
            PG8_LDB(B0, 1, 0); PG8_SCHED; PG8_LDA(At, 1, 0); PG8_STAGE(PG8_SA(0, 1), a2 + hstep, voffA);
            PG8_WAIT_L(8); PG8_BAR; PG8_WAIT_L(0); PG8_MMA(0, 0, At, B0); PG8_BAR; PG8_SCHED;
            PG8_LDB(B1, 1, 1); PG8_STAGE(PG8_SB(1, 0), b3, voffB);
            PG8_BAR; PG8_WAIT_L(0); PG8_MMA(0, 1, At, B1); PG8_BAR;
            PG8_LDA(At, 1, 1); PG8_STAGE(PG8_SA(1, 0), a3, voffA);
            PG8_BAR; PG8_WAIT_L(0); PG8_MMA(1, 0, At, B0); PG8_BAR; PG8_SCHED;
            PG8_STAGE(PG8_SB(1, 1), b3 + hstep, voffB);
            PG8_WAIT_V(6); PG8_BAR; PG8_MMA(1, 1, At, B1); PG8_BAR;
            }
        }
        if constexpr (ALIGN_EPI) { if (wr == 0) PG8_BAR; }
        bool keep = false;
        if constexpr (Epi::TWO_SEG) { if (cur.seg == 0) { E.mid(acc, cur, wr, wc, fr, fq); keep = true; } }
        if (!keep) if constexpr (!Epi::AFTER_DRAIN) { E(acc, cur, wr, wc, fr, fq); S.done(cur); }
        if (!has_next) break;
        if constexpr (Epi::INIT_ACC) { if (!keep) E.init(acc, nxt, wr, wc, fr, fq); }
        else if (!keep)
#pragma unroll
        for (int a = 0; a < 2; ++a)
#pragma unroll
            for (int b = 0; b < 2; ++b)
#pragma unroll
                for (int m = 0; m < 4; ++m)
#pragma unroll
                    for (int n = 0; n < 2; ++n) acc[a][b][m][n] = (f32x4){0.f, 0.f, 0.f, 0.f};
        cur = nxt; cA = nA; cB = nB; ++ui;
        if constexpr (ALIGN_EPI) { if (wr == 1) PG8_BAR; }
    }
    PG8_WAIT_V(0);
    if constexpr (!ALIGN_EPI) { if (wr == 0) PG8_BAR; }
    PG8_BAR;
    if constexpr (Epi::AFTER_DRAIN) { E.fused(acc, cur, wr, wc, fr, fq, lds, wid, lane); S.done(cur); }
#undef PG8_SA
#undef PG8_SB
#undef PG8_STAGE
#undef PG8_LDA
#undef PG8_LDB
#undef PG8_MMA
#undef PG8_WAIT_V
#undef PG8_WAIT_L
#undef PG8_BAR
#undef PG8_SCHED
}
}

#ifndef PG8_SP2
#define PG8_SP2 true
#endif
#ifndef PG8_ALIGN
#define PG8_ALIGN true
#endif

namespace cg = cooperative_groups;
#define LAS __attribute__((address_space(3)))
typedef unsigned short bf16_t;
typedef short bf16x8 __attribute__((ext_vector_type(8)));
typedef short s16x4 __attribute__((ext_vector_type(4)));
typedef float f32x4 __attribute__((ext_vector_type(4)));
typedef float f32x16 __attribute__((ext_vector_type(16)));
typedef unsigned u32x4 __attribute__((ext_vector_type(4)));
typedef unsigned u32x2 __attribute__((ext_vector_type(2)));
typedef float f32x2_t __attribute__((ext_vector_type(2)));
typedef __bf16 bf16x2_t __attribute__((ext_vector_type(2)));

#ifndef MK_SPLIT
#define MK_SPLIT 0
#endif

constexpr int NWAVES = 8;
constexpr int DM = 1024, SEQ = 8192, NBATCH = 2, LP = 8320, MTOK = 16384, M1 = 16640, NIN = 5376, PP = 3328, GW = 2048;
constexpr int AW = 512, BW = 512;
constexpr float RMS_EPS = 1e-6f, LOG2E = 1.4426950408889634f;
constexpr float QSCALE = 0.125f * LOG2E;
constexpr float LAM_INIT = 0.2f;

constexpr size_t MiB = 1u << 20;
constexpr size_t WS_WIN = 1 * MiB, WS_WUA = 12 * MiB, WS_WUB = 13 * MiB, WS_WO = 14 * MiB;
constexpr size_t WS_XN = 16 * MiB, WS_YA = 16 * MiB, WS_YB = 32 * MiB;
constexpr size_t WS_P = 49 * MiB, WS_T = 49 * MiB, WS_MIX = 113 * MiB;
constexpr size_t WS_G = 155 * MiB, WS_END = 219 * MiB;
static_assert(WS_XN + (size_t)M1 * DM * 2 <= WS_P && WS_P + (size_t)M1 * PP * 2 <= WS_G && WS_MIX + (size_t)MTOK * DM * 2 <= WS_G, "ws map");

constexpr int LDS_BYTES = 147456;

__device__ __forceinline__ unsigned f2bf(float f) { unsigned u = __builtin_bit_cast(unsigned, f); return (u + 0x7fffu + ((u >> 16) & 1u)) >> 16; }
__device__ __forceinline__ unsigned pk2(float lo, float hi) { f32x2_t v = {lo, hi}; bf16x2_t b = __builtin_convertvector(v, bf16x2_t); return __builtin_bit_cast(unsigned, b); }
__device__ __forceinline__ float bf2f(unsigned short u) { return __builtin_bit_cast(float, (unsigned)u << 16); }
__device__ __forceinline__ float bflo(unsigned u) { return __builtin_bit_cast(float, u << 16); }
__device__ __forceinline__ float bfhi(unsigned u) { return __builtin_bit_cast(float, u & 0xffff0000u); }
__device__ __forceinline__ float wave_sum(float v) {
#pragma unroll
    for (int o = 1; o < 64; o <<= 1) v += __shfl_xor(v, o);
    return v;
}
__device__ __forceinline__ float wave_max(float v) {
#pragma unroll
    for (int o = 1; o < 64; o <<= 1) v = fmaxf(v, __shfl_xor(v, o));
    return v;
}
__device__ __forceinline__ float fast_exp2(float x) { return __builtin_amdgcn_exp2f(x); }
__device__ __forceinline__ float sigmoidf_(float x) { return __builtin_amdgcn_rcpf(1.0f + fast_exp2(-x * LOG2E)); }

__device__ __forceinline__ int perm_in_col(int c) { const int pn = c >> 8, rem = c & 255, wc = rem >> 6, bj = (rem >> 5) & 1, j = rem & 31; return (pn << 8) + 128 * bj + 32 * wc + j; }

template <bool PERMCOL>
__device__ __forceinline__ void p0_transpose_item(const float* W, int K, int N, bf16_t* WT, LAS float* scr, int item, int lane) {
    const int nblk = N / 32, kb = item / nblk, nb = item % nblk, k0 = 64 * kb, n0 = 32 * nb;
    { f32x4 wv[8];
#pragma unroll
      for (int i = 0; i < 8; ++i) wv[i] = __builtin_nontemporal_load((const f32x4*)(W + (size_t)(k0 + 8 * i + (lane >> 3)) * N + n0 + 4 * (lane & 7)));
#pragma unroll
      for (int i = 0; i < 8; ++i) { LAS float* d = scr + (8 * i + (lane >> 3)) * 33 + 4 * (lane & 7); d[0] = wv[i].x; d[1] = wv[i].y; d[2] = wv[i].z; d[3] = wv[i].w; } }
    asm volatile("s_waitcnt lgkmcnt(0)" ::: "memory");
    const int c = lane & 7;
#pragma unroll
    for (int j = 0; j < 4; ++j) { const int n = (lane >> 3) + 8 * j; const LAS float* s = scr + (8 * c) * 33 + n;
        u32x4 o; o.x = pk2(s[0 * 33], s[1 * 33]); o.y = pk2(s[2 * 33], s[3 * 33]); o.z = pk2(s[4 * 33], s[5 * 33]); o.w = pk2(s[6 * 33], s[7 * 33]);
        const int drow = PERMCOL ? perm_in_col(n0 + n) : (n0 + n);
        *(u32x4*)(WT + (size_t)drow * K + k0 + 8 * c) = o; }
    asm volatile("s_waitcnt lgkmcnt(0)" ::: "memory");
}
__device__ __forceinline__ void rms_rows2_to_bf16(const float* x0, const float* x1, const float* g, bf16_t* o0, bf16_t* o1, int lane) {
    const f32x4 z4 = {0.f, 0.f, 0.f, 0.f};
    f32x4 v0[4], v1[4];
#pragma unroll
    for (int j = 0; j < 4; ++j) { v0[j] = x0 ? __builtin_nontemporal_load((const f32x4*)x0 + lane + 64 * j) : z4; v1[j] = x1 ? __builtin_nontemporal_load((const f32x4*)x1 + lane + 64 * j) : z4; }
    float s0 = 0.f, s1 = 0.f;
#pragma unroll
    for (int j = 0; j < 4; ++j) { s0 += (v0[j].x * v0[j].x + v0[j].y * v0[j].y) + (v0[j].z * v0[j].z + v0[j].w * v0[j].w); s1 += (v1[j].x * v1[j].x + v1[j].y * v1[j].y) + (v1[j].z * v1[j].z + v1[j].w * v1[j].w); }
#pragma unroll
    for (int o = 1; o < 64; o <<= 1) { s0 += __shfl_xor(s0, o); s1 += __shfl_xor(s1, o); }
    const float r0 = 1.0f / sqrtf(s0 * (1.f / DM) + RMS_EPS), r1 = 1.0f / sqrtf(s1 * (1.f / DM) + RMS_EPS);
    unsigned long long* p0 = (unsigned long long*)o0 + lane; unsigned long long* p1 = (unsigned long long*)o1 + lane;
#pragma unroll
    for (int j = 0; j < 4; ++j) { const f32x4 gg = ((const f32x4*)g)[lane + 64 * j]; const f32x4 y0 = v0[j] * r0 * gg, y1 = v1[j] * r1 * gg;
        p0[64 * j] = (unsigned long long)pk2(y0.x, y0.y) | ((unsigned long long)pk2(y0.z, y0.w) << 32);
        if (o1) p1[64 * j] = (unsigned long long)pk2(y1.x, y1.y) | ((unsigned long long)pk2(y1.z, y1.w) << 32); }
}

struct EpiIn {
    static constexpr bool PERM = true, AFTER_DRAIN = false, TWO_SEG = false, INIT_ACC = false;
    bf16_t* P; bf16_t* G; const float* aqn; const float* akn; const float* bqn; const float* bkn;
    __device__ __forceinline__ void operator()(const f32x4 (&acc)[2][2][4][2], const pg8::Unit& u, int wr, int wc, int fr, int fq) const {
        const int c64 = u.pn * 4 + wc;
        const float* gp = nullptr; float gscale = 1.f;
        if (c64 < 8) { gp = aqn; gscale = QSCALE; } else if (c64 < 10) gp = akn; else if (c64 >= 20 && c64 < 28) { gp = bqn; gscale = QSCALE; } else if (c64 >= 28 && c64 < 36) gp = bkn;
        const int mode = gp ? 1 : (((c64 >= 12 && c64 < 20) || (c64 >= 44 && c64 < 52)) ? 2 : (c64 >= 52 ? 3 : 0));
        f32x4 gv[2][2];
#pragma unroll
        for (int bj = 0; bj < 2; ++bj)
#pragma unroll
            for (int n = 0; n < 2; ++n) gv[bj][n] = gp ? *(const f32x4*)(gp + 32 * bj + 8 * fq + 4 * n) * gscale : (f32x4){1.f, 1.f, 1.f, 1.f};
        const bool meta = (u.pm >= 64);
#pragma unroll
        for (int ai = 0; ai < 2; ++ai)
#pragma unroll
            for (int m = 0; m < 4; ++m) {
                const int r = u.pm * 256 + ai * 128 + wr * 64 + m * 16 + fr;
                f32x4 v[2][2];
#pragma unroll
                for (int bj = 0; bj < 2; ++bj)
#pragma unroll
                    for (int n = 0; n < 2; ++n) v[bj][n] = acc[ai][bj][m][n];
                if (mode == 1) {
                    float ss = 0.f;
#pragma unroll
                    for (int bj = 0; bj < 2; ++bj)
#pragma unroll
                        for (int n = 0; n < 2; ++n) { const f32x4 x = v[bj][n]; ss += (x[0] * x[0] + x[1] * x[1]) + (x[2] * x[2] + x[3] * x[3]); }
                    ss += __shfl_xor(ss, 16); ss += __shfl_xor(ss, 32);
                    const float rs = 1.0f / sqrtf(ss * (1.f / 64.f) + RMS_EPS);
#pragma unroll
                    for (int bj = 0; bj < 2; ++bj)
#pragma unroll
                        for (int n = 0; n < 2; ++n) v[bj][n] = v[bj][n] * rs * gv[bj][n];
                } else if (mode == 2) {
#pragma unroll
                    for (int bj = 0; bj < 2; ++bj)
#pragma unroll
                        for (int n = 0; n < 2; ++n)
#pragma unroll
                            for (int e = 0; e < 4; ++e) v[bj][n][e] = v[bj][n][e] * sigmoidf_(v[bj][n][e]);
                } else if (mode == 3) {
#pragma unroll
                    for (int bj = 0; bj < 2; ++bj)
#pragma unroll
                        for (int n = 0; n < 2; ++n)
#pragma unroll
                            for (int e = 0; e < 4; ++e) v[bj][n][e] = sigmoidf_(v[bj][n][e]);
                }
#pragma unroll
                for (int bj = 0; bj < 2; ++bj) {
                    u32x4 w; w.x = pk2(v[bj][0][0], v[bj][0][1]); w.y = pk2(v[bj][0][2], v[bj][0][3]); w.z = pk2(v[bj][1][0], v[bj][1][1]); w.w = pk2(v[bj][1][2], v[bj][1][3]);
                    if (c64 < 52) {
                        const int col = c64 * 64 + 32 * bj + 8 * fq;
                        if (!meta) { const int prow = r + 128 * ((r >> 13) + 1); *(u32x4*)(P + (size_t)prow * PP + col) = w; }
                        else { const int i = r - MTOK; if (i < 128) { const int tp = (i + 112) & 127; *(u32x4*)(P + (size_t)tp * PP + col) = w; *(u32x4*)(P + (size_t)(LP + tp) * PP + col) = w; } }
                    } else if (!meta) {
                        *(u32x4*)(G + (size_t)r * GW + (c64 - 52) * 64 + 32 * bj + 8 * fq) = w;
                    }
                }
            }
    }
};

struct EpiUp {
    static constexpr bool PERM = true, AFTER_DRAIN = false, TWO_SEG = true, INIT_ACC = false;
    const bf16_t* G; bf16_t* MIX;
    __device__ __forceinline__ void mid(f32x4 (&acc)[2][2][4][2], const pg8::Unit& u, int wr, int wc, int fr, int fq) const {
#pragma unroll
        for (int ai = 0; ai < 2; ++ai)
#pragma unroll
            for (int m = 0; m < 4; ++m) { const int r = u.pm * 256 + ai * 128 + wr * 64 + m * 16 + fr;
#pragma unroll
                for (int bj = 0; bj < 2; ++bj) { const int c0 = u.pn * 256 + 128 * bj + 32 * wc + 8 * fq;
                    const u32x4 ga = *(const u32x4*)(G + (size_t)r * GW + c0), gb = *(const u32x4*)(G + (size_t)r * GW + DM + c0);
                    f32x4& a = acc[ai][bj][m][0]; f32x4& b = acc[ai][bj][m][1];
#define RAT(x, y) ((x) * __builtin_amdgcn_rcpf(fmaxf((y), 1e-30f)))
                    a[0] *= RAT(bflo(ga.x), bflo(gb.x)); a[1] *= RAT(bfhi(ga.x), bfhi(gb.x)); a[2] *= RAT(bflo(ga.y), bflo(gb.y)); a[3] *= RAT(bfhi(ga.y), bfhi(gb.y));
                    b[0] *= RAT(bflo(ga.z), bflo(gb.z)); b[1] *= RAT(bfhi(ga.z), bfhi(gb.z)); b[2] *= RAT(bflo(ga.w), bflo(gb.w)); b[3] *= RAT(bfhi(ga.w), bfhi(gb.w));
#undef RAT
                } }
    }
    __device__ __forceinline__ void operator()(const f32x4 (&acc)[2][2][4][2], const pg8::Unit& u, int wr, int wc, int fr, int fq) const {
#pragma unroll
        for (int ai = 0; ai < 2; ++ai)
#pragma unroll
            for (int m = 0; m < 4; ++m) { const int r = u.pm * 256 + ai * 128 + wr * 64 + m * 16 + fr;
#pragma unroll
                for (int bj = 0; bj < 2; ++bj) { const int c0 = u.pn * 256 + 128 * bj + 32 * wc + 8 * fq;
                    const u32x4 g = *(const u32x4*)(G + (size_t)r * GW + DM + c0);
                    const f32x4 a = acc[ai][bj][m][0], b = acc[ai][bj][m][1];
                    u32x4 w; w.x = pk2(a[0] * bflo(g.x), a[1] * bfhi(g.x)); w.y = pk2(a[2] * bflo(g.y), a[3] * bfhi(g.y)); w.z = pk2(b[0] * bflo(g.z), b[1] * bfhi(g.z)); w.w = pk2(b[2] * bflo(g.w), b[3] * bfhi(g.w));
                    *(u32x4*)(MIX + (size_t)r * DM + c0) = w; } }
    }
};
struct EpiOut {
    static constexpr bool PERM = true, AFTER_DRAIN = false, TWO_SEG = false, INIT_ACC = true;
    const float* X; float* O;
    __device__ __forceinline__ void init(f32x4 (&acc)[2][2][4][2], const pg8::Unit& u, int wr, int wc, int fr, int fq) const {
#pragma unroll
        for (int ai = 0; ai < 2; ++ai)
#pragma unroll
            for (int m = 0; m < 4; ++m) { const int r = u.pm * 256 + ai * 128 + wr * 64 + m * 16 + fr;
#pragma unroll
                for (int bj = 0; bj < 2; ++bj) { const float* xp = X + (size_t)r * DM + u.pn * 256 + 128 * bj + 32 * wc + 8 * fq;
                    acc[ai][bj][m][0] = __builtin_nontemporal_load((const f32x4*)xp); acc[ai][bj][m][1] = __builtin_nontemporal_load((const f32x4*)(xp + 4)); } }
    }
    __device__ __forceinline__ void operator()(const f32x4 (&acc)[2][2][4][2], const pg8::Unit& u, int wr, int wc, int fr, int fq) const {
#pragma unroll
        for (int ai = 0; ai < 2; ++ai)
#pragma unroll
            for (int m = 0; m < 4; ++m) { const int r = u.pm * 256 + ai * 128 + wr * 64 + m * 16 + fr;
#pragma unroll
                for (int bj = 0; bj < 2; ++bj) { float* op = O + (size_t)r * DM + u.pn * 256 + 128 * bj + 32 * wc + 8 * fq;
                    __builtin_nontemporal_store(acc[ai][bj][m][0], (f32x4*)op); __builtin_nontemporal_store(acc[ai][bj][m][1], (f32x4*)(op + 4)); } }
    }
};

#define MFMA32(a, b, c) __builtin_amdgcn_mfma_f32_32x32x16_bf16(a, b, c, 0, 0, 0)
#define SBAR() __builtin_amdgcn_sched_barrier(0)
typedef short v4i16_t __attribute__((ext_vector_type(4)));
__device__ __forceinline__ int crow(int r, int hi) { return (r & 3) + 8 * (r >> 2) + 4 * hi; }
__device__ __forceinline__ s16x4 vtr(const LAS unsigned char* p) { return __builtin_bit_cast(s16x4, __builtin_amdgcn_ds_read_tr16_b64_v4i16((LAS v4i16_t*)p)); }
__device__ __forceinline__ bf16x8 cat8(s16x4 lo, s16x4 hi) { return (bf16x8){lo[0], lo[1], lo[2], lo[3], hi[0], hi[1], hi[2], hi[3]}; }
__device__ __forceinline__ bf16x8 pack8(const f32x16& p, int b) {
    u32x4 w; w.x = pk2(p[b], p[b + 1]); w.y = pk2(p[b + 2], p[b + 3]); w.z = pk2(p[b + 4], p[b + 5]); w.w = pk2(p[b + 6], p[b + 7]); return __builtin_bit_cast(bf16x8, w); }
constexpr int ATT_SCR = 98304;

#define B_QK_INIT(N0, N1, T) do { float sl_ = slope2; asm volatile("" : "+v"(sl_));     \
    const float tb_ = sl_ * (float)(64 * (T) - (128 * qb + 32 * wq)) + abase; \
    _Pragma("unroll") for (int r = 0; r < 16; ++r) { N0[r] = fmaf(sl_, (float)((r & 3) + 8 * (r >> 2)), tb_); N1[r] = fmaf(sl_, (float)((r & 3) + 8 * (r >> 2) + 32), tb_); } } while (0)
#define B_EXP4(C, B) do { C[B] = fast_exp2(C[B]); C[B + 1] = fast_exp2(C[B + 1]); C[B + 2] = fast_exp2(C[B + 2]); C[B + 3] = fast_exp2(C[B + 3]); } while (0)
#define B_STEP(C0, C1, N0, N1, T) do { \
    const int t_ = (T); const bool has1 = (t_ + 1 <= t1), has2 = (t_ + 2 <= t1), has3 = (t_ + 3 <= t1); \
    const int r0_ = (t_ - t0) % 3, r1_ = (r0_ == 2) ? 0 : r0_ + 1, r2_ = (r1_ == 2) ? 0 : r1_ + 1;     \
    if (has3) { const size_t go = (size_t)(t_ + 3) * 64 * PP; const int kn_ = r0_ * 16384 + w * 1024; GLDS16(k0src + go, lds + kn_); GLDS16(k1src + go, lds + kn_ + 8192); } \
    if (has2) { const size_t go = (size_t)(t_ + 2) * 64 * PP; const int vn_ = 49152 + r2_ * 16384 + vdw; GLDS16(vsrc + go, lds + vn_); GLDS16(vsrc + go + 64, lds + vn_ + 8192); } \
    if (has1) { \
        const LAS unsigned char* kb = lds + r1_ * 16384 + map * 8192; \
        bf16x8 kf[8]; \
        _Pragma("unroll") for (int d0 = 0; d0 < 4; ++d0) { kf[2 * d0] = *(const LAS bf16x8*)(kb + koff[d0]); kf[2 * d0 + 1] = *(const LAS bf16x8*)(kb + koff[d0] + 4096); } \
        B_QK_INIT(N0, N1, t_ + 1); \
        SBAR(); \
        N0 = MFMA32(kf[0], qr[0], N0); B_EXP4(C0, 0); SBAR(); \
        N1 = MFMA32(kf[1], qr[0], N1); B_EXP4(C1, 0); SBAR(); \
        N0 = MFMA32(kf[2], qr[1], N0); B_EXP4(C0, 4); SBAR(); \
        N1 = MFMA32(kf[3], qr[1], N1); B_EXP4(C1, 4); SBAR(); \
        N0 = MFMA32(kf[4], qr[2], N0); B_EXP4(C0, 8); SBAR(); \
        N1 = MFMA32(kf[5], qr[2], N1); B_EXP4(C1, 8); SBAR(); \
        N0 = MFMA32(kf[6], qr[3], N0); B_EXP4(C0, 12); SBAR(); \
        N1 = MFMA32(kf[7], qr[3], N1); B_EXP4(C1, 12); SBAR(); \
    } else { \
        _Pragma("unroll") for (int r = 0; r < 16; ++r) { C0[r] = fast_exp2(C0[r]); C1[r] = fast_exp2(C1[r]); } \
    } \
    const LAS unsigned char* vb = lds + 49152 + r0_ * 16384 + vlane; \
    s16x4 va[8], vc[8];                                             \
    _Pragma("unroll") for (int d = 0; d < 4; ++d) { va[2 * d] = vtr(vb + d * 4096); va[2 * d + 1] = vtr(vb + d * 4096 + 512); } \
    if (t_ == 1 || t_ >= 2 * qb) {                                  \
        _Pragma("unroll") for (int r = 0; r < 16; ++r) { const int k0t = 64 * t_ + crow(r, hi), k1t = k0t + 32; \
            if (k0t > qt || k0t < 112) C0[r] = 0.f; if (k1t > qt || k1t < 112) C1[r] = 0.f; } \
    } \
      \
    const bf16x8 pw0 = pack8(C0, 0); \
    _Pragma("unroll") for (int d = 0; d < 4; ++d) { vc[2 * d] = vtr(vb + d * 4096 + 1024); vc[2 * d + 1] = vtr(vb + d * 4096 + 1536); } \
    SBAR(); \
    o[0] = MFMA32(pw0, cat8(va[0], va[1]), o[0]); o[1] = MFMA32(pw0, cat8(va[2], va[3]), o[1]); \
    o[2] = MFMA32(pw0, cat8(va[4], va[5]), o[2]); o[3] = MFMA32(pw0, cat8(va[6], va[7]), o[3]); \
    const bf16x8 pw1 = pack8(C0, 8); \
    float a_ = ((C0[0] + C0[1]) + (C0[2] + C0[3])) + ((C0[4] + C0[5]) + (C0[6] + C0[7])); \
    SBAR(); \
    _Pragma("unroll") for (int d = 0; d < 4; ++d) { va[2 * d] = vtr(vb + d * 4096 + 2048); va[2 * d + 1] = vtr(vb + d * 4096 + 2560); } \
    o[0] = MFMA32(pw1, cat8(vc[0], vc[1]), o[0]); o[1] = MFMA32(pw1, cat8(vc[2], vc[3]), o[1]); \
    o[2] = MFMA32(pw1, cat8(vc[4], vc[5]), o[2]); o[3] = MFMA32(pw1, cat8(vc[6], vc[7]), o[3]); \
    const bf16x8 pw2 = pack8(C1, 0); \
    a_ += ((C0[8] + C0[9]) + (C0[10] + C0[11])) + ((C0[12] + C0[13]) + (C0[14] + C0[15])); \
    SBAR(); \
    _Pragma("unroll") for (int d = 0; d < 4; ++d) { vc[2 * d] = vtr(vb + d * 4096 + 3072); vc[2 * d + 1] = vtr(vb + d * 4096 + 3584); } \
    o[0] = MFMA32(pw2, cat8(va[0], va[1]), o[0]); o[1] = MFMA32(pw2, cat8(va[2], va[3]), o[1]); \
    o[2] = MFMA32(pw2, cat8(va[4], va[5]), o[2]); o[3] = MFMA32(pw2, cat8(va[6], va[7]), o[3]); \
    const bf16x8 pw3 = pack8(C1, 8); \
    a_ += ((C1[0] + C1[1]) + (C1[2] + C1[3])) + ((C1[4] + C1[5]) + (C1[6] + C1[7])); \
    SBAR(); \
    o[0] = MFMA32(pw3, cat8(vc[0], vc[1]), o[0]); o[1] = MFMA32(pw3, cat8(vc[2], vc[3]), o[1]); \
    o[2] = MFMA32(pw3, cat8(vc[4], vc[5]), o[2]); o[3] = MFMA32(pw3, cat8(vc[6], vc[7]), o[3]); \
    a_ += ((C1[8] + C1[9]) + (C1[10] + C1[11])) + ((C1[12] + C1[13]) + (C1[14] + C1[15])); \
    lsum += a_; \
    SBAR(); \
      \
      \
    if (has3 && has2) asm volatile("s_waitcnt vmcnt(4) lgkmcnt(0)\n\ts_barrier" ::: "memory"); \
    else asm volatile("s_waitcnt vmcnt(0) lgkmcnt(0)\n\ts_barrier" ::: "memory"); \
} while (0)

__device__ __forceinline__ void attn_b_core(const bf16_t* __restrict__ P, float kmax, int b, int h, int qb, int t0, int t1, LAS unsigned char* lds, f32x16 (&o)[4], float& lsum) {
    int tid = threadIdx.x; asm volatile("" : "+v"(tid));
    const int lane = tid & 63, r32 = lane & 31, hi = lane >> 5; const int w = __builtin_amdgcn_readfirstlane(tid >> 6);
    const int map = w >> 2, wq = w & 3;
    const size_t rowbase = (size_t)b * LP;
    const float slope2 = exp2f(-2.0f * (float)(h + 1)) * LOG2E;
    const int krow = 8 * w + (lane >> 3);
    const bf16_t* k0src = P + (rowbase + krow) * PP + 1792 + h * 128 + (((lane & 7) ^ ((krow >> 1) & 7)) << 3);
    const bf16_t* k1src = k0src + 64;
    const bf16_t* vsrc = P + (rowbase + 16 * (w & 3) + (lane >> 2)) * PP + 2304 + h * 128 + (w >> 2) * 32 + (lane & 3) * 8;
    const int vdw = (w >> 2) * 4096 + (w & 3) * 1024;
    int koff[4];
#pragma unroll
    for (int d0 = 0; d0 < 4; ++d0) koff[d0] = r32 * 128 + ((((2 * d0 + hi) ^ ((r32 >> 1) & 7))) << 4);
#define GLDS16(gp, lp) __builtin_amdgcn_global_load_lds((const unsigned*)(gp), (LAS unsigned*)(lp), 16, 0, 0)
    const int qt = 128 * qb + 32 * wq + r32;
    bf16x8 qr[4];
    { const bf16_t* qp = P + (rowbase + qt) * PP + 1280 + h * 128 + map * 64 + 8 * hi;
#pragma unroll
      for (int d0 = 0; d0 < 4; ++d0) qr[d0] = *(const bf16x8*)(qp + 16 * d0); }
    float qss = 0.f;
#pragma unroll
    for (int d0 = 0; d0 < 4; ++d0)
#pragma unroll
        for (int e = 0; e < 8; ++e) { const float f = bf2f((unsigned short)qr[d0][e]); qss += f * f; }
    qss += __shfl_xor(qss, 32);
    const float mrow = sqrtf(qss) * kmax;
    const float abase = -slope2 * (float)(r32 - 4 * hi) - mrow;
#pragma unroll
    for (int d = 0; d < 4; ++d) o[d] = f32x16{};
    lsum = 0.f;
    const int vlane = ((lane >> 4) & 1) * 32 + (lane & 3) * 8 + (4 * hi + ((lane & 15) >> 2)) * 64;
    { const size_t go = (size_t)t0 * 64 * PP, g1 = (size_t)64 * PP;
      GLDS16(k0src + go, lds + w * 1024); GLDS16(k1src + go, lds + 8192 + w * 1024); GLDS16(vsrc + go, lds + 49152 + vdw); GLDS16(vsrc + go + 64, lds + 49152 + vdw + 8192);
      if (t0 + 1 <= t1) { GLDS16(k0src + go + g1, lds + 16384 + w * 1024); GLDS16(k1src + go + g1, lds + 16384 + 8192 + w * 1024);
                          GLDS16(vsrc + go + g1, lds + 49152 + 16384 + vdw); GLDS16(vsrc + go + g1 + 64, lds + 49152 + 16384 + vdw + 8192); }
      if (t0 + 2 <= t1) { GLDS16(k0src + go + 2 * g1, lds + 32768 + w * 1024); GLDS16(k1src + go + 2 * g1, lds + 32768 + 8192 + w * 1024); } }
    asm volatile("s_waitcnt vmcnt(0)" ::: "memory");
    __syncthreads();
    f32x16 sA0, sA1, sB0, sB1;
    { const LAS unsigned char* kb = lds + map * 8192;
      B_QK_INIT(sA0, sA1, t0);
#pragma unroll
      for (int d0 = 0; d0 < 4; ++d0) { const bf16x8 k0 = *(const LAS bf16x8*)(kb + koff[d0]), k1 = *(const LAS bf16x8*)(kb + koff[d0] + 4096);
          sA0 = MFMA32(k0, qr[d0], sA0); sA1 = MFMA32(k1, qr[d0], sA1); } }
    __syncthreads();
    for (int t = t0; t <= t1; t += 2) {
        B_STEP(sA0, sA1, sB0, sB1, t);
        if (t + 1 <= t1) B_STEP(sB0, sB1, sA0, sA1, t + 1);
    }
}
#undef B_STEP
#undef GLDS16
#undef B_EXP4
#undef B_QK_INIT
__device__ __forceinline__ void attn_b_finalize(const bf16_t* __restrict__ P, bf16_t* __restrict__ YB, const float* __restrict__ subln, float lam, int b, int h, int qb, LAS unsigned char* lds, f32x16 (&o)[4], float lsum) {
    int tid = threadIdx.x; asm volatile("" : "+v"(tid));
    const int lane = tid & 63, r32 = lane & 31, hi = lane >> 5; const int w = __builtin_amdgcn_readfirstlane(tid >> 6);
    const int map = w >> 2, wq = w & 3;
    const size_t rowbase = (size_t)b * LP;
    lsum += __shfl_xor(lsum, 32);
    LAS float* scr = (LAS float*)(lds + ATT_SCR) + w * 32;
    { float inv = 1.0f / lsum; if (map == 1) inv *= lam; if (hi == 0) scr[r32] = inv; }
    float rl[16];
#pragma unroll
    for (int r = 0; r < 16; ++r) rl[r] = scr[crow(r, hi)];
#pragma unroll
    for (int d0 = 0; d0 < 4; ++d0)
#pragma unroll
        for (int r = 0; r < 16; ++r) o[d0][r] *= rl[r];
    LAS float* X = (LAS float*)lds;
    if (map == 1) {
#pragma unroll
        for (int d0 = 0; d0 < 4; ++d0)
#pragma unroll
            for (int r = 0; r < 16; ++r) X[((wq * 4 + d0) * 16 + r) * 64 + lane] = o[d0][r];
    }
    __syncthreads();
    LAS unsigned short* Y = (LAS unsigned short*)(lds + 65536);
    if (map == 0) {
        float rn[16];
#pragma unroll
        for (int r = 0; r < 16; ++r) { float ss = 0.f;
#pragma unroll
            for (int d0 = 0; d0 < 4; ++d0) { o[d0][r] -= X[((wq * 4 + d0) * 16 + r) * 64 + lane]; ss += o[d0][r] * o[d0][r]; }
            ss += __shfl_xor(ss, 1); ss += __shfl_xor(ss, 2); ss += __shfl_xor(ss, 4); ss += __shfl_xor(ss, 8); ss += __shfl_xor(ss, 16);
            rn[r] = (1.0f - LAM_INIT) / sqrtf(ss * (1.f / 128.f) + RMS_EPS); }
#pragma unroll
        for (int d0 = 0; d0 < 4; ++d0) { const float sg = subln[32 * d0 + r32];
#pragma unroll
            for (int r = 0; r < 16; ++r) Y[(32 * wq + crow(r, hi)) * 128 + 32 * d0 + r32] = (unsigned short)f2bf(o[d0][r] * rn[r] * sg); }
    }
    __syncthreads();
    { u32x4 yv[4], zv[4];
#pragma unroll
      for (int i = 0; i < 4; ++i) { const int x = tid + 512 * i, row = x >> 4, c = x & 15;
          yv[i] = *(const LAS u32x4*)(Y + row * 128 + c * 8);
          zv[i] = *(const u32x4*)(P + (rowbase + 128 * qb + row) * PP + 2816 + h * 128 + c * 8); }
#pragma unroll
      for (int i = 0; i < 4; ++i) { const int x = tid + 512 * i, row = x >> 4, c = x & 15;
          u32x4 ov; ov.x = pk2(bflo(yv[i].x) * bflo(zv[i].x), bfhi(yv[i].x) * bfhi(zv[i].x)); ov.y = pk2(bflo(yv[i].y) * bflo(zv[i].y), bfhi(yv[i].y) * bfhi(zv[i].y));
          ov.z = pk2(bflo(yv[i].z) * bflo(zv[i].z), bfhi(yv[i].z) * bfhi(zv[i].z)); ov.w = pk2(bflo(yv[i].w) * bflo(zv[i].w), bfhi(yv[i].w) * bfhi(zv[i].w));
          *(u32x4*)(YB + ((size_t)b * SEQ + 128 * (qb - 1) + row) * BW + h * 128 + c * 8) = ov; } }
    __syncthreads();
}

__device__ __forceinline__ void attn_a_unit(const bf16_t* __restrict__ P, bf16_t* __restrict__ YA, const float* __restrict__ sink, float kmax, int b, int kvh, int qb, LAS unsigned char* lds) {
    int tid = threadIdx.x; asm volatile("" : "+v"(tid));
    const int lane = tid & 63, r32 = lane & 31, hi = lane >> 5; const int w = __builtin_amdgcn_readfirstlane(tid >> 6);
    const size_t rowbase = (size_t)b * LP; const int kt0 = 128 * (qb - 1);
    { u32x4 kk[4], vv[4];
#pragma unroll
      for (int j = 0; j < 4; ++j) { kk[j] = *(const u32x4*)(P + (rowbase + kt0 + 64 * j + lane) * PP + 512 + kvh * 64 + w * 8);
                                    vv[j] = *(const u32x4*)(P + (rowbase + kt0 + 64 * j + (tid >> 3)) * PP + 640 + kvh * 64 + (tid & 7) * 8); }
#pragma unroll
      for (int j = 0; j < 4; ++j) { *(LAS u32x4*)(lds + j * 8192 + w * 1024 + lane * 16) = kk[j];
                                    *(LAS u32x4*)(lds + 32768 + j * 8192 + ((tid & 7) >> 2) * 4096 + (tid >> 3) * 64 + (tid & 3) * 16) = vv[j]; } }
    __syncthreads();
    const int g = w >> 1, hq = kvh * 4 + g;
    const float slope2 = exp2f(-(float)(hq + 1)) * LOG2E, sink2 = sink[hq] * LOG2E;
    const int vlane = ((lane >> 4) & 1) * 32 + (lane & 3) * 8 + (4 * hi + ((lane & 15) >> 2)) * 64;
    LAS float* scr = (LAS float*)(lds + ATT_SCR) + w * 32;
    for (int sub = 0; sub < 2; ++sub) {
        const int q0 = 64 * (w & 1) + 32 * sub; const int qrel = 128 + q0 + r32;
        bf16x8 qr[4];
        { const bf16_t* qp = P + (rowbase + kt0 + qrel) * PP + hq * 64 + 8 * hi;
#pragma unroll
          for (int d0 = 0; d0 < 4; ++d0) qr[d0] = *(const bf16x8*)(qp + 16 * d0); }
        float qss = 0.f;
#pragma unroll
        for (int d0 = 0; d0 < 4; ++d0)
#pragma unroll
            for (int e = 0; e < 8; ++e) { const float f = bf2f((unsigned short)qr[d0][e]); qss += f * f; }
        qss += __shfl_xor(qss, 32);
        const float cref = fmaxf(sqrtf(qss) * kmax, sink2);
        f32x16 o[2]; o[0] = f32x16{}; o[1] = f32x16{}; float lsum = 0.f;
        for (int jj = 0; jj < 3; ++jj) { const int j = (w & 1) + jj;
            f32x16 s0, s1;
#pragma unroll
            for (int r = 0; r < 16; ++r) { const int d0_ = qrel - (64 * j + crow(r, hi)); s0[r] = -slope2 * (float)d0_ - cref; s1[r] = -slope2 * (float)(d0_ - 32) - cref; }
            const LAS unsigned char* kb = lds + j * 8192 + hi * 1024 + r32 * 16;
#pragma unroll
            for (int d0 = 0; d0 < 4; ++d0) {
                const bf16x8 k0 = *(const LAS bf16x8*)(kb + d0 * 2048), k1 = *(const LAS bf16x8*)(kb + d0 * 2048 + 512);
                s0 = MFMA32(k0, qr[d0], s0); s1 = MFMA32(k1, qr[d0], s1); }
#pragma unroll
            for (int r = 0; r < 16; ++r) { const int kr = 64 * j + crow(r, hi); const int da = qrel - kr, db = da - 32;
                const float e0 = fast_exp2(s0[r]), e1 = fast_exp2(s1[r]);
                s0[r] = (da >= 0 && da < 128 && kt0 + kr >= 112) ? e0 : 0.f;
                s1[r] = (db >= 0 && db < 128 && kt0 + kr + 32 >= 112) ? e1 : 0.f; }
            { float a = 0.f;
#pragma unroll
              for (int r = 0; r < 16; ++r) a += s0[r] + s1[r];
              lsum += a; }
            const bf16x8 pw0 = pack8(s0, 0), pw1 = pack8(s0, 8), pw2 = pack8(s1, 0), pw3 = pack8(s1, 8);
            const LAS unsigned char* vb = lds + 32768 + j * 8192 + vlane;
#pragma unroll
            for (int d0 = 0; d0 < 2; ++d0) {
                o[d0] = MFMA32(pw0, cat8(vtr(vb + d0 * 4096), vtr(vb + d0 * 4096 + 512)), o[d0]);
                o[d0] = MFMA32(pw1, cat8(vtr(vb + d0 * 4096 + 1024), vtr(vb + d0 * 4096 + 1536)), o[d0]);
                o[d0] = MFMA32(pw2, cat8(vtr(vb + d0 * 4096 + 2048), vtr(vb + d0 * 4096 + 2560)), o[d0]);
                o[d0] = MFMA32(pw3, cat8(vtr(vb + d0 * 4096 + 3072), vtr(vb + d0 * 4096 + 3584)), o[d0]);
            }
        }
        lsum += __shfl_xor(lsum, 32);
        { const float inv = 1.0f / (lsum + fast_exp2(sink2 - cref)); if (hi == 0) scr[r32] = inv; }
        float rl[16];
#pragma unroll
        for (int r = 0; r < 16; ++r) rl[r] = scr[crow(r, hi)];
        LAS unsigned short* Yw = (LAS unsigned short*)(lds + 65536) + w * 2048;
#pragma unroll
        for (int d0 = 0; d0 < 2; ++d0)
#pragma unroll
            for (int r = 0; r < 16; ++r) Yw[crow(r, hi) * 64 + 32 * d0 + r32] = (unsigned short)f2bf(o[d0][r] * rl[r]);
        { u32x4 yv[4], zv[4];
#pragma unroll
          for (int i = 0; i < 4; ++i) { const int row = i * 8 + (lane >> 3), c = lane & 7;
              yv[i] = *(const LAS u32x4*)(Yw + row * 64 + c * 8);
              zv[i] = *(const u32x4*)(P + (rowbase + kt0 + 128 + q0 + row) * PP + 768 + hq * 64 + c * 8); }
#pragma unroll
          for (int i = 0; i < 4; ++i) { const int row = i * 8 + (lane >> 3), c = lane & 7;
              u32x4 ov; ov.x = pk2(bflo(yv[i].x) * bflo(zv[i].x), bfhi(yv[i].x) * bfhi(zv[i].x)); ov.y = pk2(bflo(yv[i].y) * bflo(zv[i].y), bfhi(yv[i].y) * bfhi(zv[i].y));
              ov.z = pk2(bflo(yv[i].z) * bflo(zv[i].z), bfhi(yv[i].z) * bfhi(zv[i].z)); ov.w = pk2(bflo(yv[i].w) * bflo(zv[i].w), bfhi(yv[i].w) * bfhi(zv[i].w));
              *(u32x4*)(YA + ((size_t)b * SEQ + kt0 + q0 + row) * AW + hq * 64 + c * 8) = ov; } }
    }
    __syncthreads();
}

constexpr size_t WS_SLOT = 219 * MiB; constexpr int SLOT_BYTES = 133120, SLOT_MAX = 280;
constexpr int TAB_OFF = 102400;
constexpr int CW_QUEUE = 8192;
__device__ __forceinline__ void unit_decode(int j, int& b, int& h, int& qb) { h = 3 - (j >> 7); const int jj = j & 127; qb = 64 - (jj >> 1); b = jj & 1; }
__device__ __forceinline__ int b_window(int h, float mmax) {
    const float slope2 = exp2f(-2.0f * (float)(h + 1)) * LOG2E;
    const float need = 24.0f + 2.0f * mmax + log2f(1.0f / (slope2 * 0.69314718f));
    const float d = ceilf(need / slope2) + 1.0f;
    return d > 1.0e6f ? 1000000 : (int)d;
}
__device__ __forceinline__ int b_tmin(int qb, int dh) { const int k = 128 * qb - dh; return k < 128 ? 1 : (k >> 6); }
__device__ __forceinline__ void b_store_partial(unsigned char* ws, int slot, const f32x16 (&o)[4], float lsum) {
    int tid = threadIdx.x; asm volatile("" : "+v"(tid));
    const int lane = tid & 63; const int w = __builtin_amdgcn_readfirstlane(tid >> 6);
    float* S = (float*)(ws + WS_SLOT + (size_t)slot * SLOT_BYTES);
#pragma unroll
    for (int d0 = 0; d0 < 4; ++d0)
#pragma unroll
        for (int r = 0; r < 16; ++r) S[((w * 4 + d0) * 16 + r) * 64 + lane] = o[d0][r];
    S[32768 + w * 64 + lane] = lsum;
}
__device__ __forceinline__ void b_load_partials(const unsigned char* ws, int slot0, int nc, f32x16 (&o)[4], float& lsum) {
    int tid = threadIdx.x; asm volatile("" : "+v"(tid));
    const int lane = tid & 63; const int w = __builtin_amdgcn_readfirstlane(tid >> 6);
#pragma unroll
    for (int d = 0; d < 4; ++d) o[d] = f32x16{};
    lsum = 0.f;
    for (int c = 0; c < nc; ++c) { const float* S = (const float*)(ws + WS_SLOT + (size_t)(slot0 + c) * SLOT_BYTES);
#pragma unroll
        for (int d0 = 0; d0 < 4; ++d0)
#pragma unroll
            for (int r = 0; r < 16; ++r) o[d0][r] += S[((w * 4 + d0) * 16 + r) * 64 + lane];
        lsum += S[32768 + w * 64 + lane]; }
}

#define GAS __attribute__((address_space(1)))
typedef GAS unsigned gu32;
typedef GAS unsigned long long gu64;
#define RLX_AGENT __ATOMIC_RELAXED, __HIP_MEMORY_SCOPE_AGENT
#define LDS_WAIT() asm volatile("s_waitcnt lgkmcnt(0)" ::: "memory")
#define VM_WAIT() asm volatile("s_waitcnt vmcnt(0)" ::: "memory")
__device__ __forceinline__ unsigned long long rt() { return __builtin_amdgcn_s_memrealtime(); }
#define XB_TMO      128
#define XB_XCNT(j)  (256  + 64 * (j))
#define XB_XSUB(j)  (1280 + 64 * (j))
#define XB_XGEN(j)  (2304 + 64 * (j))
#define XB_TOP      3328
#define XB_TOPGEN   3392
#define XCD_BAR_WORDS 3456
#define XB_SPIN_CAP (1u << 18)

__device__ __forceinline__ unsigned xb_ld(unsigned* p)              { return __hip_atomic_load(p, __ATOMIC_RELAXED, __HIP_MEMORY_SCOPE_AGENT); }
__device__ __forceinline__ unsigned xb_add(unsigned* p, unsigned v) { return __hip_atomic_fetch_add(p, v, __ATOMIC_RELAXED, __HIP_MEMORY_SCOPE_AGENT); }
__device__ __forceinline__ unsigned xb_xcc_id() { return (unsigned)__builtin_amdgcn_s_getreg((3 << 11) | 20) & 0xFu; }
#define XB_SPIN(cond, bar) do { unsigned _sp = 0; while (cond) { __builtin_amdgcn_s_sleep(1); \
    if ((++_sp & 255u) == 0u) { if (xb_ld(&(bar)[XB_TMO])) break; if (_sp > XB_SPIN_CAP) { atomicAdd(&(bar)[XB_TMO], 1u); break; } } } } while (0)

struct XcdBarrier {
    unsigned* bar; unsigned x;
    volatile LAS unsigned* st;
};

__device__ __forceinline__ XcdBarrier xcd_barrier_post(unsigned* bar, volatile LAS unsigned* st) {
    XcdBarrier b; b.bar = bar; b.x = xb_xcc_id(); b.st = st;
    if (threadIdx.x == 0) (void)xb_add(&bar[XB_XCNT(b.x)], 1u);
    return b;
}
__device__ __forceinline__ void xcd_barrier_complete(unsigned* bar, unsigned x, unsigned& nloc, unsigned& nx) {
    const unsigned G = gridDim.x * gridDim.y * gridDim.z;
    unsigned sum, cnt, mine, sp = 0u;
    for (;;) {
        sum = 0u; cnt = 0u; mine = 0u;
#pragma unroll
        for (unsigned j = 0; j < 16; ++j) { const unsigned c = xb_ld(&bar[XB_XCNT(j)]); sum += c; cnt += (c > 0u) ? 1u : 0u; mine = (j == x) ? c : mine; }
        if (sum == G) break;
        __builtin_amdgcn_s_sleep(1);
        if ((++sp & 255u) == 0u) { if (xb_ld(&bar[XB_TMO])) break; if (sp > XB_SPIN_CAP) { atomicAdd(&bar[XB_TMO], 1u); break; } }
    }
    nloc = mine > 0u ? mine : 1u; nx = cnt > 0u ? cnt : 1u;
}

__device__ __forceinline__ void xcd_barrier(const XcdBarrier& b) {
    asm volatile("s_waitcnt vmcnt(0)" ::: "memory");
    __syncthreads();
    if (threadIdx.x == 0) {
        unsigned* bar = b.bar;
        __builtin_amdgcn_s_waitcnt(0);
        unsigned nloc = b.st[0], nx = b.st[1];
        if (nloc == 0u) { xcd_barrier_complete(bar, b.x, nloc, nx); b.st[0] = nloc; b.st[1] = nx; }
        const unsigned old = xb_add(&bar[XB_XSUB(b.x)], 1u);
        const unsigned gen = old / nloc;
        if (old + 1u == (gen + 1u) * nloc) {
            __builtin_amdgcn_fence(__ATOMIC_RELEASE, "agent");
            asm volatile("s_waitcnt vmcnt(0)" ::: "memory");
            const unsigned og = xb_add(&bar[XB_TOP], 1u);
            const unsigned tg = og / nx;
            if (og + 1u == (tg + 1u) * nx) xb_add(&bar[XB_TOPGEN], 1u);
            else XB_SPIN(xb_ld(&bar[XB_TOPGEN]) == tg, bar);
            __builtin_amdgcn_fence(__ATOMIC_ACQUIRE, "agent");
            xb_add(&bar[XB_XGEN(b.x)], 1u);
            asm volatile("s_waitcnt vmcnt(0)" ::: "memory");
        } else {
            XB_SPIN(xb_ld(&bar[XB_XGEN(b.x)]) == gen, bar);
            __builtin_amdgcn_fence(__ATOMIC_ACQUIRE, "agent");
            asm volatile("s_waitcnt vmcnt(0)" ::: "memory");
        }
    }
    __syncthreads();
}

struct Args { const float* in[17]; float* out; unsigned char* ws; int ph_lo, ph_hi; };

__global__ void __launch_bounds__(NWAVES * 64, 2) hybrid_fwd(Args args) {
    extern __shared__ __attribute__((aligned(16))) unsigned char lds_raw[];
    LAS unsigned char* lds = (LAS unsigned char*)lds_raw;
    cg::grid_group grid = cg::this_grid();
    const int tid = threadIdx.x, lane = tid & 63; const int wave = __builtin_amdgcn_readfirstlane(tid >> 6);
    const int G = gridDim.x; const int bx = blockIdx.x; const int vcu = (G % 8 == 0) ? (bx % 8) * (G / 8) + bx / 8 : bx;
    unsigned char* ws = args.ws;
    bf16_t* WinT = (bf16_t*)(ws + WS_WIN); bf16_t* WuaT = (bf16_t*)(ws + WS_WUA); bf16_t* WubT = (bf16_t*)(ws + WS_WUB); bf16_t* WoT = (bf16_t*)(ws + WS_WO);
    bf16_t* XN = (bf16_t*)(ws + WS_XN);
    bf16_t* YA = (bf16_t*)args.out; bf16_t* YB = YA + (size_t)MTOK * AW;
    bf16_t* Pb = (bf16_t*)(ws + WS_P); float* T = (float*)(ws + WS_T); bf16_t* MIX = (bf16_t*)(ws + WS_MIX); bf16_t* Gt = (bf16_t*)(ws + WS_G);
    const int lo = args.ph_lo, hi = args.ph_hi;
    volatile LAS unsigned* bst = (volatile LAS unsigned*)(lds + 131072 + 352);
    if (tid < 2) bst[tid] = 0u;
    __syncthreads();
    XcdBarrier bar = xcd_barrier_post((unsigned*)ws + 4096, bst);
    if (hi > 1000) grid.sync();
#define IN(k) (lo <= (k) && (k) < hi)
#define SEAM(k) do { if (IN(k) && IN((k) + 1)) xcd_barrier(bar); } while (0)

    if (IN(0)) {
        LAS float* scr = (LAS float*)(lds + wave * 16384);
        const int gw = vcu * NWAVES + wave, NGW = G * NWAVES;
        constexpr int I_IN = (DM / 64) * (NIN / 32), I_UP = (AW / 64) * (DM / 32), I_O = (DM / 64) * (DM / 32);
        constexpr int NITEMS = I_IN + 2 * I_UP + I_O;
        for (int it = gw; it < NITEMS; it += NGW) {
            int r = it;
            if (r < I_IN) { p0_transpose_item<true>(args.in[3], DM, NIN, WinT, scr, r, lane); continue; } r -= I_IN;
            if (r < I_UP) { p0_transpose_item<false>(args.in[14], AW, DM, WuaT, scr, r, lane); continue; } r -= I_UP;
            if (r < I_UP) { p0_transpose_item<false>(args.in[15], BW, DM, WubT, scr, r, lane); continue; } r -= I_UP;
            p0_transpose_item<false>(args.in[16], DM, DM, WoT, scr, r, lane);
        }
        for (int m = gw; m < M1; m += 2 * NGW) {
            const int m2 = m + NGW; const bool has2 = (m2 < M1);
            const float* s0 = (m < MTOK) ? args.in[0] + (size_t)m * DM : ((m < MTOK + 16) ? args.in[1] + (size_t)(m - MTOK) * DM : nullptr);
            const float* s1 = !has2 ? nullptr : (m2 < MTOK) ? args.in[0] + (size_t)m2 * DM : ((m2 < MTOK + 16) ? args.in[1] + (size_t)(m2 - MTOK) * DM : nullptr);
            rms_rows2_to_bf16(s0, s1, args.in[2], XN + (size_t)m * DM, has2 ? XN + (size_t)m2 * DM : nullptr, lane);
        }
    }
    SEAM(0);
    const int p1_full = pg8::InOrder::NUNITS / G;
    const bool p1_split = (p1_full * G >= pg8::InOrder::NNG + pg8::InOrder::NMETA) && (pg8::InOrder::NUNITS % G != 0);
    if (IN(1)) {
        pg8::Gemm g{XN, WinT, M1, NIN, DM}; pg8::InOrder S{G, bx, 0, p1_split ? p1_full * G : pg8::InOrder::NUNITS};
        EpiIn E{Pb, Gt, args.in[4], args.in[5], args.in[7], args.in[8]};
        pg8::gemm_phase<EpiIn, pg8::InOrder, PG8_ALIGN, PG8_SP2>(lds, g, S, E);
    }
    SEAM(1);
    if (IN(2) && p1_split) {
        pg8::Gemm g{XN, WinT, M1, NIN, DM}; pg8::InOrder S{G, bx, p1_full, pg8::InOrder::NUNITS};
        EpiIn E{Pb, Gt, args.in[4], args.in[5], args.in[7], args.in[8]};
        pg8::gemm_phase<EpiIn, pg8::InOrder, PG8_ALIGN, PG8_SP2>(lds, g, S, E);
    }
    if (IN(2)) {
#define SCAL(x) __builtin_bit_cast(float, __builtin_amdgcn_readfirstlane(__builtin_bit_cast(int, (x))))
        const float knB = wave_max(fabsf(args.in[8][lane])), qnB = wave_max(fabsf(args.in[7][lane]));
        const float kmaxB = SCAL(8.0f * 1.02f * knB);
        const float kmaxA = SCAL(8.0f * 1.02f * wave_max(fabsf(args.in[5][lane])));
        const float lam = SCAL(__expf(wave_sum(args.in[9][lane] * args.in[10][lane])) - __expf(wave_sum(args.in[11][lane] * args.in[12][lane])) + LAM_INIT);
        const float mmaxB = SCAL(qnB * LOG2E * 1.02f * kmaxB);
        LAS int* incl = (LAS int*)(lds + TAB_OFF); LAS int* sincl = incl + 512; LAS int* order = sincl + 512; LAS int* keys = order + 512; LAS int* misc = keys + 512;
        int C = 1 << 20, myn, mync;
        { int ub, uh, uqb; unit_decode(tid, ub, uh, uqb); myn = 2 * uqb + 2 - b_tmin(uqb, b_window(uh, mmaxB)); }
        {
#pragma unroll 1
            for (int ci = 0; ci < 7; ++ci) {
                const int cd = ci < 4 ? 44 + 4 * ci : (ci == 4 ? 64 : (ci == 5 ? 88 : 176));
                const int nc_ = (myn + cd - 1) / cd;
                int v = nc_ > 1 ? nc_ : 0;
#pragma unroll
                for (int o_ = 1; o_ < 64; o_ <<= 1) v += __shfl_xor(v, o_);
                if (lane == 0) misc[8 + wave] = v;
                __syncthreads();
                int tot = 0;
#pragma unroll
                for (int k = 0; k < 8; ++k) tot += misc[8 + k];
                __syncthreads();
                if (tot <= SLOT_MAX) { C = cd; break; }
            }
        }
        {
            mync = (myn + C - 1) / C;
            const int myper = (myn + mync - 1) / mync, mykey = myper * 512 + (511 - tid);
            keys[tid] = mykey;
            __syncthreads();
            int rank = 0;
            for (int k = 0; k < 128; ++k) { const u32x4 kv = ((const LAS u32x4*)keys)[k]; rank += ((int)kv.x > mykey ? 1 : 0) + ((int)kv.y > mykey ? 1 : 0) + ((int)kv.z > mykey ? 1 : 0) + ((int)kv.w > mykey ? 1 : 0); }
            order[rank] = tid; incl[rank] = mync; sincl[rank] = mync > 1 ? mync : 0;
            __syncthreads();
            for (int d = 1; d < 512; d <<= 1) { const int a = tid >= d ? incl[tid - d] : 0, c = tid >= d ? sincl[tid - d] : 0; __syncthreads(); incl[tid] += a; sincl[tid] += c; __syncthreads(); }
        }
        const int NI = incl[511];
        unsigned* qctr = (unsigned*)ws + CW_QUEUE;
        for (;;) {
            if (tid == 0) misc[0] = (int)__hip_atomic_fetch_add(qctr, 1u, __ATOMIC_RELAXED, __HIP_MEMORY_SCOPE_AGENT);
            __syncthreads();
            const int it = misc[0];
            __syncthreads();
            if (it >= NI + 256) break;
            if (it < NI) {
                int lo_ = 0, hi_ = 511;
                while (lo_ < hi_) { const int mid = (lo_ + hi_) >> 1; if (incl[mid] > it) hi_ = mid; else lo_ = mid + 1; }
                const int p = lo_, jn = incl[p] - (p ? incl[p - 1] : 0), c = it - (incl[p] - jn);
                int ub, uh, uqb; unit_decode(order[p], ub, uh, uqb);
                const int tmin = b_tmin(uqb, b_window(uh, mmaxB)), n = 2 * uqb + 2 - tmin, per = (n + jn - 1) / jn;
                const int t0 = tmin + c * per, t1 = min(t0 + per - 1, 2 * uqb + 1);
                f32x16 o[4]; float lsum;
                attn_b_core(Pb, kmaxB, ub, uh, uqb, t0, t1, lds, o, lsum);
                if (jn == 1) attn_b_finalize(Pb, YB, args.in[13], lam, ub, uh, uqb, lds, o, lsum);
                else b_store_partial(ws, sincl[p] - jn + c, o, lsum);
            } else {
                const int au = it - NI, bk = au >> 6;
                attn_a_unit(Pb, YA, args.in[6], kmaxA, bk >> 1, bk & 1, 1 + (au & 63), lds);
            }
        }
        if (sincl[511] > 0) {
            xcd_barrier(bar);
            for (int p = bx; p < 512; p += G) {
                const int jn = incl[p] - (p ? incl[p - 1] : 0);
                if (jn > 1) { int ub, uh, uqb; unit_decode(order[p], ub, uh, uqb);
                    f32x16 o[4]; float lsum;
                    b_load_partials(ws, sincl[p] - jn, jn, o, lsum);
                    attn_b_finalize(Pb, YB, args.in[13], lam, ub, uh, uqb, lds, o, lsum); }
            }
        }
    }
    SEAM(2);
    if (IN(3)) {
        pg8::Gemm g{YA, WuaT, MTOK, DM, AW, YB, WubT}; pg8::StaticOrder2 S; S.init(MTOK, DM, G, bx); EpiUp E{Gt, MIX};
        pg8::gemm_phase<EpiUp, pg8::StaticOrder2, PG8_ALIGN, PG8_SP2>(lds, g, S, E);
    }
    SEAM(3);
    if (IN(4)) {
        pg8::Gemm g{MIX, WoT, MTOK, DM, DM}; pg8::StaticOrder S; S.init(MTOK, DM, G, bx); EpiOut E{args.in[0], args.out};
        pg8::gemm_phase<EpiOut, pg8::StaticOrder, PG8_ALIGN, PG8_SP2>(lds, g, S, E);
    }
#undef IN
#undef SEAM
}

extern "C" void kernel_launch(void* const* d_in, const int* in_sizes, int n_in, void* d_out, int out_size, void* d_ws, size_t ws_size, hipStream_t stream) {
    static int grid = 0;
    if (grid == 0) {
        if (n_in != 17 || ws_size < WS_END) { fprintf(stderr, "kernel_launch: unexpected inputs (n_in %d, ws %zu)\n", n_in, ws_size); grid = -1; return; }
        int dev = 0, cus = 0, per_cu = 0;
        hipGetDevice(&dev); hipDeviceGetAttribute(&cus, hipDeviceAttributeMultiprocessorCount, dev);
        if (hipFuncSetAttribute((const void*)hybrid_fwd, hipFuncAttributeMaxDynamicSharedMemorySize, LDS_BYTES) != hipSuccess) { fprintf(stderr, "kernel_launch: hipFuncSetAttribute failed\n"); grid = -1; return; }
        if (hipOccupancyMaxActiveBlocksPerMultiprocessor(&per_cu, (const void*)hybrid_fwd, NWAVES * 64, LDS_BYTES) != hipSuccess || per_cu < 1) { fprintf(stderr, "kernel_launch: occupancy query says %d\n", per_cu); per_cu = 1; }
        (void)hipGetLastError();
        grid = cus * 1;
        if (grid <= 0) grid = 256;
    }
    if (grid < 0) return;
    if (hipMemsetAsync(d_ws, 0, 65536, stream) != hipSuccess) { fprintf(stderr, "kernel_launch: memset failed\n"); return; }
    Args a{};
    for (int i = 0; i < 17; ++i) a.in[i] = (const float*)d_in[i];
    a.out = (float*)d_out; a.ws = (unsigned char*)d_ws;
#if MK_SPLIT
    for (int p = 0; p < 5; ++p) { a.ph_lo = p; a.ph_hi = p + 1; void* kargs[] = {&a};
        hipError_t e = hipLaunchCooperativeKernel((const void*)hybrid_fwd, dim3(grid), dim3(NWAVES * 64), kargs, LDS_BYTES, stream);
        if (e != hipSuccess) fprintf(stderr, "kernel_launch: launch %d failed: %s\n", p, hipGetErrorString(e)); }
#else
    a.ph_lo = 0; a.ph_hi = 5; void* kargs[] = {&a};
    hipError_t e = hipLaunchCooperativeKernel((const void*)hybrid_fwd, dim3(grid), dim3(NWAVES * 64), kargs, LDS_BYTES, stream);
    if (e != hipSuccess) fprintf(stderr, "kernel_launch: cooperative launch failed: %s (grid %d)\n", hipGetErrorString(e), grid);
#endif
}
```

```cpp
#include <hip/hip_cooperative_groups.h>
#include <hip/hip_runtime.h>
#include <cstdio>
#include <cstdint>
namespace pg8 {
#define PG8_LAS __attribute__((address_space(3)))
typedef unsigned short bf16_t;
typedef short bf16x8 __attribute__((ext_vector_type(8)));
typedef float f32x4 __attribute__((ext_vector_type(4)));
typedef unsigned u32x4 __attribute__((ext_vector_type(4)));
constexpr int BM = 256, BK = 64, HALF = 128, HTB = HALF * BK * 2  , STAGE_BYTES = 8 * HTB, NXCD = 8, WGM = 8;

__host__ __device__ __forceinline__ int lds_byte(int r, int c) { const int st = (r >> 4) * 2 + (c >> 5), rr = r & 15, cc = c & 31, ob = rr * 64 + cc * 2; return st * 1024 + (ob ^ (((ob >> 9) & 1) << 5)); }
__host__ __device__ __forceinline__ void stage_rc(int b, int& R, int& C) { const int st = b / 1024, sb = b % 1024, swz = sb ^ (((sb >> 9) & 1) << 5); R = (st >> 1) * 16 + swz / 64; C = (st & 1) * 32 + (swz % 64) / 2; }
__host__ __device__ __forceinline__ int perm32(int rho) { const int n = rho >> 4, i = rho & 15; return 8 * (i >> 2) + 4 * n + (i & 3); }

struct Unit { int pm, pn, seg; };
struct Gemm { const bf16_t* A; const bf16_t* Bt; int M, N, K; const bf16_t* A2; const bf16_t* Bt2; };

struct StaticOrder {
    int nM, nN, nwg, G, c;
    __host__ __device__ void init(int M, int N, int G_, int c_) { nM = M / BM; nN = N / BM; nwg = nM * nN; G = G_; c = c_; }
    __host__ __device__ bool next(int i, Unit& u) const {
        const long L = (long)i * G + c; if (L >= nwg) return false;
        int wgid = (int)L; { const int q = nwg / NXCD, r = nwg % NXCD, xcd = wgid % NXCD, off = wgid / NXCD; wgid = (xcd < r ? xcd * (q + 1) : r * (q + 1) + (xcd - r) * q) + off; }
        const int nig = WGM * nN, gid = wgid / nig, fm = gid * WGM, gsz = (nM - fm) < WGM ? (nM - fm) : WGM;
        u.pm = fm + ((wgid % nig) % gsz); u.pn = (wgid % nig) / gsz; u.seg = 0; return true;
    }
    __device__ __forceinline__ void a_ready(const Unit&) const {}
    __device__ __forceinline__ void done(const Unit&) const {}
};

struct InOrder { int G, c, i0, lim;
    static constexpr int NNG = 832, NMETA = 13, NGATE = 512, NUNITS = NNG + NMETA + NGATE;
    __host__ __device__ bool next(int i, Unit& u) const {
        const int L = (i + i0) * G + c; if (L >= lim) return false;
        u.seg = 0;
        if (L < NNG) { const int x = L & 7, k = L >> 3; u.pn = k >> 3; u.pm = x + 8 * (k & 7); }
        else if (L < NNG + NMETA) { u.pm = 64; u.pn = L - NNG; }
        else { const int L2 = L - (NNG + NMETA) + 5; const int x = L2 & 7; int k = L2 >> 3; if (k == 64) k = 0; u.pn = 13 + (k >> 3); u.pm = x + 8 * (k & 7); }
        return true;
    }
    __device__ __forceinline__ void a_ready(const Unit&) const {}
    __device__ __forceinline__ void done(const Unit&) const {}
};
struct StaticOrder2 { StaticOrder base;
    __host__ __device__ void init(int M, int N, int G_, int c_) { base.init(M, N, G_, c_); }
    __host__ __device__ bool next(int i, Unit& u) const { if (!base.next(i >> 1, u)) return false; u.seg = i & 1; return true; }
    __device__ __forceinline__ void a_ready(const Unit&) const {}
    __device__ __forceinline__ void done(const Unit&) const {}
};
__device__ __forceinline__ unsigned cvt_pk_bf16(float lo, float hi) { unsigned r; asm volatile("v_cvt_pk_bf16_f32 %0, %1, %2" : "=v"(r) : "v"(lo), "v"(hi)); return r; }
typedef float f32x2 __attribute__((ext_vector_type(2)));
__device__ __forceinline__ f32x2 gelu_pk(f32x2 v) {
    const f32x2 av = __builtin_elementwise_abs(v), d = av * 0.2316418882f + 1.0f;
    f32x2 t; t.x = __builtin_amdgcn_rcpf(d.x); t.y = __builtin_amdgcn_rcpf(d.y);
    f32x2 q = t * 0.5307027145f + (-0.7265760135f); q = q * t + 0.7107068705f; q = q * t + (-0.142248368f); q = q * t + 0.127414796f; q = q * t;
    const f32x2 s = (v * v) * (-0.72134752044f);
    f32x2 e; e.x = __builtin_amdgcn_exp2f(s.x); e.y = __builtin_amdgcn_exp2f(s.y);
    const f32x2 m = v * (q * e), r = v - m;
    f32x2 o; o.x = v.x < 0.f ? m.x : r.x; o.y = v.y < 0.f ? m.y : r.y; return o;
}

template <int ACT  > struct EpiBf16 {
    static constexpr bool PERM = true, AFTER_DRAIN = false, TWO_SEG = false, INIT_ACC = false; static_assert(ACT == 0 || ACT == 1, "EpiBf16: ACT is 0 (none) or 1 (gelu_pk)");
    bf16_t* O; int ldc; const float* bias; int split_cols; size_t split_stride; float scale0;
    __device__ __forceinline__ void operator()(const f32x4 (&acc)[2][2][4][2], const Unit& u, int wr, int wc, int fr, int fq) const {
        const int row0 = u.pm * BM + wr * 64 + fr; int colt = u.pn * BM; bf16_t* base = O;
        float sc = 1.f; if (split_cols) { const int t = colt / split_cols; base += (size_t)t * split_stride; colt -= t * split_cols; if (t == 0) sc = scale0; }
        const int col0 = colt + wc * 32 + 8 * fq, bcol0 = u.pn * BM + wc * 32 + 8 * fq;
        f32x4 bv[2][2];
#pragma unroll
        for (int bj = 0; bj < 2; ++bj)
#pragma unroll
            for (int n = 0; n < 2; ++n) bv[bj][n] = bias ? *(const f32x4*)(bias + bcol0 + bj * HALF + 4 * n) : (f32x4){0.f, 0.f, 0.f, 0.f};
#pragma unroll
        for (int ai = 0; ai < 2; ++ai)
#pragma unroll
            for (int m = 0; m < 4; ++m) { bf16_t* rowp = base + (size_t)(row0 + ai * HALF + m * 16) * ldc + col0;
#pragma unroll
                for (int bj = 0; bj < 2; ++bj) { f32x4 v0 = acc[ai][bj][m][0] + bv[bj][0], v1 = acc[ai][bj][m][1] + bv[bj][1];
                    if (ACT == 1) { f32x2 a = gelu_pk((f32x2){v0[0], v0[1]}), b = gelu_pk((f32x2){v0[2], v0[3]}), c = gelu_pk((f32x2){v1[0], v1[1]}), d = gelu_pk((f32x2){v1[2], v1[3]});
                        v0 = (f32x4){a.x, a.y, b.x, b.y}; v1 = (f32x4){c.x, c.y, d.x, d.y}; }
                    v0 = v0 * sc; v1 = v1 * sc; u32x4 w; w.x = cvt_pk_bf16(v0[0], v0[1]); w.y = cvt_pk_bf16(v0[2], v0[3]); w.z = cvt_pk_bf16(v1[0], v1[1]); w.w = cvt_pk_bf16(v1[2], v1[3]);
                    *(u32x4*)(rowp + bj * HALF) = w; } }
    }
};

template <class Epi, class Sched, bool ALIGN_EPI = false, bool SP2 = false>
__device__ __forceinline__ void gemm_phase(PG8_LAS unsigned char* lds, const Gemm g, const Sched& S, const Epi& E) {
    const int tid = threadIdx.x, wid = __builtin_amdgcn_readfirstlane(tid >> 6), lane = tid & 63, wr = wid >> 2, wc = wid & 3, fr = lane & 15, fq = lane >> 4;
    const int K = g.K, nt = K / BK;
    unsigned voffA[2], voffB[2];
#pragma unroll
    for (int i = 0; i < 2; ++i) { int R, C; stage_rc(tid * 16 + i * 8192, R, C); const int Rb = Epi::PERM ? ((R & ~31) + perm32(R & 31)) : R;
        voffA[i] = (unsigned)(R * K + C) * 2u; voffB[i] = (unsigned)(Rb * K + C) * 2u; }
    const size_t kstep = (size_t)(BK * 2);
    const size_t hstep = (size_t)HALF * K * 2;
    const size_t tstep = 2 * hstep;
    const unsigned ldsw = (unsigned)wid * 1024u;
    const int aoff = lds_byte(wr * 64 + fr, fq * 8), boff = lds_byte(wc * 32 + fr, fq * 8);
#define PG8_SA(b, h) (((b) * 2 + (h)) * HTB)
#define PG8_SB(b, h) ((4 + (b) * 2 + (h)) * HTB)
#define PG8_STAGE(bufoff, gbase, voff) do { _Pragma("unroll") for (int _i = 0; _i < 2; ++_i) \
        __builtin_amdgcn_global_load_lds((const unsigned*)((const char*)(gbase) + (voff)[_i]), (PG8_LAS unsigned*)(lds + (bufoff) + ldsw + _i * 8192), 16, 0, 0); } while (0)
#define PG8_LDA(dst, b, h) do { _Pragma("unroll") for (int m = 0; m < 4; ++m) _Pragma("unroll") for (int k = 0; k < 2; ++k) dst[m][k] = *(const PG8_LAS bf16x8*)(lds + PG8_SA(b, h) + aoff + m * 2048 + k * 1024); } while (0)
#define PG8_LDB(dst, b, h) do { _Pragma("unroll") for (int n = 0; n < 2; ++n) _Pragma("unroll") for (int k = 0; k < 2; ++k) dst[n][k] = *(const PG8_LAS bf16x8*)(lds + PG8_SB(b, h) + boff + n * 2048 + k * 1024); } while (0)
#define PG8_MMA(ai, bj, At, Bt) do { __builtin_amdgcn_s_setprio(1); _Pragma("unroll") for (int m = 0; m < 4; ++m) _Pragma("unroll") for (int n = 0; n < 2; ++n) _Pragma("unroll") for (int k = 0; k < 2; ++k) \
        acc[ai][bj][m][n] = __builtin_amdgcn_mfma_f32_16x16x32_bf16(Bt[n][k], At[m][k], acc[ai][bj][m][n], 0, 0, 0); __builtin_amdgcn_s_setprio(0); } while (0)
#define PG8_WAIT_V(n) asm volatile("s_waitcnt vmcnt(" #n ")" ::: "memory")
#define PG8_WAIT_L(n) asm volatile("s_waitcnt lgkmcnt(" #n ")" ::: "memory")
#define PG8_BAR __builtin_amdgcn_s_barrier()
#define PG8_SCHED __builtin_amdgcn_sched_barrier(0)
    Unit cur, nxt; int ui = 0;
    if (!S.next(0, cur)) return;
    f32x4 acc[2][2][4][2];
    if constexpr (Epi::INIT_ACC) E.init(acc, cur, wr, wc, fr, fq);
    else
#pragma unroll
    for (int a = 0; a < 2; ++a)
#pragma unroll
        for (int b = 0; b < 2; ++b)
#pragma unroll
            for (int m = 0; m < 4; ++m)
#pragma unroll
                for (int n = 0; n < 2; ++n) acc[a][b][m][n] = (f32x4){0.f, 0.f, 0.f, 0.f};
    bf16x8 At[4][2], B0[2][2], B1[2][2];
    const char* cA = (const char*)(cur.seg ? g.A2 : g.A) + (size_t)cur.pm * tstep; const char* cB = (const char*)(cur.seg ? g.Bt2 : g.Bt) + (size_t)cur.pn * tstep;
    S.a_ready(cur);
    if constexpr (SP2) {
        PG8_STAGE(PG8_SB(0, 0), cB, voffB); PG8_STAGE(PG8_SB(0, 1), cB + hstep, voffB); PG8_STAGE(PG8_SA(0, 0), cA, voffA); PG8_STAGE(PG8_SA(0, 1), cA + hstep, voffA);
        if (wr == 1) PG8_BAR;
        PG8_WAIT_V(2); PG8_BAR;
        PG8_STAGE(PG8_SB(1, 0), cB + kstep, voffB); PG8_STAGE(PG8_SA(1, 0), cA + kstep, voffA); PG8_STAGE(PG8_SB(1, 1), cB + hstep + kstep, voffB);
        PG8_WAIT_V(6); PG8_BAR;
    } else {
        PG8_STAGE(PG8_SB(0, 0), cB, voffB); PG8_STAGE(PG8_SA(0, 0), cA, voffA); PG8_STAGE(PG8_SB(0, 1), cB + hstep, voffB); PG8_STAGE(PG8_SA(0, 1), cA + hstep, voffA);
        if (wr == 1) PG8_BAR;
        PG8_WAIT_V(4); PG8_BAR;
        PG8_STAGE(PG8_SB(1, 0), cB + kstep, voffB); PG8_STAGE(PG8_SA(1, 0), cA + kstep, voffA); PG8_STAGE(PG8_SB(1, 1), cB + hstep + kstep, voffB);
        PG8_WAIT_V(6); PG8_BAR;
    }
    for (;;) {
        const bool has_next = S.next(ui + 1, nxt);
        const char* nA = has_next ? (const char*)(nxt.seg ? g.A2 : g.A) + (size_t)nxt.pm * tstep : cA; const char* nB = has_next ? (const char*)(nxt.seg ? g.Bt2 : g.Bt) + (size_t)nxt.pn * tstep : cB;
        for (int t = 0; t < nt; t += 2) {
            const bool last = (t == nt - 2);
            const char* a1 = cA + (size_t)(t + 1) * kstep;
            const char* a2 = last ? nA : cA + (size_t)(t + 2) * kstep; const char* b2 = last ? nB : cB + (size_t)(t + 2) * kstep;
            const char* a3 = a2 + kstep; const char* b3 = b2 + kstep;
            if (last && has_next) S.a_ready(nxt);
            if constexpr (SP2) {
            PG8_LDB(B0, 0, 0); PG8_LDB(B1, 0, 1); PG8_SCHED; PG8_LDA(At, 0, 0); PG8_STAGE(PG8_SA(1, 1), a1 + hstep, voffA);
            PG8_WAIT_V(8); PG8_WAIT_L(0); PG8_BAR; PG8_MMA(0, 0, At, B0); PG8_MMA(0, 1, At, B1); PG8_BAR; PG8_SCHED;
            PG8_LDA(At, 0, 1); PG8_STAGE(PG8_SB(0, 0), b2, voffB); PG8_STAGE(PG8_SB(0, 1), b2 + hstep, voffB); PG8_STAGE(PG8_SA(0, 0), a2, voffA);
            PG8_WAIT_V(8); PG8_WAIT_L(0); PG8_BAR; PG8_MMA(1, 0, At, B0); PG8_MMA(1, 1, At, B1); PG8_BAR; PG8_SCHED;
            PG8_LDB(B0, 1, 0); PG8_LDB(B1, 1, 1); PG8_SCHED; PG8_LDA(At, 1, 0); PG8_STAGE(PG8_SA(0, 1), a2 + hstep, voffA);
            PG8_WAIT_V(8); PG8_WAIT_L(0); PG8_BAR; PG8_MMA(0, 0, At, B0); PG8_MMA(0, 1, At, B1); PG8_BAR; PG8_SCHED;
            PG8_LDA(At, 1, 1); PG8_STAGE(PG8_SB(1, 0), b3, voffB); PG8_STAGE(PG8_SB(1, 1), b3 + hstep, voffB); PG8_STAGE(PG8_SA(1, 0), a3, voffA);
            PG8_WAIT_V(8); PG8_WAIT_L(0); PG8_BAR; PG8_MMA(1, 0, At, B0); PG8_MMA(1, 1, At, B1); PG8_BAR; PG8_SCHED;
            } else {
            PG8_LDB(B0, 0, 0); PG8_SCHED; PG8_LDA(At, 0, 0); PG8_STAGE(PG8_SA(1, 1), a1 + hstep, voffA);
            PG8_WAIT_L(8); PG8_BAR; PG8_WAIT_L(0); PG8_MMA(0, 0, At, B0); PG8_BAR; PG8_SCHED;
            PG8_LDB(B1, 0, 1); PG8_STAGE(PG8_SB(0, 0), b2, voffB);
            PG8_BAR; PG8_WAIT_L(0); PG8_MMA(0, 1, At, B1); PG8_BAR;
            PG8_LDA(At, 0, 1); PG8_STAGE(PG8_SA(0, 0), a2, voffA);
            PG8_BAR; PG8_WAIT_L(0); PG8_MMA(1, 0, At, B0); PG8_BAR; PG8_SCHED;
            PG8_STAGE(PG8_SB(0, 1), b2 + hstep, voffB);
            PG8_WAIT_V(6); PG8_BAR; PG8_MMA(1, 1, At, B1); PG8_BAR;
            PG8_LDB(B0, 1, 0); PG8_SCHED; PG8_LDA(At, 1, 0); PG8_STAGE(PG8_SA(0, 1), a2 + hstep, voffA);
            PG8_WAIT_L(8); PG8_BAR; PG8_WAIT_L(0); PG8_MMA(0, 0, At, B0); PG8_BAR; PG8_SCHED;
            PG8_LDB(B1, 1, 1); PG8_STAGE(PG8_SB(1, 0), b3, voffB);
            PG8_BAR; PG8_WAIT_L(0); PG8_MMA(0, 1, At, B1); PG8_BAR;
            PG8_LDA(At, 1, 1); PG8_STAGE(PG8_SA(1, 0), a3, voffA);
            PG8_BAR; PG8_WAIT_L(0); PG8_MMA(1, 0, At, B0); PG8_BAR; PG8_SCHED;
            PG8_STAGE(PG8_SB(1, 1), b3 + hstep, voffB);
            PG8_WAIT_V(6); PG8_BAR; PG8_MMA(1, 1, At, B1); PG8_BAR;
            }
        }
        if constexpr (ALIGN_EPI) { if (wr == 0) PG8_BAR; }
        bool keep = false;
        if constexpr (Epi::TWO_SEG) { if (cur.seg == 0) { E.mid(acc, cur, wr, wc, fr, fq); keep = true; } }
        if (!keep) if constexpr (!Epi::AFTER_DRAIN) { E(acc, cur, wr, wc, fr, fq); S.done(cur); }
        if (!has_next) break;
        if constexpr (Epi::INIT_ACC) { if (!keep) E.init(acc, nxt, wr, wc, fr, fq); }
        else if (!keep)
#pragma unroll
        for (int a = 0; a < 2; ++a)
#pragma unroll
            for (int b = 0; b < 2; ++b)
#pragma unroll
                for (int m = 0; m < 4; ++m)
#pragma unroll
                    for (int n = 0; n < 2; ++n) acc[a][b][m][n] = (f32x4){0.f, 0.f, 0.f, 0.f};
        cur = nxt; cA = nA; cB = nB; ++ui;
        if constexpr (ALIGN_EPI) { if (wr == 1) PG8_BAR; }
    }
    PG8_WAIT_V(0);
    if constexpr (!ALIGN_EPI) { if (wr == 0) PG8_BAR; }
    PG8_BAR;
    if constexpr (Epi::AFTER_DRAIN) { E.fused(acc, cur, wr, wc, fr, fq, lds, wid, lane); S.done(cur); }
#undef PG8_SA
#undef PG8_SB
#undef PG8_STAGE
#undef PG8_LDA
#undef PG8_LDB
#undef PG8_MMA
#undef PG8_WAIT_V
#undef PG8_WAIT_L
#undef PG8_BAR
#undef PG8_SCHED
}
}

#ifndef PG8_SP2
#define PG8_SP2 true
#endif
#ifndef PG8_ALIGN
#define PG8_ALIGN true
#endif

namespace cg = cooperative_groups;
#define LAS __attribute__((address_space(3)))
typedef unsigned short bf16_t;
typedef short bf16x8 __attribute__((ext_vector_type(8)));
typedef short s16x4 __attribute__((ext_vector_type(4)));
typedef float f32x4 __attribute__((ext_vector_type(4)));
typedef float f32x16 __attribute__((ext_vector_type(16)));
typedef unsigned u32x4 __attribute__((ext_vector_type(4)));
typedef unsigned u32x2 __attribute__((ext_vector_type(2)));
typedef float f32x2_t __attribute__((ext_vector_type(2)));
typedef __bf16 bf16x2_t __attribute__((ext_vector_type(2)));

#ifndef MK_SPLIT
#define MK_SPLIT 0
#endif

constexpr int NWAVES = 8;
constexpr int DM = 1024, SEQ = 8192, NBATCH = 2, LP = 8320, MTOK = 16384, M1 = 16640, NIN = 5376, PP = 3328, GW = 2048;
constexpr int AW = 512, BW = 512;
constexpr float RMS_EPS = 1e-6f, LOG2E = 1.4426950408889634f;
constexpr float QSCALE = 0.125f * LOG2E;
constexpr float LAM_INIT = 0.2f;

constexpr size_t MiB = 1u << 20;
constexpr size_t WS_WIN = 1 * MiB, WS_WUA = 12 * MiB, WS_WUB = 13 * MiB, WS_WO = 14 * MiB;
constexpr size_t WS_XN = 16 * MiB, WS_YA = 16 * MiB, WS_YB = 32 * MiB;
constexpr size_t WS_P = 49 * MiB, WS_T = 49 * MiB, WS_MIX = 113 * MiB;
constexpr size_t WS_G = 155 * MiB, WS_END = 219 * MiB;
static_assert(WS_XN + (size_t)M1 * DM * 2 <= WS_P && WS_P + (size_t)M1 * PP * 2 <= WS_G && WS_MIX + (size_t)MTOK * DM * 2 <= WS_G, "ws map");

constexpr int LDS_BYTES = 147456;

__device__ __forceinline__ unsigned f2bf(float f) { unsigned u = __builtin_bit_cast(unsigned, f); return (u + 0x7fffu + ((u >> 16) & 1u)) >> 16; }
__device__ __forceinline__ unsigned pk2(float lo, float hi) { f32x2_t v = {lo, hi}; bf16x2_t b = __builtin_convertvector(v, bf16x2_t); return __builtin_bit_cast(unsigned, b); }
__device__ __forceinline__ float bf2f(unsigned short u) { return __builtin_bit_cast(float, (unsigned)u << 16); }
__device__ __forceinline__ float bflo(unsigned u) { return __builtin_bit_cast(float, u << 16); }
__device__ __forceinline__ float bfhi(unsigned u) { return __builtin_bit_cast(float, u & 0xffff0000u); }
__device__ __forceinline__ float wave_sum(float v) {
#pragma unroll
    for (int o = 1; o < 64; o <<= 1) v += __shfl_xor(v, o);
    return v;
}
__device__ __forceinline__ float wave_max(float v) {
#pragma unroll
    for (int o = 1; o < 64; o <<= 1) v = fmaxf(v, __shfl_xor(v, o));
    return v;
}
__device__ __forceinline__ float fast_exp2(float x) { return __builtin_amdgcn_exp2f(x); }
__device__ __forceinline__ float sigmoidf_(float x) { return __builtin_amdgcn_rcpf(1.0f + fast_exp2(-x * LOG2E)); }

__device__ __forceinline__ int perm_in_col(int c) { const int pn = c >> 8, rem = c & 255, wc = rem >> 6, bj = (rem >> 5) & 1, j = rem & 31; return (pn << 8) + 128 * bj + 32 * wc + j; }

template <bool PERMCOL>
__device__ __forceinline__ void p0_transpose_item(const float* W, int K, int N, bf16_t* WT, LAS float* scr, int item, int lane) {
    const int nblk = N / 32, kb = item / nblk, nb = item % nblk, k0 = 64 * kb, n0 = 32 * nb;
    { f32x4 wv[8];
#pragma unroll
      for (int i = 0; i < 8; ++i) wv[i] = __builtin_nontemporal_load((const f32x4*)(W + (size_t)(k0 + 8 * i + (lane >> 3)) * N + n0 + 4 * (lane & 7)));
#pragma unroll
      for (int i = 0; i < 8; ++i) { LAS float* d = scr + (8 * i + (lane >> 3)) * 33 + 4 * (lane & 7); d[0] = wv[i].x; d[1] = wv[i].y; d[2] = wv[i].z; d[3] = wv[i].w; } }
    asm volatile("s_waitcnt lgkmcnt(0)" ::: "memory");
    const int c = lane & 7;
#pragma unroll
    for (int j = 0; j < 4; ++j) { const int n = (lane >> 3) + 8 * j; const LAS float* s = scr + (8 * c) * 33 + n;
        u32x4 o; o.x = pk2(s[0 * 33], s[1 * 33]); o.y = pk2(s[2 * 33], s[3 * 33]); o.z = pk2(s[4 * 33], s[5 * 33]); o.w = pk2(s[6 * 33], s[7 * 33]);
        const int drow = PERMCOL ? perm_in_col(n0 + n) : (n0 + n);
        *(u32x4*)(WT + (size_t)drow * K + k0 + 8 * c) = o; }
    asm volatile("s_waitcnt lgkmcnt(0)" ::: "memory");
}
__device__ __forceinline__ void rms_rows2_to_bf16(const float* x0, const float* x1, const float* g, bf16_t* o0, bf16_t* o1, int lane) {
    const f32x4 z4 = {0.f, 0.f, 0.f, 0.f};
    f32x4 v0[4], v1[4];
#pragma unroll
    for (int j = 0; j < 4; ++j) { v0[j] = x0 ? __builtin_nontemporal_load((const f32x4*)x0 + lane + 64 * j) : z4; v1[j] = x1 ? __builtin_nontemporal_load((const f32x4*)x1 + lane + 64 * j) : z4; }
    float s0 = 0.f, s1 = 0.f;
#pragma unroll
    for (int j = 0; j < 4; ++j) { s0 += (v0[j].x * v0[j].x + v0[j].y * v0[j].y) + (v0[j].z * v0[j].z + v0[j].w * v0[j].w); s1 += (v1[j].x * v1[j].x + v1[j].y * v1[j].y) + (v1[j].z * v1[j].z + v1[j].w * v1[j].w); }
#pragma unroll
    for (int o = 1; o < 64; o <<= 1) { s0 += __shfl_xor(s0, o); s1 += __shfl_xor(s1, o); }
    const float r0 = 1.0f / sqrtf(s0 * (1.f / DM) + RMS_EPS), r1 = 1.0f / sqrtf(s1 * (1.f / DM) + RMS_EPS);
    unsigned long long* p0 = (unsigned long long*)o0 + lane; unsigned long long* p1 = (unsigned long long*)o1 + lane;
#pragma unroll
    for (int j = 0; j < 4; ++j) { const f32x4 gg = ((const f32x4*)g)[lane + 64 * j]; const f32x4 y0 = v0[j] * r0 * gg, y1 = v1[j] * r1 * gg;
        p0[64 * j] = (unsigned long long)pk2(y0.x, y0.y) | ((unsigned long long)pk2(y0.z, y0.w) << 32);
        if (o1) p1[64 * j] = (unsigned long long)pk2(y1.x, y1.y) | ((unsigned long long)pk2(y1.z, y1.w) << 32); }
}

struct EpiIn {
    static constexpr bool PERM = true, AFTER_DRAIN = false, TWO_SEG = false, INIT_ACC = false;
    bf16_t* P; bf16_t* G; const float* aqn; const float* akn; const float* bqn; const float* bkn;
    __device__ __forceinline__ void operator()(const f32x4 (&acc)[2][2][4][2], const pg8::Unit& u, int wr, int wc, int fr, int fq) const {
        const int c64 = u.pn * 4 + wc;
        const float* gp = nullptr; float gscale = 1.f;
        if (c64 < 8) { gp = aqn; gscale = QSCALE; } else if (c64 < 10) gp = akn; else if (c64 >= 20 && c64 < 28) { gp = bqn; gscale = QSCALE; } else if (c64 >= 28 && c64 < 36) gp = bkn;
        const int mode = gp ? 1 : (((c64 >= 12 && c64 < 20) || (c64 >= 44 && c64 < 52)) ? 2 : (c64 >= 52 ? 3 : 0));
        f32x4 gv[2][2];
#pragma unroll
        for (int bj = 0; bj < 2; ++bj)
#pragma unroll
            for (int n = 0; n < 2; ++n) gv[bj][n] = gp ? *(const f32x4*)(gp + 32 * bj + 8 * fq + 4 * n) * gscale : (f32x4){1.f, 1.f, 1.f, 1.f};
        const bool meta = (u.pm >= 64);
#pragma unroll
        for (int ai = 0; ai < 2; ++ai)
#pragma unroll
            for (int m = 0; m < 4; ++m) {
                const int r = u.pm * 256 + ai * 128 + wr * 64 + m * 16 + fr;
                f32x4 v[2][2];
#pragma unroll
                for (int bj = 0; bj < 2; ++bj)
#pragma unroll
                    for (int n = 0; n < 2; ++n) v[bj][n] = acc[ai][bj][m][n];
                if (mode == 1) {
                    float ss = 0.f;
#pragma unroll
                    for (int bj = 0; bj < 2; ++bj)
#pragma unroll
                        for (int n = 0; n < 2; ++n) { const f32x4 x = v[bj][n]; ss += (x[0] * x[0] + x[1] * x[1]) + (x[2] * x[2] + x[3] * x[3]); }
                    ss += __shfl_xor(ss, 16); ss += __shfl_xor(ss, 32);
                    const float rs = 1.0f / sqrtf(ss * (1.f / 64.f) + RMS_EPS);
#pragma unroll
                    for (int bj = 0; bj < 2; ++bj)
#pragma unroll
                        for (int n = 0; n < 2; ++n) v[bj][n] = v[bj][n] * rs * gv[bj][n];
                } else if (mode == 2) {
#pragma unroll
                    for (int bj = 0; bj < 2; ++bj)
#pragma unroll
                        for (int n = 0; n < 2; ++n)
#pragma unroll
                            for (int e = 0; e < 4; ++e) v[bj][n][e] = v[bj][n][e] * sigmoidf_(v[bj][n][e]);
                } else if (mode == 3) {
#pragma unroll
                    for (int bj = 0; bj < 2; ++bj)
#pragma unroll
                        for (int n = 0; n < 2; ++n)
#pragma unroll
                            for (int e = 0; e < 4; ++e) v[bj][n][e] = sigmoidf_(v[bj][n][e]);
                }
#pragma unroll
                for (int bj = 0; bj < 2; ++bj) {
                    u32x4 w; w.x = pk2(v[bj][0][0], v[bj][0][1]); w.y = pk2(v[bj][0][2], v[bj][0][3]); w.z = pk2(v[bj][1][0], v[bj][1][1]); w.w = pk2(v[bj][1][2], v[bj][1][3]);
                    if (c64 < 52) {
                        const int col = c64 * 64 + 32 * bj + 8 * fq;
                        if (!meta) { const int prow = r + 128 * ((r >> 13) + 1); *(u32x4*)(P + (size_t)prow * PP + col) = w; }
                        else { const int i = r - MTOK; if (i < 128) { const int tp = (i + 112) & 127; *(u32x4*)(P + (size_t)tp * PP + col) = w; *(u32x4*)(P + (size_t)(LP + tp) * PP + col) = w; } }
                    } else if (!meta) {
                        *(u32x4*)(G + (size_t)r * GW + (c64 - 52) * 64 + 32 * bj + 8 * fq) = w;
                    }
                }
            }
    }
};

struct EpiUp {
    static constexpr bool PERM = true, AFTER_DRAIN = false, TWO_SEG = true, INIT_ACC = false;
    const bf16_t* G; bf16_t* MIX;
    __device__ __forceinline__ void mid(f32x4 (&acc)[2][2][4][2], const pg8::Unit& u, int wr, int wc, int fr, int fq) const {
#pragma unroll
        for (int ai = 0; ai < 2; ++ai)
#pragma unroll
            for (int m = 0; m < 4; ++m) { const int r = u.pm * 256 + ai * 128 + wr * 64 + m * 16 + fr;
#pragma unroll
                for (int bj = 0; bj < 2; ++bj) { const int c0 = u.pn * 256 + 128 * bj + 32 * wc + 8 * fq;
                    const u32x4 ga = *(const u32x4*)(G + (size_t)r * GW + c0), gb = *(const u32x4*)(G + (size_t)r * GW + DM + c0);
                    f32x4& a = acc[ai][bj][m][0]; f32x4& b = acc[ai][bj][m][1];
#define RAT(x, y) ((x) * __builtin_amdgcn_rcpf(fmaxf((y), 1e-30f)))
                    a[0] *= RAT(bflo(ga.x), bflo(gb.x)); a[1] *= RAT(bfhi(ga.x), bfhi(gb.x)); a[2] *= RAT(bflo(ga.y), bflo(gb.y)); a[3] *= RAT(bfhi(ga.y), bfhi(gb.y));
                    b[0] *= RAT(bflo(ga.z), bflo(gb.z)); b[1] *= RAT(bfhi(ga.z), bfhi(gb.z)); b[2] *= RAT(bflo(ga.w), bflo(gb.w)); b[3] *= RAT(bfhi(ga.w), bfhi(gb.w));
#undef RAT
                } }
    }
    __device__ __forceinline__ void operator()(const f32x4 (&acc)[2][2][4][2], const pg8::Unit& u, int wr, int wc, int fr, int fq) const {
#pragma unroll
        for (int ai = 0; ai < 2; ++ai)
#pragma unroll
            for (int m = 0; m < 4; ++m) { const int r = u.pm * 256 + ai * 128 + wr * 64 + m * 16 + fr;
#pragma unroll
                for (int bj = 0; bj < 2; ++bj) { const int c0 = u.pn * 256 + 128 * bj + 32 * wc + 8 * fq;
                    const u32x4 g = *(const u32x4*)(G + (size_t)r * GW + DM + c0);
                    const f32x4 a = acc[ai][bj][m][0], b = acc[ai][bj][m][1];
                    u32x4 w; w.x = pk2(a[0] * bflo(g.x), a[1] * bfhi(g.x)); w.y = pk2(a[2] * bflo(g.y), a[3] * bfhi(g.y)); w.z = pk2(b[0] * bflo(g.z), b[1] * bfhi(g.z)); w.w = pk2(b[2] * bflo(g.w), b[3] * bfhi(g.w));
                    *(u32x4*)(MIX + (size_t)r * DM + c0) = w; } }
    }
};
struct EpiOut {
    static constexpr bool PERM = true, AFTER_DRAIN = false, TWO_SEG = false, INIT_ACC = true;
    const float* X; float* O;
    __device__ __forceinline__ void init(f32x4 (&acc)[2][2][4][2], const pg8::Unit& u, int wr, int wc, int fr, int fq) const {
#pragma unroll
        for (int ai = 0; ai < 2; ++ai)
#pragma unroll
            for (int m = 0; m < 4; ++m) { const int r = u.pm * 256 + ai * 128 + wr * 64 + m * 16 + fr;
#pragma unroll
                for (int bj = 0; bj < 2; ++bj) { const float* xp = X + (size_t)r * DM + u.pn * 256 + 128 * bj + 32 * wc + 8 * fq;
                    acc[ai][bj][m][0] = __builtin_nontemporal_load((const f32x4*)xp); acc[ai][bj][m][1] = __builtin_nontemporal_load((const f32x4*)(xp + 4)); } }
    }
    __device__ __forceinline__ void operator()(const f32x4 (&acc)[2][2][4][2], const pg8::Unit& u, int wr, int wc, int fr, int fq) const {
#pragma unroll
        for (int ai = 0; ai < 2; ++ai)
#pragma unroll
            for (int m = 0; m < 4; ++m) { const int r = u.pm * 256 + ai * 128 + wr * 64 + m * 16 + fr;
#pragma unroll
                for (int bj = 0; bj < 2; ++bj) { float* op = O + (size_t)r * DM + u.pn * 256 + 128 * bj + 32 * wc + 8 * fq;
                    __builtin_nontemporal_store(acc[ai][bj][m][0], (f32x4*)op); __builtin_nontemporal_store(acc[ai][bj][m][1], (f32x4*)(op + 4)); } }
    }
};

#define MFMA32(a, b, c) __builtin_amdgcn_mfma_f32_32x32x16_bf16(a, b, c, 0, 0, 0)
#define SBAR() __builtin_amdgcn_sched_barrier(0)
typedef short v4i16_t __attribute__((ext_vector_type(4)));
__device__ __forceinline__ int crow(int r, int hi) { return (r & 3) + 8 * (r >> 2) + 4 * hi; }
__device__ __forceinline__ s16x4 vtr(const LAS unsigned char* p) { return __builtin_bit_cast(s16x4, __builtin_amdgcn_ds_read_tr16_b64_v4i16((LAS v4i16_t*)p)); }
__device__ __forceinline__ bf16x8 cat8(s16x4 lo, s16x4 hi) { return (bf16x8){lo[0], lo[1], lo[2], lo[3], hi[0], hi[1], hi[2], hi[3]}; }
__device__ __forceinline__ bf16x8 pack8(const f32x16& p, int b) {
    u32x4 w; w.x = pk2(p[b], p[b + 1]); w.y = pk2(p[b + 2], p[b + 3]); w.z = pk2(p[b + 4], p[b + 5]); w.w = pk2(p[b + 6], p[b + 7]); return __builtin_bit_cast(bf16x8, w); }
constexpr int ATT_SCR = 98304;

#define B_QK_INIT(N0, N1, T) do { float sl_ = slope2; asm volatile("" : "+v"(sl_));     \
    const float tb_ = sl_ * (float)(64 * (T) - (128 * qb + 32 * wq)) + abase; \
    _Pragma("unroll") for (int r = 0; r < 16; ++r) { N0[r] = fmaf(sl_, (float)((r & 3) + 8 * (r >> 2)), tb_); N1[r] = fmaf(sl_, (float)((r & 3) + 8 * (r >> 2) + 32), tb_); } } while (0)
#define B_EXP4(C, B) do { C[B] = fast_exp2(C[B]); C[B + 1] = fast_exp2(C[B + 1]); C[B + 2] = fast_exp2(C[B + 2]); C[B + 3] = fast_exp2(C[B + 3]); } while (0)
#define B_STEP(C0, C1, N0, N1, T) do { \
    const int t_ = (T); const bool has1 = (t_ + 1 <= t1), has2 = (t_ + 2 <= t1), has3 = (t_ + 3 <= t1); \
    const int r0_ = (t_ - t0) % 3, r1_ = (r0_ == 2) ? 0 : r0_ + 1, r2_ = (r1_ == 2) ? 0 : r1_ + 1;     \
    if (has3) { const size_t go = (size_t)(t_ + 3) * 64 * PP; const int kn_ = r0_ * 16384 + w * 1024; GLDS16(k0src + go, lds + kn_); GLDS16(k1src + go, lds + kn_ + 8192); } \
    if (has2) { const size_t go = (size_t)(t_ + 2) * 64 * PP; const int vn_ = 49152 + r2_ * 16384 + vdw; GLDS16(vsrc + go, lds + vn_); GLDS16(vsrc + go + 64, lds + vn_ + 8192); } \
    if (has1) { \
        const LAS unsigned char* kb = lds + r1_ * 16384 + map * 8192; \
        bf16x8 kf[8]; \
        _Pragma("unroll") for (int d0 = 0; d0 < 4; ++d0) { kf[2 * d0] = *(const LAS bf16x8*)(kb + koff[d0]); kf[2 * d0 + 1] = *(const LAS bf16x8*)(kb + koff[d0] + 4096); } \
        B_QK_INIT(N0, N1, t_ + 1); \
        SBAR(); \
        N0 = MFMA32(kf[0], qr[0], N0); B_EXP4(C0, 0); SBAR(); \
        N1 = MFMA32(kf[1], qr[0], N1); B_EXP4(C1, 0); SBAR(); \
        N0 = MFMA32(kf[2], qr[1], N0); B_EXP4(C0, 4); SBAR(); \
        N1 = MFMA32(kf[3], qr[1], N1); B_EXP4(C1, 4); SBAR(); \
        N0 = MFMA32(kf[4], qr[2], N0); B_EXP4(C0, 8); SBAR(); \
        N1 = MFMA32(kf[5], qr[2], N1); B_EXP4(C1, 8); SBAR(); \
        N0 = MFMA32(kf[6], qr[3], N0); B_EXP4(C0, 12); SBAR(); \
        N1 = MFMA32(kf[7], qr[3], N1); B_EXP4(C1, 12); SBAR(); \
    } else { \
        _Pragma("unroll") for (int r = 0; r < 16; ++r) { C0[r] = fast_exp2(C0[r]); C1[r] = fast_exp2(C1[r]); } \
    } \
    const LAS unsigned char* vb = lds + 49152 + r0_ * 16384 + vlane; \
    s16x4 va[8], vc[8];                                             \
    _Pragma("unroll") for (int d = 0; d < 4; ++d) { va[2 * d] = vtr(vb + d * 4096); va[2 * d + 1] = vtr(vb + d * 4096 + 512); } \
    if (t_ == 1 || t_ >= 2 * qb) {                                  \
        _Pragma("unroll") for (int r = 0; r < 16; ++r) { const int k0t = 64 * t_ + crow(r, hi), k1t = k0t + 32; \
            if (k0t > qt || k0t < 112) C0[r] = 0.f; if (k1t > qt || k1t < 112) C1[r] = 0.f; } \
    } \
      \
    const bf16x8 pw0 = pack8(C0, 0); \
    _Pragma("unroll") for (int d = 0; d < 4; ++d) { vc[2 * d] = vtr(vb + d * 4096 + 1024); vc[2 * d + 1] = vtr(vb + d * 4096 + 1536); } \
    SBAR(); \
    o[0] = MFMA32(pw0, cat8(va[0], va[1]), o[0]); o[1] = MFMA32(pw0, cat8(va[2], va[3]), o[1]); \
    o[2] = MFMA32(pw0, cat8(va[4], va[5]), o[2]); o[3] = MFMA32(pw0, cat8(va[6], va[7]), o[3]); \
    const bf16x8 pw1 = pack8(C0, 8); \
    float a_ = ((C0[0] + C0[1]) + (C0[2] + C0[3])) + ((C0[4] + C0[5]) + (C0[6] + C0[7])); \
    SBAR(); \
    _Pragma("unroll") for (int d = 0; d < 4; ++d) { va[2 * d] = vtr(vb + d * 4096 + 2048); va[2 * d + 1] = vtr(vb + d * 4096 + 2560); } \
    o[0] = MFMA32(pw1, cat8(vc[0], vc[1]), o[0]); o[1] = MFMA32(pw1, cat8(vc[2], vc[3]), o[1]); \
    o[2] = MFMA32(pw1, cat8(vc[4], vc[5]), o[2]); o[3] = MFMA32(pw1, cat8(vc[6], vc[7]), o[3]); \
    const bf16x8 pw2 = pack8(C1, 0); \
    a_ += ((C0[8] + C0[9]) + (C0[10] + C0[11])) + ((C0[12] + C0[13]) + (C0[14] + C0[15])); \
    SBAR(); \
    _Pragma("unroll") for (int d = 0; d < 4; ++d) { vc[2 * d] = vtr(vb + d * 4096 + 3072); vc[2 * d + 1] = vtr(vb + d * 4096 + 3584); } \
    o[0] = MFMA32(pw2, cat8(va[0], va[1]), o[0]); o[1] = MFMA32(pw2, cat8(va[2], va[3]), o[1]); \
    o[2] = MFMA32(pw2, cat8(va[4], va[5]), o[2]); o[3] = MFMA32(pw2, cat8(va[6], va[7]), o[3]); \
    const bf16x8 pw3 = pack8(C1, 8); \
    a_ += ((C1[0] + C1[1]) + (C1[2] + C1[3])) + ((C1[4] + C1[5]) + (C1[6] + C1[7])); \
    SBAR(); \
    o[0] = MFMA32(pw3, cat8(vc[0], vc[1]), o[0]); o[1] = MFMA32(pw3, cat8(vc[2], vc[3]), o[1]); \
    o[2] = MFMA32(pw3, cat8(vc[4], vc[5]), o[2]); o[3] = MFMA32(pw3, cat8(vc[6], vc[7]), o[3]); \
    a_ += ((C1[8] + C1[9]) + (C1[10] + C1[11])) + ((C1[12] + C1[13]) + (C1[14] + C1[15])); \
    lsum += a_; \
    SBAR(); \
      \
      \
    if (has3 && has2) asm volatile("s_waitcnt vmcnt(4) lgkmcnt(0)\n\ts_barrier" ::: "memory"); \
    else asm volatile("s_waitcnt vmcnt(0) lgkmcnt(0)\n\ts_barrier" ::: "memory"); \
} while (0)

__device__ __forceinline__ void attn_b_core(const bf16_t* __restrict__ P, float kmax, int b, int h, int qb, int t0, int t1, LAS unsigned char* lds, f32x16 (&o)[4], float& lsum) {
    int tid = threadIdx.x; asm volatile("" : "+v"(tid));
    const int lane = tid & 63, r32 = lane & 31, hi = lane >> 5; const int w = __builtin_amdgcn_readfirstlane(tid >> 6);
    const int map = w >> 2, wq = w & 3;
    const size_t rowbase = (size_t)b * LP;
    const float slope2 = exp2f(-2.0f * (float)(h + 1)) * LOG2E;
    const int krow = 8 * w + (lane >> 3);
    const bf16_t* k0src = P + (rowbase + krow) * PP + 1792 + h * 128 + (((lane & 7) ^ ((krow >> 1) & 7)) << 3);
    const bf16_t* k1src = k0src + 64;
    const bf16_t* vsrc = P + (rowbase + 16 * (w & 3) + (lane >> 2)) * PP + 2304 + h * 128 + (w >> 2) * 32 + (lane & 3) * 8;
    const int vdw = (w >> 2) * 4096 + (w & 3) * 1024;
    int koff[4];
#pragma unroll
    for (int d0 = 0; d0 < 4; ++d0) koff[d0] = r32 * 128 + ((((2 * d0 + hi) ^ ((r32 >> 1) & 7))) << 4);
#define GLDS16(gp, lp) __builtin_amdgcn_global_load_lds((const unsigned*)(gp), (LAS unsigned*)(lp), 16, 0, 0)
    const int qt = 128 * qb + 32 * wq + r32;
    bf16x8 qr[4];
    { const bf16_t* qp = P + (rowbase + qt) * PP + 1280 + h * 128 + map * 64 + 8 * hi;
#pragma unroll
      for (int d0 = 0; d0 < 4; ++d0) qr[d0] = *(const bf16x8*)(qp + 16 * d0); }
    float qss = 0.f;
#pragma unroll
    for (int d0 = 0; d0 < 4; ++d0)
#pragma unroll
        for (int e = 0; e < 8; ++e) { const float f = bf2f((unsigned short)qr[d0][e]); qss += f * f; }
    qss += __shfl_xor(qss, 32);
    const float mrow = sqrtf(qss) * kmax;
    const float abase = -slope2 * (float)(r32 - 4 * hi) - mrow;
#pragma unroll
    for (int d = 0; d < 4; ++d) o[d] = f32x16{};
    lsum = 0.f;
    const int vlane = ((lane >> 4) & 1) * 32 + (lane & 3) * 8 + (4 * hi + ((lane & 15) >> 2)) * 64;
    { const size_t go = (size_t)t0 * 64 * PP, g1 = (size_t)64 * PP;
      GLDS16(k0src + go, lds + w * 1024); GLDS16(k1src + go, lds + 8192 + w * 1024); GLDS16(vsrc + go, lds + 49152 + vdw); GLDS16(vsrc + go + 64, lds + 49152 + vdw + 8192);
      if (t0 + 1 <= t1) { GLDS16(k0src + go + g1, lds + 16384 + w * 1024); GLDS16(k1src + go + g1, lds + 16384 + 8192 + w * 1024);
                          GLDS16(vsrc + go + g1, lds + 49152 + 16384 + vdw); GLDS16(vsrc + go + g1 + 64, lds + 49152 + 16384 + vdw + 8192); }
      if (t0 + 2 <= t1) { GLDS16(k0src + go + 2 * g1, lds + 32768 + w * 1024); GLDS16(k1src + go + 2 * g1, lds + 32768 + 8192 + w * 1024); } }
    asm volatile("s_waitcnt vmcnt(0)" ::: "memory");
    __syncthreads();
    f32x16 sA0, sA1, sB0, sB1;
    { const LAS unsigned char* kb = lds + map * 8192;
      B_QK_INIT(sA0, sA1, t0);
#pragma unroll
      for (int d0 = 0; d0 < 4; ++d0) { const bf16x8 k0 = *(const LAS bf16x8*)(kb + koff[d0]), k1 = *(const LAS bf16x8*)(kb + koff[d0] + 4096);
          sA0 = MFMA32(k0, qr[d0], sA0); sA1 = MFMA32(k1, qr[d0], sA1); } }
    __syncthreads();
    for (int t = t0; t <= t1; t += 2) {
        B_STEP(sA0, sA1, sB0, sB1, t);
        if (t + 1 <= t1) B_STEP(sB0, sB1, sA0, sA1, t + 1);
    }
}
#undef B_STEP
#undef GLDS16
#undef B_EXP4
#undef B_QK_INIT
__device__ __forceinline__ void attn_b_finalize(const bf16_t* __restrict__ P, bf16_t* __restrict__ YB, const float* __restrict__ subln, float lam, int b, int h, int qb, LAS unsigned char* lds, f32x16 (&o)[4], float lsum) {
    int tid = threadIdx.x; asm volatile("" : "+v"(tid));
    const int lane = tid & 63, r32 = lane & 31, hi = lane >> 5; const int w = __builtin_amdgcn_readfirstlane(tid >> 6);
    const int map = w >> 2, wq = w & 3;
    const size_t rowbase = (size_t)b * LP;
    lsum += __shfl_xor(lsum, 32);
    LAS float* scr = (LAS float*)(lds + ATT_SCR) + w * 32;
    { float inv = 1.0f / lsum; if (map == 1) inv *= lam; if (hi == 0) scr[r32] = inv; }
    float rl[16];
#pragma unroll
    for (int r = 0; r < 16; ++r) rl[r] = scr[crow(r, hi)];
#pragma unroll
    for (int d0 = 0; d0 < 4; ++d0)
#pragma unroll
        for (int r = 0; r < 16; ++r) o[d0][r] *= rl[r];
    LAS float* X = (LAS float*)lds;
    if (map == 1) {
#pragma unroll
        for (int d0 = 0; d0 < 4; ++d0)
#pragma unroll
            for (int r = 0; r < 16; ++r) X[((wq * 4 + d0) * 16 + r) * 64 + lane] = o[d0][r];
    }
    __syncthreads();
    LAS unsigned short* Y = (LAS unsigned short*)(lds + 65536);
    if (map == 0) {
        float rn[16];
#pragma unroll
        for (int r = 0; r < 16; ++r) { float ss = 0.f;
#pragma unroll
            for (int d0 = 0; d0 < 4; ++d0) { o[d0][r] -= X[((wq * 4 + d0) * 16 + r) * 64 + lane]; ss += o[d0][r] * o[d0][r]; }
            ss += __shfl_xor(ss, 1); ss += __shfl_xor(ss, 2); ss += __shfl_xor(ss, 4); ss += __shfl_xor(ss, 8); ss += __shfl_xor(ss, 16);
            rn[r] = (1.0f - LAM_INIT) / sqrtf(ss * (1.f / 128.f) + RMS_EPS); }
#pragma unroll
        for (int d0 = 0; d0 < 4; ++d0) { const float sg = subln[32 * d0 + r32];
#pragma unroll
            for (int r = 0; r < 16; ++r) Y[(32 * wq + crow(r, hi)) * 128 + 32 * d0 + r32] = (unsigned short)f2bf(o[d0][r] * rn[r] * sg); }
    }
    __syncthreads();
    { u32x4 yv[4], zv[4];
#pragma unroll
      for (int i = 0; i < 4; ++i) { const int x = tid + 512 * i, row = x >> 4, c = x & 15;
          yv[i] = *(const LAS u32x4*)(Y + row * 128 + c * 8);
          zv[i] = *(const u32x4*)(P + (rowbase + 128 * qb + row) * PP + 2816 + h * 128 + c * 8); }
#pragma unroll
      for (int i = 0; i < 4; ++i) { const int x = tid + 512 * i, row = x >> 4, c = x & 15;
          u32x4 ov; ov.x = pk2(bflo(yv[i].x) * bflo(zv[i].x), bfhi(yv[i].x) * bfhi(zv[i].x)); ov.y = pk2(bflo(yv[i].y) * bflo(zv[i].y), bfhi(yv[i].y) * bfhi(zv[i].y));
          ov.z = pk2(bflo(yv[i].z) * bflo(zv[i].z), bfhi(yv[i].z) * bfhi(zv[i].z)); ov.w = pk2(bflo(yv[i].w) * bflo(zv[i].w), bfhi(yv[i].w) * bfhi(zv[i].w));
          __builtin_nontemporal_store(ov, (u32x4*)(YB + ((size_t)b * SEQ + 128 * (qb - 1) + row) * BW + h * 128 + c * 8)); } }
    __syncthreads();
}

__device__ __forceinline__ void attn_a_unit(const bf16_t* __restrict__ P, bf16_t* __restrict__ YA, const float* __restrict__ sink, float kmax, int b, int kvh, int qb, LAS unsigned char* lds) {
    int tid = threadIdx.x; asm volatile("" : "+v"(tid));
    const int lane = tid & 63, r32 = lane & 31, hi = lane >> 5; const int w = __builtin_amdgcn_readfirstlane(tid >> 6);
    const size_t rowbase = (size_t)b * LP; const int kt0 = 128 * (qb - 1);
    { u32x4 kk[4], vv[4];
#pragma unroll
      for (int j = 0; j < 4; ++j) { kk[j] = *(const u32x4*)(P + (rowbase + kt0 + 64 * j + lane) * PP + 512 + kvh * 64 + w * 8);
                                    vv[j] = *(const u32x4*)(P + (rowbase + kt0 + 64 * j + (tid >> 3)) * PP + 640 + kvh * 64 + (tid & 7) * 8); }
#pragma unroll
      for (int j = 0; j < 4; ++j) { *(LAS u32x4*)(lds + j * 8192 + w * 1024 + lane * 16) = kk[j];
                                    *(LAS u32x4*)(lds + 32768 + j * 8192 + ((tid & 7) >> 2) * 4096 + (tid >> 3) * 64 + (tid & 3) * 16) = vv[j]; } }
    __syncthreads();
    const int g = w >> 1, hq = kvh * 4 + g;
    const float slope2 = exp2f(-(float)(hq + 1)) * LOG2E, sink2 = sink[hq] * LOG2E;
    const int vlane = ((lane >> 4) & 1) * 32 + (lane & 3) * 8 + (4 * hi + ((lane & 15) >> 2)) * 64;
    LAS float* scr = (LAS float*)(lds + ATT_SCR) + w * 32;
    for (int sub = 0; sub < 2; ++sub) {
        const int q0 = 64 * (w & 1) + 32 * sub; const int qrel = 128 + q0 + r32;
        bf16x8 qr[4];
        { const bf16_t* qp = P + (rowbase + kt0 + qrel) * PP + hq * 64 + 8 * hi;
#pragma unroll
          for (int d0 = 0; d0 < 4; ++d0) qr[d0] = *(const bf16x8*)(qp + 16 * d0); }
        float qss = 0.f;
#pragma unroll
        for (int d0 = 0; d0 < 4; ++d0)
#pragma unroll
            for (int e = 0; e < 8; ++e) { const float f = bf2f((unsigned short)qr[d0][e]); qss += f * f; }
        qss += __shfl_xor(qss, 32);
        const float cref = fmaxf(sqrtf(qss) * kmax, sink2);
        f32x16 o[2]; o[0] = f32x16{}; o[1] = f32x16{}; float lsum = 0.f;
        for (int jj = 0; jj < 3; ++jj) { const int j = (w & 1) + jj;
            f32x16 s0, s1;
#pragma unroll
            for (int r = 0; r < 16; ++r) { const int d0_ = qrel - (64 * j + crow(r, hi)); s0[r] = -slope2 * (float)d0_ - cref; s1[r] = -slope2 * (float)(d0_ - 32) - cref; }
            const LAS unsigned char* kb = lds + j * 8192 + hi * 1024 + r32 * 16;
#pragma unroll
            for (int d0 = 0; d0 < 4; ++d0) {
                const bf16x8 k0 = *(const LAS bf16x8*)(kb + d0 * 2048), k1 = *(const LAS bf16x8*)(kb + d0 * 2048 + 512);
                s0 = MFMA32(k0, qr[d0], s0); s1 = MFMA32(k1, qr[d0], s1); }
#pragma unroll
            for (int r = 0; r < 16; ++r) { const int kr = 64 * j + crow(r, hi); const int da = qrel - kr, db = da - 32;
                const float e0 = fast_exp2(s0[r]), e1 = fast_exp2(s1[r]);
                s0[r] = (da >= 0 && da < 128 && kt0 + kr >= 112) ? e0 : 0.f;
                s1[r] = (db >= 0 && db < 128 && kt0 + kr + 32 >= 112) ? e1 : 0.f; }
            { float a = 0.f;
#pragma unroll
              for (int r = 0; r < 16; ++r) a += s0[r] + s1[r];
              lsum += a; }
            const bf16x8 pw0 = pack8(s0, 0), pw1 = pack8(s0, 8), pw2 = pack8(s1, 0), pw3 = pack8(s1, 8);
            const LAS unsigned char* vb = lds + 32768 + j * 8192 + vlane;
#pragma unroll
            for (int d0 = 0; d0 < 2; ++d0) {
                o[d0] = MFMA32(pw0, cat8(vtr(vb + d0 * 4096), vtr(vb + d0 * 4096 + 512)), o[d0]);
                o[d0] = MFMA32(pw1, cat8(vtr(vb + d0 * 4096 + 1024), vtr(vb + d0 * 4096 + 1536)), o[d0]);
                o[d0] = MFMA32(pw2, cat8(vtr(vb + d0 * 4096 + 2048), vtr(vb + d0 * 4096 + 2560)), o[d0]);
                o[d0] = MFMA32(pw3, cat8(vtr(vb + d0 * 4096 + 3072), vtr(vb + d0 * 4096 + 3584)), o[d0]);
            }
        }
        lsum += __shfl_xor(lsum, 32);
        { const float inv = 1.0f / (lsum + fast_exp2(sink2 - cref)); if (hi == 0) scr[r32] = inv; }
        float rl[16];
#pragma unroll
        for (int r = 0; r < 16; ++r) rl[r] = scr[crow(r, hi)];
        LAS unsigned short* Yw = (LAS unsigned short*)(lds + 65536) + w * 2048;
#pragma unroll
        for (int d0 = 0; d0 < 2; ++d0)
#pragma unroll
            for (int r = 0; r < 16; ++r) Yw[crow(r, hi) * 64 + 32 * d0 + r32] = (unsigned short)f2bf(o[d0][r] * rl[r]);
        { u32x4 yv[4], zv[4];
#pragma unroll
          for (int i = 0; i < 4; ++i) { const int row = i * 8 + (lane >> 3), c = lane & 7;
              yv[i] = *(const LAS u32x4*)(Yw + row * 64 + c * 8);
              zv[i] = *(const u32x4*)(P + (rowbase + kt0 + 128 + q0 + row) * PP + 768 + hq * 64 + c * 8); }
#pragma unroll
          for (int i = 0; i < 4; ++i) { const int row = i * 8 + (lane >> 3), c = lane & 7;
              u32x4 ov; ov.x = pk2(bflo(yv[i].x) * bflo(zv[i].x), bfhi(yv[i].x) * bfhi(zv[i].x)); ov.y = pk2(bflo(yv[i].y) * bflo(zv[i].y), bfhi(yv[i].y) * bfhi(zv[i].y));
              ov.z = pk2(bflo(yv[i].z) * bflo(zv[i].z), bfhi(yv[i].z) * bfhi(zv[i].z)); ov.w = pk2(bflo(yv[i].w) * bflo(zv[i].w), bfhi(yv[i].w) * bfhi(zv[i].w));
              __builtin_nontemporal_store(ov, (u32x4*)(YA + ((size_t)b * SEQ + kt0 + q0 + row) * AW + hq * 64 + c * 8)); } }
    }
    __syncthreads();
}

constexpr size_t WS_SLOT = 219 * MiB; constexpr int SLOT_BYTES = 133120, SLOT_MAX = 280;
constexpr int TAB_OFF = 102400;
constexpr int CW_QUEUE = 8192;
__device__ __forceinline__ void unit_decode(int j, int& b, int& h, int& qb) { h = 3 - (j >> 7); const int jj = j & 127; qb = 64 - (jj >> 1); b = jj & 1; }
__device__ __forceinline__ int b_window(int h, float mmax) {
    const float slope2 = exp2f(-2.0f * (float)(h + 1)) * LOG2E;
    const float need = 24.0f + 2.0f * mmax + log2f(1.0f / (slope2 * 0.69314718f));
    const float d = ceilf(need / slope2) + 1.0f;
    return d > 1.0e6f ? 1000000 : (int)d;
}
__device__ __forceinline__ int b_tmin(int qb, int dh) { const int k = 128 * qb - dh; return k < 128 ? 1 : (k >> 6); }
__device__ __forceinline__ void b_store_partial(unsigned char* ws, int slot, const f32x16 (&o)[4], float lsum) {
    int tid = threadIdx.x; asm volatile("" : "+v"(tid));
    const int lane = tid & 63; const int w = __builtin_amdgcn_readfirstlane(tid >> 6);
    float* S = (float*)(ws + WS_SLOT + (size_t)slot * SLOT_BYTES);
#pragma unroll
    for (int d0 = 0; d0 < 4; ++d0)
#pragma unroll
        for (int r = 0; r < 16; ++r) S[((w * 4 + d0) * 16 + r) * 64 + lane] = o[d0][r];
    S[32768 + w * 64 + lane] = lsum;
}
__device__ __forceinline__ void b_load_partials(const unsigned char* ws, int slot0, int nc, f32x16 (&o)[4], float& lsum) {
    int tid = threadIdx.x; asm volatile("" : "+v"(tid));
    const int lane = tid & 63; const int w = __builtin_amdgcn_readfirstlane(tid >> 6);
#pragma unroll
    for (int d = 0; d < 4; ++d) o[d] = f32x16{};
    lsum = 0.f;
    for (int c = 0; c < nc; ++c) { const float* S = (const float*)(ws + WS_SLOT + (size_t)(slot0 + c) * SLOT_BYTES);
#pragma unroll
        for (int d0 = 0; d0 < 4; ++d0)
#pragma unroll
            for (int r = 0; r < 16; ++r) o[d0][r] += S[((w * 4 + d0) * 16 + r) * 64 + lane];
        lsum += S[32768 + w * 64 + lane]; }
}

#define GAS __attribute__((address_space(1)))
typedef GAS unsigned gu32;
typedef GAS unsigned long long gu64;
#define RLX_AGENT __ATOMIC_RELAXED, __HIP_MEMORY_SCOPE_AGENT
#define LDS_WAIT() asm volatile("s_waitcnt lgkmcnt(0)" ::: "memory")
#define VM_WAIT() asm volatile("s_waitcnt vmcnt(0)" ::: "memory")
__device__ __forceinline__ unsigned long long rt() { return __builtin_amdgcn_s_memrealtime(); }
#define XB_TMO      128
#define XB_XCNT(j)  (256  + 64 * (j))
#define XB_XSUB(j)  (1280 + 64 * (j))
#define XB_XGEN(j)  (2304 + 64 * (j))
#define XB_TOP      3328
#define XB_TOPGEN   3392
#define XCD_BAR_WORDS 3456
#define XB_SPIN_CAP (1u << 18)

__device__ __forceinline__ unsigned xb_ld(unsigned* p)              { return __hip_atomic_load(p, __ATOMIC_RELAXED, __HIP_MEMORY_SCOPE_AGENT); }
__device__ __forceinline__ unsigned xb_add(unsigned* p, unsigned v) { return __hip_atomic_fetch_add(p, v, __ATOMIC_RELAXED, __HIP_MEMORY_SCOPE_AGENT); }
__device__ __forceinline__ unsigned xb_xcc_id() { return (unsigned)__builtin_amdgcn_s_getreg((3 << 11) | 20) & 0xFu; }
#define XB_SPIN(cond, bar) do { unsigned _sp = 0; while (cond) { __builtin_amdgcn_s_sleep(1); \
    if ((++_sp & 255u) == 0u) { if (xb_ld(&(bar)[XB_TMO])) break; if (_sp > XB_SPIN_CAP) { atomicAdd(&(bar)[XB_TMO], 1u); break; } } } } while (0)

struct XcdBarrier {
    unsigned* bar; unsigned x;
    volatile LAS unsigned* st;
};

__device__ __forceinline__ XcdBarrier xcd_barrier_post(unsigned* bar, volatile LAS unsigned* st) {
    XcdBarrier b; b.bar = bar; b.x = xb_xcc_id(); b.st = st;
    if (threadIdx.x == 0) (void)xb_add(&bar[XB_XCNT(b.x)], 1u);
    return b;
}
__device__ __forceinline__ void xcd_barrier_complete(unsigned* bar, unsigned x, unsigned& nloc, unsigned& nx) {
    const unsigned G = gridDim.x * gridDim.y * gridDim.z;
    unsigned sum, cnt, mine, sp = 0u;
    for (;;) {
        sum = 0u; cnt = 0u; mine = 0u;
#pragma unroll
        for (unsigned j = 0; j < 16; ++j) { const unsigned c = xb_ld(&bar[XB_XCNT(j)]); sum += c; cnt += (c > 0u) ? 1u : 0u; mine = (j == x) ? c : mine; }
        if (sum == G) break;
        __builtin_amdgcn_s_sleep(1);
        if ((++sp & 255u) == 0u) { if (xb_ld(&bar[XB_TMO])) break; if (sp > XB_SPIN_CAP) { atomicAdd(&bar[XB_TMO], 1u); break; } }
    }
    nloc = mine > 0u ? mine : 1u; nx = cnt > 0u ? cnt : 1u;
}

__device__ __forceinline__ void xcd_barrier(const XcdBarrier& b) {
    asm volatile("s_waitcnt vmcnt(0)" ::: "memory");
    __syncthreads();
    if (threadIdx.x == 0) {
        unsigned* bar = b.bar;
        __builtin_amdgcn_s_waitcnt(0);
        unsigned nloc = b.st[0], nx = b.st[1];
        if (nloc == 0u) { xcd_barrier_complete(bar, b.x, nloc, nx); b.st[0] = nloc; b.st[1] = nx; }
        const unsigned old = xb_add(&bar[XB_XSUB(b.x)], 1u);
        const unsigned gen = old / nloc;
        if (old + 1u == (gen + 1u) * nloc) {
            __builtin_amdgcn_fence(__ATOMIC_RELEASE, "agent");
            asm volatile("s_waitcnt vmcnt(0)" ::: "memory");
            const unsigned og = xb_add(&bar[XB_TOP], 1u);
            const unsigned tg = og / nx;
            if (og + 1u == (tg + 1u) * nx) xb_add(&bar[XB_TOPGEN], 1u);
            else XB_SPIN(xb_ld(&bar[XB_TOPGEN]) == tg, bar);
            __builtin_amdgcn_fence(__ATOMIC_ACQUIRE, "agent");
            xb_add(&bar[XB_XGEN(b.x)], 1u);
            asm volatile("s_waitcnt vmcnt(0)" ::: "memory");
        } else {
            XB_SPIN(xb_ld(&bar[XB_XGEN(b.x)]) == gen, bar);
            __builtin_amdgcn_fence(__ATOMIC_ACQUIRE, "agent");
            asm volatile("s_waitcnt vmcnt(0)" ::: "memory");
        }
    }
    __syncthreads();
}

struct Args { const float* in[17]; float* out; unsigned char* ws; int ph_lo, ph_hi; };

__global__ void __launch_bounds__(NWAVES * 64, 2) hybrid_fwd(Args args) {
    extern __shared__ __attribute__((aligned(16))) unsigned char lds_raw[];
    LAS unsigned char* lds = (LAS unsigned char*)lds_raw;
    cg::grid_group grid = cg::this_grid();
    const int tid = threadIdx.x, lane = tid & 63; const int wave = __builtin_amdgcn_readfirstlane(tid >> 6);
    const int G = gridDim.x; const int bx = blockIdx.x; const int vcu = (G % 8 == 0) ? (bx % 8) * (G / 8) + bx / 8 : bx;
    unsigned char* ws = args.ws;
    bf16_t* WinT = (bf16_t*)(ws + WS_WIN); bf16_t* WuaT = (bf16_t*)(ws + WS_WUA); bf16_t* WubT = (bf16_t*)(ws + WS_WUB); bf16_t* WoT = (bf16_t*)(ws + WS_WO);
    bf16_t* XN = (bf16_t*)(ws + WS_XN);
    bf16_t* YA = (bf16_t*)args.out; bf16_t* YB = YA + (size_t)MTOK * AW;
    bf16_t* Pb = (bf16_t*)(ws + WS_P); float* T = (float*)(ws + WS_T); bf16_t* MIX = (bf16_t*)(ws + WS_MIX); bf16_t* Gt = (bf16_t*)(ws + WS_G);
    const int lo = args.ph_lo, hi = args.ph_hi;
    volatile LAS unsigned* bst = (volatile LAS unsigned*)(lds + 131072 + 352);
    if (tid < 2) bst[tid] = 0u;
    __syncthreads();
    XcdBarrier bar = xcd_barrier_post((unsigned*)ws + 4096, bst);
    if (hi > 1000) grid.sync();
#define IN(k) (lo <= (k) && (k) < hi)
#define SEAM(k) do { if (IN(k) && IN((k) + 1)) xcd_barrier(bar); } while (0)

    if (IN(0)) {
        LAS float* scr = (LAS float*)(lds + wave * 16384);
        const int gw = vcu * NWAVES + wave, NGW = G * NWAVES;
        constexpr int I_IN = (DM / 64) * (NIN / 32), I_UP = (AW / 64) * (DM / 32), I_O = (DM / 64) * (DM / 32);
        constexpr int NITEMS = I_IN + 2 * I_UP + I_O;
        for (int it = gw; it < NITEMS; it += NGW) {
            int r = it;
            if (r < I_IN) { p0_transpose_item<true>(args.in[3], DM, NIN, WinT, scr, r, lane); continue; } r -= I_IN;
            if (r < I_UP) { p0_transpose_item<false>(args.in[14], AW, DM, WuaT, scr, r, lane); continue; } r -= I_UP;
            if (r < I_UP) { p0_transpose_item<false>(args.in[15], BW, DM, WubT, scr, r, lane); continue; } r -= I_UP;
            p0_transpose_item<false>(args.in[16], DM, DM, WoT, scr, r, lane);
        }
        for (int m = gw; m < M1; m += 2 * NGW) {
            const int m2 = m + NGW; const bool has2 = (m2 < M1);
            const float* s0 = (m < MTOK) ? args.in[0] + (size_t)m * DM : ((m < MTOK + 16) ? args.in[1] + (size_t)(m - MTOK) * DM : nullptr);
            const float* s1 = !has2 ? nullptr : (m2 < MTOK) ? args.in[0] + (size_t)m2 * DM : ((m2 < MTOK + 16) ? args.in[1] + (size_t)(m2 - MTOK) * DM : nullptr);
            rms_rows2_to_bf16(s0, s1, args.in[2], XN + (size_t)m * DM, has2 ? XN + (size_t)m2 * DM : nullptr, lane);
        }
    }
    SEAM(0);
    const int p1_full = pg8::InOrder::NUNITS / G;
    const bool p1_split = (p1_full * G >= pg8::InOrder::NNG + pg8::InOrder::NMETA) && (pg8::InOrder::NUNITS % G != 0);
    if (IN(1)) {
        pg8::Gemm g{XN, WinT, M1, NIN, DM}; pg8::InOrder S{G, bx, 0, p1_split ? p1_full * G : pg8::InOrder::NUNITS};
        EpiIn E{Pb, Gt, args.in[4], args.in[5], args.in[7], args.in[8]};
        pg8::gemm_phase<EpiIn, pg8::InOrder, PG8_ALIGN, PG8_SP2>(lds, g, S, E);
    }
    SEAM(1);
    if (IN(2) && p1_split) {
        pg8::Gemm g{XN, WinT, M1, NIN, DM}; pg8::InOrder S{G, bx, p1_full, pg8::InOrder::NUNITS};
        EpiIn E{Pb, Gt, args.in[4], args.in[5], args.in[7], args.in[8]};
        pg8::gemm_phase<EpiIn, pg8::InOrder, PG8_ALIGN, PG8_SP2>(lds, g, S, E);
    }
    if (IN(2)) {
#define SCAL(x) __builtin_bit_cast(float, __builtin_amdgcn_readfirstlane(__builtin_bit_cast(int, (x))))
        const float knB = wave_max(fabsf(args.in[8][lane])), qnB = wave_max(fabsf(args.in[7][lane]));
        const float kmaxB = SCAL(8.0f * 1.02f * knB);
        const float kmaxA = SCAL(8.0f * 1.02f * wave_max(fabsf(args.in[5][lane])));
        const float lam = SCAL(__expf(wave_sum(args.in[9][lane] * args.in[10][lane])) - __expf(wave_sum(args.in[11][lane] * args.in[12][lane])) + LAM_INIT);
        const float mmaxB = SCAL(qnB * LOG2E * 1.02f * kmaxB);
        LAS int* incl = (LAS int*)(lds + TAB_OFF); LAS int* sincl = incl + 512; LAS int* order = sincl + 512; LAS int* keys = order + 512; LAS int* misc = keys + 512;
        int C = 1 << 20, myn, mync;
        { int ub, uh, uqb; unit_decode(tid, ub, uh, uqb); myn = 2 * uqb + 2 - b_tmin(uqb, b_window(uh, mmaxB)); }
        {
#pragma unroll 1
            for (int ci = 0; ci < 7; ++ci) {
                const int cd = ci < 4 ? 44 + 4 * ci : (ci == 4 ? 64 : (ci == 5 ? 88 : 176));
                const int nc_ = (myn + cd - 1) / cd;
                int v = nc_ > 1 ? nc_ : 0;
#pragma unroll
                for (int o_ = 1; o_ < 64; o_ <<= 1) v += __shfl_xor(v, o_);
                if (lane == 0) misc[8 + wave] = v;
                __syncthreads();
                int tot = 0;
#pragma unroll
                for (int k = 0; k < 8; ++k) tot += misc[8 + k];
                __syncthreads();
                if (tot <= SLOT_MAX) { C = cd; break; }
            }
        }
        {
            mync = (myn + C - 1) / C;
            const int myper = (myn + mync - 1) / mync, mykey = myper * 512 + (511 - tid);
            keys[tid] = mykey;
            __syncthreads();
            int rank = 0;
            for (int k = 0; k < 128; ++k) { const u32x4 kv = ((const LAS u32x4*)keys)[k]; rank += ((int)kv.x > mykey ? 1 : 0) + ((int)kv.y > mykey ? 1 : 0) + ((int)kv.z > mykey ? 1 : 0) + ((int)kv.w > mykey ? 1 : 0); }
            order[rank] = tid; incl[rank] = mync; sincl[rank] = mync > 1 ? mync : 0;
            __syncthreads();
            for (int d = 1; d < 512; d <<= 1) { const int a = tid >= d ? incl[tid - d] : 0, c = tid >= d ? sincl[tid - d] : 0; __syncthreads(); incl[tid] += a; sincl[tid] += c; __syncthreads(); }
        }
        const int NI = incl[511];
        unsigned* qctr = (unsigned*)ws + CW_QUEUE;
        for (;;) {
            if (tid == 0) misc[0] = (int)__hip_atomic_fetch_add(qctr, 1u, __ATOMIC_RELAXED, __HIP_MEMORY_SCOPE_AGENT);
            __syncthreads();
            const int it = misc[0];
            __syncthreads();
            if (it >= NI + 256) break;
            if (it < NI) {
                int lo_ = 0, hi_ = 511;
                while (lo_ < hi_) { const int mid = (lo_ + hi_) >> 1; if (incl[mid] > it) hi_ = mid; else lo_ = mid + 1; }
                const int p = lo_, jn = incl[p] - (p ? incl[p - 1] : 0), c = it - (incl[p] - jn);
                int ub, uh, uqb; unit_decode(order[p], ub, uh, uqb);
                const int tmin = b_tmin(uqb, b_window(uh, mmaxB)), n = 2 * uqb + 2 - tmin, per = (n + jn - 1) / jn;
                const int t0 = tmin + c * per, t1 = min(t0 + per - 1, 2 * uqb + 1);
                f32x16 o[4]; float lsum;
                attn_b_core(Pb, kmaxB, ub, uh, uqb, t0, t1, lds, o, lsum);
                if (jn == 1) attn_b_finalize(Pb, YB, args.in[13], lam, ub, uh, uqb, lds, o, lsum);
                else b_store_partial(ws, sincl[p] - jn + c, o, lsum);
            } else {
                const int au = it - NI, bk = au >> 6;
                attn_a_unit(Pb, YA, args.in[6], kmaxA, bk >> 1, bk & 1, 1 + (au & 63), lds);
            }
        }
        if (sincl[511] > 0) {
            xcd_barrier(bar);
            for (int p = bx; p < 512; p += G) {
                const int jn = incl[p] - (p ? incl[p - 1] : 0);
                if (jn > 1) { int ub, uh, uqb; unit_decode(order[p], ub, uh, uqb);
                    f32x16 o[4]; float lsum;
                    b_load_partials(ws, sincl[p] - jn, jn, o, lsum);
                    attn_b_finalize(Pb, YB, args.in[13], lam, ub, uh, uqb, lds, o, lsum); }
            }
        }
    }
    SEAM(2);
    if (IN(3)) {
        pg8::Gemm g{YA, WuaT, MTOK, DM, AW, YB, WubT}; pg8::StaticOrder2 S; S.init(MTOK, DM, G, bx); EpiUp E{Gt, MIX};
        pg8::gemm_phase<EpiUp, pg8::StaticOrder2, PG8_ALIGN, PG8_SP2>(lds, g, S, E);
    }
    SEAM(3);
    if (IN(4)) {
        pg8::Gemm g{MIX, WoT, MTOK, DM, DM}; pg8::StaticOrder S; S.init(MTOK, DM, G, bx); EpiOut E{args.in[0], args.out};
        pg8::gemm_phase<EpiOut, pg8::StaticOrder, PG8_ALIGN, PG8_SP2>(lds, g, S, E);
    }
#undef IN
#undef SEAM
}

extern "C" void kernel_launch(void* const* d_in, const int* in_sizes, int n_in, void* d_out, int out_size, void* d_ws, size_t ws_size, hipStream_t stream) {
    static int grid = 0;
    if (grid == 0) {
        if (n_in != 17 || ws_size < WS_END) { fprintf(stderr, "kernel_launch: unexpected inputs (n_in %d, ws %zu)\n", n_in, ws_size); grid = -1; return; }
        int dev = 0, cus = 0, per_cu = 0;
        hipGetDevice(&dev); hipDeviceGetAttribute(&cus, hipDeviceAttributeMultiprocessorCount, dev);
        if (hipFuncSetAttribute((const void*)hybrid_fwd, hipFuncAttributeMaxDynamicSharedMemorySize, LDS_BYTES) != hipSuccess) { fprintf(stderr, "kernel_launch: hipFuncSetAttribute failed\n"); grid = -1; return; }
        if (hipOccupancyMaxActiveBlocksPerMultiprocessor(&per_cu, (const void*)hybrid_fwd, NWAVES * 64, LDS_BYTES) != hipSuccess || per_cu < 1) { fprintf(stderr, "kernel_launch: occupancy query says %d\n", per_cu); per_cu = 1; }
        (void)hipGetLastError();
        grid = cus * 1;
        if (grid <= 0) grid = 256;
    }
    if (grid < 0) return;
    if (hipMemsetAsync(d_ws, 0, 65536, stream) != hipSuccess) { fprintf(stderr, "kernel_launch: memset failed\n"); return; }
    Args a{};
    for (int i = 0; i < 17; ++i) a.in[i] = (const float*)d_in[i];
    a.out = (float*)d_out; a.ws = (unsigned char*)d_ws;
#if MK_SPLIT
    for (int p = 0; p < 5; ++p) { a.ph_lo = p; a.ph_hi = p + 1; void* kargs[] = {&a};
        hipError_t e = hipLaunchCooperativeKernel((const void*)hybrid_fwd, dim3(grid), dim3(NWAVES * 64), kargs, LDS_BYTES, stream);
        if (e != hipSuccess) fprintf(stderr, "kernel_launch: launch %d failed: %s\n", p, hipGetErrorString(e)); }
#else
    a.ph_lo = 0; a.ph_hi = 5; void* kargs[] = {&a};
    hipError_t e = hipLaunchCooperativeKernel((const void*)hybrid_fwd, dim3(grid), dim3(NWAVES * 64), kargs, LDS_BYTES, stream);
    if (e != hipSuccess) fprintf(stderr, "kernel_launch: cooperative launch failed: %s (grid %d)\n", hipGetErrorString(e), grid);
#endif
}
```

```cpp
#include <hip/hip_cooperative_groups.h>
#include <hip/hip_runtime.h>
#include <cstdio>
#include <cstdint>
namespace pg8 {
#define PG8_LAS __attribute__((address_space(3)))
typedef unsigned short bf16_t;
typedef short bf16x8 __attribute__((ext_vector_type(8)));
typedef float f32x4 __attribute__((ext_vector_type(4)));
typedef unsigned u32x4 __attribute__((ext_vector_type(4)));
constexpr int BM = 256, BK = 64, HALF = 128, HTB = HALF * BK * 2  , STAGE_BYTES = 8 * HTB, NXCD = 8, WGM = 8;

__host__ __device__ __forceinline__ int lds_byte(int r, int c) { const int st = (r >> 4) * 2 + (c >> 5), rr = r & 15, cc = c & 31, ob = rr * 64 + cc * 2; return st * 1024 + (ob ^ (((ob >> 9) & 1) << 5)); }
__host__ __device__ __forceinline__ void stage_rc(int b, int& R, int& C) { const int st = b / 1024, sb = b % 1024, swz = sb ^ (((sb >> 9) & 1) << 5); R = (st >> 1) * 16 + swz / 64; C = (st & 1) * 32 + (swz % 64) / 2; }
__host__ __device__ __forceinline__ int perm32(int rho) { const int n = rho >> 4, i = rho & 15; return 8 * (i >> 2) + 4 * n + (i & 3); }

struct Unit { int pm, pn, seg; };
struct Gemm { const bf16_t* A; const bf16_t* Bt; int M, N, K; const bf16_t* A2; const bf16_t* Bt2; };

struct StaticOrder {
    int nM, nN, nwg, G, c;
    __host__ __device__ void init(int M, int N, int G_, int c_) { nM = M / BM; nN = N / BM; nwg = nM * nN; G = G_; c = c_; }
    __host__ __device__ bool next(int i, Unit& u) const {
        const long L = (long)i * G + c; if (L >= nwg) return false;
        int wgid = (int)L; { const int q = nwg / NXCD, r = nwg % NXCD, xcd = wgid % NXCD, off = wgid / NXCD; wgid = (xcd < r ? xcd * (q + 1) : r * (q + 1) + (xcd - r) * q) + off; }
        const int nig = WGM * nN, gid = wgid / nig, fm = gid * WGM, gsz = (nM - fm) < WGM ? (nM - fm) : WGM;
        u.pm = fm + ((wgid % nig) % gsz); u.pn = (wgid % nig) / gsz; u.seg = 0; return true;
    }
    __device__ __forceinline__ void a_ready(const Unit&) const {}
    __device__ __forceinline__ void done(const Unit&) const {}
};

struct InOrder { int G, c, i0, lim;
    static constexpr int NNG = 832, NMETA = 13, NGATE = 512, NUNITS = NNG + NMETA + NGATE;
    __host__ __device__ bool next(int i, Unit& u) const {
        const int L = (i + i0) * G + c; if (L >= lim) return false;
        u.seg = 0;
        if (L < NNG) { const int x = L & 7, k = L >> 3; u.pn = k >> 3; u.pm = x + 8 * (k & 7); }
        else if (L < NNG + NMETA) { u.pm = 64; u.pn = L - NNG; }
        else { const int L2 = L - (NNG + NMETA) + 5; const int x = L2 & 7; int k = L2 >> 3; if (k == 64) k = 0; u.pn = 13 + (k >> 3); u.pm = x + 8 * (k & 7); }
        return true;
    }
    __device__ __forceinline__ void a_ready(const Unit&) const {}
    __device__ __forceinline__ void done(const Unit&) const {}
};
struct StaticOrder2 { StaticOrder base;
    __host__ __device__ void init(int M, int N, int G_, int c_) { base.init(M, N, G_, c_); }
    __host__ __device__ bool next(int i, Unit& u) const { if (!base.next(i >> 1, u)) return false; u.seg = i & 1; return true; }
    __device__ __forceinline__ void a_ready(const Unit&) const {}
    __device__ __forceinline__ void done(const Unit&) const {}
};
__device__ __forceinline__ unsigned cvt_pk_bf16(float lo, float hi) { unsigned r; asm volatile("v_cvt_pk_bf16_f32 %0, %1, %2" : "=v"(r) : "v"(lo), "v"(hi)); return r; }
typedef float f32x2 __attribute__((ext_vector_type(2)));
__device__ __forceinline__ f32x2 gelu_pk(f32x2 v) {
    const f32x2 av = __builtin_elementwise_abs(v), d = av * 0.2316418882f + 1.0f;
    f32x2 t; t.x = __builtin_amdgcn_rcpf(d.x); t.y = __builtin_amdgcn_rcpf(d.y);
    f32x2 q = t * 0.5307027145f + (-0.7265760135f); q = q * t + 0.7107068705f; q = q * t + (-0.142248368f); q = q * t + 0.127414796f; q = q * t;
    const f32x2 s = (v * v) * (-0.72134752044f);
    f32x2 e; e.x = __builtin_amdgcn_exp2f(s.x); e.y = __builtin_amdgcn_exp2f(s.y);
    const f32x2 m = v * (q * e), r = v - m;
    f32x2 o; o.x = v.x < 0.f ? m.x : r.x; o.y = v.y < 0.f ? m.y : r.y; return o;
}

template <int ACT  > struct EpiBf16 {
    static constexpr bool PERM = true, AFTER_DRAIN = false, TWO_SEG = false, INIT_ACC = false; static_assert(ACT == 0 || ACT == 1, "EpiBf16: ACT is 0 (none) or 1 (gelu_pk)");
    bf16_t* O; int ldc; const float* bias; int split_cols; size_t split_stride; float scale0;
    __device__ __forceinline__ void operator()(const f32x4 (&acc)[2][2][4][2], const Unit& u, int wr, int wc, int fr, int fq) const {
        const int row0 = u.pm * BM + wr * 64 + fr; int colt = u.pn * BM; bf16_t* base = O;
        float sc = 1.f; if (split_cols) { const int t = colt / split_cols; base += (size_t)t * split_stride; colt -= t * split_cols; if (t == 0) sc = scale0; }
        const int col0 = colt + wc * 32 + 8 * fq, bcol0 = u.pn * BM + wc * 32 + 8 * fq;
        f32x4 bv[2][2];
#pragma unroll
        for (int bj = 0; bj < 2; ++bj)
#pragma unroll
            for (int n = 0; n < 2; ++n) bv[bj][n] = bias ? *(const f32x4*)(bias + bcol0 + bj * HALF + 4 * n) : (f32x4){0.f, 0.f, 0.f, 0.f};
#pragma unroll
        for (int ai = 0; ai < 2; ++ai)
#pragma unroll
            for (int m = 0; m < 4; ++m) { bf16_t* rowp = base + (size_t)(row0 + ai * HALF + m * 16) * ldc + col0;
#pragma unroll
                for (int bj = 0; bj < 2; ++bj) { f32x4 v0 = acc[ai][bj][m][0] + bv[bj][0], v1 = acc[ai][bj][m][1] + bv[bj][1];
                    if (ACT == 1) { f32x2 a = gelu_pk((f32x2){v0[0], v0[1]}), b = gelu_pk((f32x2){v0[2], v0[3]}), c = gelu_pk((f32x2){v1[0], v1[1]}), d = gelu_pk((f32x2){v1[2], v1[3]});
                        v0 = (f32x4){a.x, a.y, b.x, b.y}; v1 = (f32x4){c.x, c.y, d.x, d.y}; }
                    v0 = v0 * sc; v1 = v1 * sc; u32x4 w; w.x = cvt_pk_bf16(v0[0], v0[1]); w.y = cvt_pk_bf16(v0[2], v0[3]); w.z = cvt_pk_bf16(v1[0], v1[1]); w.w = cvt_pk_bf16(v1[2], v1[3]);
                    *(u32x4*)(rowp + bj * HALF) = w; } }
    }
};

template <class Epi, class Sched, bool ALIGN_EPI = false, bool SP2 = false>
__device__ __forceinline__ void gemm_phase(PG8_LAS unsigned char* lds, const Gemm g, const Sched& S, const Epi& E) {
    const int tid = threadIdx.x, wid = __builtin_amdgcn_readfirstlane(tid >> 6), lane = tid & 63, wr = wid >> 2, wc = wid & 3, fr = lane & 15, fq = lane >> 4;
    const int K = g.K, nt = K / BK;
    unsigned voffA[2], voffB[2];
#pragma unroll
    for (int i = 0; i < 2; ++i) { int R, C; stage_rc(tid * 16 + i * 8192, R, C); const int Rb = Epi::PERM ? ((R & ~31) + perm32(R & 31)) : R;
        voffA[i] = (unsigned)(R * K + C) * 2u; voffB[i] = (unsigned)(Rb * K + C) * 2u; }
    const size_t kstep = (size_t)(BK * 2);
    const size_t hstep = (size_t)HALF * K * 2;
    const size_t tstep = 2 * hstep;
    const unsigned ldsw = (unsigned)wid * 1024u;
    const int aoff = lds_byte(wr * 64 + fr, fq * 8), boff = lds_byte(wc * 32 + fr, fq * 8);
#define PG8_SA(b, h) (((b) * 2 + (h)) * HTB)
#define PG8_SB(b, h) ((4 + (b) * 2 + (h)) * HTB)
#define PG8_STAGE(bufoff, gbase, voff) do { _Pragma("unroll") for (int _i = 0; _i < 2; ++_i) \
        __builtin_amdgcn_global_load_lds((const unsigned*)((const char*)(gbase) + (voff)[_i]), (PG8_LAS unsigned*)(lds + (bufoff) + ldsw + _i * 8192), 16, 0, 0); } while (0)
#define PG8_LDA(dst, b, h) do { _Pragma("unroll") for (int m = 0; m < 4; ++m) _Pragma("unroll") for (int k = 0; k < 2; ++k) dst[m][k] = *(const PG8_LAS bf16x8*)(lds + PG8_SA(b, h) + aoff + m * 2048 + k * 1024); } while (0)
#define PG8_LDB(dst, b, h) do { _Pragma("unroll") for (int n = 0; n < 2; ++n) _Pragma("unroll") for (int k = 0; k < 2; ++k) dst[n][k] = *(const PG8_LAS bf16x8*)(lds + PG8_SB(b, h) + boff + n * 2048 + k * 1024); } while (0)
#define PG8_MMA(ai, bj, At, Bt) do { __builtin_amdgcn_s_setprio(1); _Pragma("unroll") for (int m = 0; m < 4; ++m) _Pragma("unroll") for (int n = 0; n < 2; ++n) _Pragma("unroll") for (int k = 0; k < 2; ++k) \
        acc[ai][bj][m][n] = __builtin_amdgcn_mfma_f32_16x16x32_bf16(Bt[n][k], At[m][k], acc[ai][bj][m][n], 0, 0, 0); __builtin_amdgcn_s_setprio(0); } while (0)
#define PG8_WAIT_V(n) asm volatile("s_waitcnt vmcnt(" #n ")" ::: "memory")
#define PG8_WAIT_L(n) asm volatile("s_waitcnt lgkmcnt(" #n ")" ::: "memory")
#define PG8_BAR __builtin_amdgcn_s_barrier()
#define PG8_SCHED __builtin_amdgcn_sched_barrier(0)
    Unit cur, nxt; int ui = 0;
    if (!S.next(0, cur)) return;
    f32x4 acc[2][2][4][2];
    if constexpr (Epi::INIT_ACC) E.init(acc, cur, wr, wc, fr, fq);
    else
#pragma unroll
    for (int a = 0; a < 2; ++a)
#pragma unroll
        for (int b = 0; b < 2; ++b)
#pragma unroll
            for (int m = 0; m < 4; ++m)
#pragma unroll
                for (int n = 0; n < 2; ++n) acc[a][b][m][n] = (f32x4){0.f, 0.f, 0.f, 0.f};
    bf16x8 At[4][2], B0[2][2], B1[2][2];
    const char* cA = (const char*)(cur.seg ? g.A2 : g.A) + (size_t)cur.pm * tstep; const char* cB = (const char*)(cur.seg ? g.Bt2 : g.Bt) + (size_t)cur.pn * tstep;
    S.a_ready(cur);
    if constexpr (SP2) {
        PG8_STAGE(PG8_SB(0, 0), cB, voffB); PG8_STAGE(PG8_SB(0, 1), cB + hstep, voffB); PG8_STAGE(PG8_SA(0, 0), cA, voffA); PG8_STAGE(PG8_SA(0, 1), cA + hstep, voffA);
        if (wr == 1) PG8_BAR;
        PG8_WAIT_V(2); PG8_BAR;
        PG8_STAGE(PG8_SB(1, 0), cB + kstep, voffB); PG8_STAGE(PG8_SA(1, 0), cA + kstep, voffA); PG8_STAGE(PG8_SB(1, 1), cB + hstep + kstep, voffB);
        PG8_WAIT_V(6); PG8_BAR;
    } else {
        PG8_STAGE(PG8_SB(0, 0), cB, voffB); PG8_STAGE(PG8_SA(0, 0), cA, voffA); PG8_STAGE(PG8_SB(0, 1), cB + hstep, voffB); PG8_STAGE(PG8_SA(0, 1), cA + hstep, voffA);
        if (wr == 1) PG8_BAR;
        PG8_WAIT_V(4); PG8_BAR;
        PG8_STAGE(PG8_SB(1, 0), cB + kstep, voffB); PG8_STAGE(PG8_SA(1, 0), cA + kstep, voffA); PG8_STAGE(PG8_SB(1, 1), cB + hstep + kstep, voffB);
        PG8_WAIT_V(6); PG8_BAR;
    }
    for (;;) {
        const bool has_next = S.next(ui + 1, nxt);
        const char* nA = has_next ? (const char*)(nxt.seg ? g.A2 : g.A) + (size_t)nxt.pm * tstep : cA; const char* nB = has_next ? (const char*)(nxt.seg ? g.Bt2 : g.Bt) + (size_t)nxt.pn * tstep : cB;
        for (int t = 0; t < nt; t += 2) {
            const bool last = (t == nt - 2);
            const char* a1 = cA + (size_t)(t + 1) * kstep;
            const char* a2 = last ? nA : cA + (size_t)(t + 2) * kstep; const char* b2 = last ? nB : cB + (size_t)(t + 2) * kstep;
            const char* a3 = a2 + kstep; const char* b3 = b2 + kstep;
            if (last && has_next) S.a_ready(nxt);
            if constexpr (SP2) {
            PG8_LDB(B0, 0, 0); PG8_LDB(B1, 0, 1); PG8_SCHED; PG8_LDA(At, 0, 0); PG8_STAGE(PG8_SA(1, 1), a1 + hstep, voffA);
            PG8_WAIT_V(8); PG8_WAIT_L(0); PG8_BAR; PG8_MMA(0, 0, At, B0); PG8_MMA(0, 1, At, B1); PG8_BAR; PG8_SCHED;
            PG8_LDA(At, 0, 1); PG8_STAGE(PG8_SB(0, 0), b2, voffB); PG8_STAGE(PG8_SB(0, 1), b2 + hstep, voffB); PG8_STAGE(PG8_SA(0, 0), a2, voffA);
            PG8_WAIT_V(8); PG8_WAIT_L(0); PG8_BAR; PG8_MMA(1, 0, At, B0); PG8_MMA(1, 1, At, B1); PG8_BAR; PG8_SCHED;
            PG8_LDB(B0, 1, 0); PG8_LDB(B1, 1, 1); PG8_SCHED; PG8_LDA(At, 1, 0); PG8_STAGE(PG8_SA(0, 1), a2 + hstep, voffA);
            PG8_WAIT_V(8); PG8_WAIT_L(0); PG8_BAR; PG8_MMA(0, 0, At, B0); PG8_MMA(0, 1, At, B1); PG8_BAR; PG8_SCHED;
            PG8_LDA(At, 1, 1); PG8_STAGE(PG8_SB(1, 0), b3, voffB); PG8_STAGE(PG8_SB(1, 1), b3 + hstep, voffB); PG8_STAGE(PG8_SA(1, 0), a3, voffA);
            PG8_WAIT_V(8); PG8_WAIT_L(0); PG8_BAR; PG8_MMA(1, 0, At, B0); PG8_MMA(1, 1, At, B1); PG8_BAR; PG8_SCHED;
            } else {
            PG8_LDB(B0, 0, 0); PG8_SCHED; PG8_LDA(At, 0, 0); PG8_STAGE(PG8_SA(1, 1), a1 + hstep, voffA);
            PG8_WAIT_L(8); PG8_BAR; PG8_WAIT_L(0); PG8_MMA(0, 0, At, B0); PG8_BAR; PG8_SCHED;
            PG8_LDB(B1, 0, 1); PG8_STAGE(PG8_SB(0, 0), b2, voffB);
            PG8_BAR; PG8_WAIT_L(0); PG8_MMA(0, 1, At, B1); PG8_BAR;
            PG8_LDA(At, 0, 1); PG8_STAGE(PG8_SA(0, 0), a2, voffA);
            PG8_BAR; PG8_WAIT_L(0); PG8_MMA(1, 0, At, B0); PG8_BAR; PG8_SCHED;
            PG8_STAGE(PG8_SB(0, 1), b2 + hstep, voffB);
            PG8_WAIT_V(6); PG8_BAR; PG8_MMA(1, 1, At, B1); PG8_BAR;
            PG8_LDB(B0, 1, 0); PG8_SCHED; PG8_LDA(At, 1, 0); PG8_STAGE(PG8_SA(0, 1), a2 + hstep, voffA);
            PG8_WAIT_L(8); PG8_BAR; PG8_WAIT_L(0); PG8_MMA(0, 0, At, B0); PG8_BAR; PG8_SCHED;
            PG8_LDB(B1, 1, 1); PG8_STAGE(PG8_SB(1, 0), b3, voffB);
            PG8_BAR; PG8_WAIT_L(0); PG8_MMA(0, 1, At, B1); PG8_BAR;
            PG8_LDA(At, 1, 1); PG8_STAGE(PG8_SA(1, 0), a3, voffA);
            PG8_BAR; PG8_WAIT_L(0); PG8_MMA(1, 0, At, B0); PG8_BAR; PG8_SCHED;
            PG8_STAGE(PG8_SB(1, 1), b3 + hstep, voffB);
            PG8_WAIT_V(6); PG8_BAR; PG8_MMA(1, 1, At, B1); PG8_BAR;
            }
        }
        if constexpr (ALIGN_EPI) { if (wr == 0) PG8_BAR; }
        bool keep = false;
        if constexpr (Epi::TWO_SEG) { if (cur.seg == 0) { E.mid(acc, cur, wr, wc, fr, fq); keep = true; } }
        if (!keep) if constexpr (!Epi::AFTER_DRAIN) { E(acc, cur, wr, wc, fr, fq); S.done(cur); }
        if (!has_next) break;
        if constexpr (Epi::INIT_ACC) { if (!keep) E.init(acc, nxt, wr, wc, fr, fq); }
        else if (!keep)
#pragma unroll
        for (int a = 0; a < 2; ++a)
#pragma unroll
            for (int b = 0; b < 2; ++b)
#pragma unroll
                for (int m = 0; m < 4; ++m)
#pragma unroll
                    for (int n = 0; n < 2; ++n) acc[a][b][m][n] = (f32x4){0.f, 0.f, 0.f, 0.f};
        cur = nxt; cA = nA; cB = nB; ++ui;
        if constexpr (ALIGN_EPI) { if (wr == 1) PG8_BAR; }
    }
    PG8_WAIT_V(0);
    if constexpr (!ALIGN_EPI) { if (wr == 0) PG8_BAR; }
    PG8_BAR;
    if constexpr (Epi::AFTER_DRAIN) { E.fused(acc, cur, wr, wc, fr, fq, lds, wid, lane); S.done(cur); }
#undef PG8_SA
#undef PG8_SB
#undef PG8_STAGE
#undef PG8_LDA
#undef PG8_LDB
#undef PG8_MMA
#undef PG8_WAIT_V
#undef PG8_WAIT_L
#undef PG8_BAR
#undef PG8_SCHED
}
}

#ifndef PG8_SP2
#define PG8_SP2 true
#endif
#ifndef PG8_ALIGN
#define PG8_ALIGN true
#endif

namespace cg = cooperative_groups;
#define LAS __attribute__((address_space(3)))
typedef unsigned short bf16_t;
typedef short bf16x8 __attribute__((ext_vector_type(8)));
typedef short s16x4 __attribute__((ext_vector_type(4)));
typedef float f32x4 __attribute__((ext_vector_type(4)));
typedef float f32x16 __attribute__((ext_vector_type(16)));
typedef unsigned u32x4 __attribute__((ext_vector_type(4)));
typedef unsigned u32x2 __attribute__((ext_vector_type(2)));
typedef float f32x2_t __attribute__((ext_vector_type(2)));
typedef __bf16 bf16x2_t __attribute__((ext_vector_type(2)));

#ifndef MK_SPLIT
#define MK_SPLIT 0
#endif

constexpr int NWAVES = 8;
constexpr int DM = 1024, SEQ = 8192, NBATCH = 2, LP = 8320, MTOK = 16384, M1 = 16640, NIN = 5376, PP = 3328, GW = 2048;
constexpr int AW = 512, BW = 512;
constexpr float RMS_EPS = 1e-6f, LOG2E = 1.4426950408889634f;
constexpr float QSCALE = 0.125f * LOG2E;
constexpr float LAM_INIT = 0.2f;

constexpr size_t MiB = 1u << 20;
constexpr size_t WS_WIN = 1 * MiB, WS_WUA = 12 * MiB, WS_WUB = 13 * MiB, WS_WO = 14 * MiB;
constexpr size_t WS_XN = 16 * MiB, WS_YA = 16 * MiB, WS_YB = 32 * MiB;
constexpr size_t WS_P = 49 * MiB, WS_T = 49 * MiB, WS_MIX = 113 * MiB;
constexpr size_t WS_G = 155 * MiB, WS_END = 219 * MiB;
static_assert(WS_XN + (size_t)M1 * DM * 2 <= WS_P && WS_P + (size_t)M1 * PP * 2 <= WS_G && WS_MIX + (size_t)MTOK * DM * 2 <= WS_G, "ws map");

constexpr int LDS_BYTES = 147456;

__device__ __forceinline__ unsigned f2bf(float f) { unsigned u = __builtin_bit_cast(unsigned, f); return (u + 0x7fffu + ((u >> 16) & 1u)) >> 16; }
__device__ __forceinline__ unsigned pk2(float lo, float hi) { f32x2_t v = {lo, hi}; bf16x2_t b = __builtin_convertvector(v, bf16x2_t); return __builtin_bit_cast(unsigned, b); }
__device__ __forceinline__ float bf2f(unsigned short u) { return __builtin_bit_cast(float, (unsigned)u << 16); }
__device__ __forceinline__ float bflo(unsigned u) { return __builtin_bit_cast(float, u << 16); }
__device__ __forceinline__ float bfhi(unsigned u) { return __builtin_bit_cast(float, u & 0xffff0000u); }
__device__ __forceinline__ float wave_sum(float v) {
#pragma unroll
    for (int o = 1; o < 64; o <<= 1) v += __shfl_xor(v, o);
    return v;
}
__device__ __forceinline__ float wave_max(float v) {
#pragma unroll
    for (int o = 1; o < 64; o <<= 1) v = fmaxf(v, __shfl_xor(v, o));
    return v;
}
__device__ __forceinline__ float fast_exp2(float x) { return __builtin_amdgcn_exp2f(x); }
__device__ __forceinline__ float sigmoidf_(float x) { return __builtin_amdgcn_rcpf(1.0f + fast_exp2(-x * LOG2E)); }

__device__ __forceinline__ int perm_in_col(int c) { const int pn = c >> 8, rem = c & 255, wc = rem >> 6, bj = (rem >> 5) & 1, j = rem & 31; return (pn << 8) + 128 * bj + 32 * wc + j; }

template <bool PERMCOL>
__device__ __forceinline__ void p0_transpose_item(const float* W, int K, int N, bf16_t* WT, LAS float* scr, int item, int lane) {
    const int nblk = N / 32, kb = item / nblk, nb = item % nblk, k0 = 64 * kb, n0 = 32 * nb;
    { f32x4 wv[8];
#pragma unroll
      for (int i = 0; i < 8; ++i) wv[i] = __builtin_nontemporal_load((const f32x4*)(W + (size_t)(k0 + 8 * i + (lane >> 3)) * N + n0 + 4 * (lane & 7)));
#pragma unroll
      for (int i = 0; i < 8; ++i) { LAS float* d = scr + (8 * i + (lane >> 3)) * 33 + 4 * (lane & 7); d[0] = wv[i].x; d[1] = wv[i].y; d[2] = wv[i].z; d[3] = wv[i].w; } }
    asm volatile("s_waitcnt lgkmcnt(0)" ::: "memory");
    const int c = lane & 7;
#pragma unroll
    for (int j = 0; j < 4; ++j) { const int n = (lane >> 3) + 8 * j; const LAS float* s = scr + (8 * c) * 33 + n;
        u32x4 o; o.x = pk2(s[0 * 33], s[1 * 33]); o.y = pk2(s[2 * 33], s[3 * 33]); o.z = pk2(s[4 * 33], s[5 * 33]); o.w = pk2(s[6 * 33], s[7 * 33]);
        const int drow = PERMCOL ? perm_in_col(n0 + n) : (n0 + n);
        *(u32x4*)(WT + (size_t)drow * K + k0 + 8 * c) = o; }
    asm volatile("s_waitcnt lgkmcnt(0)" ::: "memory");
}
__device__ __forceinline__ void rms_rows2_to_bf16(const float* x0, const float* x1, const float* g, bf16_t* o0, bf16_t* o1, int lane) {
    const f32x4 z4 = {0.f, 0.f, 0.f, 0.f};
    f32x4 v0[4], v1[4];
#pragma unroll
    for (int j = 0; j < 4; ++j) { v0[j] = x0 ? __builtin_nontemporal_load((const f32x4*)x0 + lane + 64 * j) : z4; v1[j] = x1 ? __builtin_nontemporal_load((const f32x4*)x1 + lane + 64 * j) : z4; }
    float s0 = 0.f, s1 = 0.f;
#pragma unroll
    for (int j = 0; j < 4; ++j) { s0 += (v0[j].x * v0[j].x + v0[j].y * v0[j].y) + (v0[j].z * v0[j].z + v0[j].w * v0[j].w); s1 += (v1[j].x * v1[j].x + v1[j].y * v1[j].y) + (v1[j].z * v1[j].z + v1[j].w * v1[j].w); }
#pragma unroll
    for (int o = 1; o < 64; o <<= 1) { s0 += __shfl_xor(s0, o); s1 += __shfl_xor(s1, o); }
    const float r0 = 1.0f / sqrtf(s0 * (1.f / DM) + RMS_EPS), r1 = 1.0f / sqrtf(s1 * (1.f / DM) + RMS_EPS);
    unsigned long long* p0 = (unsigned long long*)o0 + lane; unsigned long long* p1 = (unsigned long long*)o1 + lane;
#pragma unroll
    for (int j = 0; j < 4; ++j) { const f32x4 gg = ((const f32x4*)g)[lane + 64 * j]; const f32x4 y0 = v0[j] * r0 * gg, y1 = v1[j] * r1 * gg;
        p0[64 * j] = (unsigned long long)pk2(y0.x, y0.y) | ((unsigned long long)pk2(y0.z, y0.w) << 32);
        if (o1) p1[64 * j] = (unsigned long long)pk2(y1.x, y1.y) | ((unsigned long long)pk2(y1.z, y1.w) << 32); }
}

struct EpiIn {
    static constexpr bool PERM = true, AFTER_DRAIN = false, TWO_SEG = false, INIT_ACC = false;
    bf16_t* P; bf16_t* G; const float* aqn; const float* akn; const float* bqn; const float* bkn;
    __device__ __forceinline__ void operator()(const f32x4 (&acc)[2][2][4][2], const pg8::Unit& u, int wr, int wc, int fr, int fq) const {
        const int c64 = u.pn * 4 + wc;
        const float* gp = nullptr; float gscale = 1.f;
        if (c64 < 8) { gp = aqn; gscale = QSCALE; } else if (c64 < 10) gp = akn; else if (c64 >= 20 && c64 < 28) { gp = bqn; gscale = QSCALE; } else if (c64 >= 28 && c64 < 36) gp = bkn;
        const int mode = gp ? 1 : (((c64 >= 12 && c64 < 20) || (c64 >= 44 && c64 < 52)) ? 2 : (c64 >= 52 ? 3 : 0));
        f32x4 gv[2][2];
#pragma unroll
        for (int bj = 0; bj < 2; ++bj)
#pragma unroll
            for (int n = 0; n < 2; ++n) gv[bj][n] = gp ? *(const f32x4*)(gp + 32 * bj + 8 * fq + 4 * n) * gscale : (f32x4){1.f, 1.f, 1.f, 1.f};
        const bool meta = (u.pm >= 64);
#pragma unroll
        for (int ai = 0; ai < 2; ++ai)
#pragma unroll
            for (int m = 0; m < 4; ++m) {
                const int r = u.pm * 256 + ai * 128 + wr * 64 + m * 16 + fr;
                f32x4 v[2][2];
#pragma unroll
                for (int bj = 0; bj < 2; ++bj)
#pragma unroll
                    for (int n = 0; n < 2; ++n) v[bj][n] = acc[ai][bj][m][n];
                if (mode == 1) {
                    float ss = 0.f;
#pragma unroll
                    for (int bj = 0; bj < 2; ++bj)
#pragma unroll
                        for (int n = 0; n < 2; ++n) { const f32x4 x = v[bj][n]; ss += (x[0] * x[0] + x[1] * x[1]) + (x[2] * x[2] + x[3] * x[3]); }
                    ss += __shfl_xor(ss, 16); ss += __shfl_xor(ss, 32);
                    const float rs = 1.0f / sqrtf(ss * (1.f / 64.f) + RMS_EPS);
#pragma unroll
                    for (int bj = 0; bj < 2; ++bj)
#pragma unroll
                        for (int n = 0; n < 2; ++n) v[bj][n] = v[bj][n] * rs * gv[bj][n];
                } else if (mode == 2) {
#pragma unroll
                    for (int bj = 0; bj < 2; ++bj)
#pragma unroll
                        for (int n = 0; n < 2; ++n)
#pragma unroll
                            for (int e = 0; e < 4; ++e) v[bj][n][e] = v[bj][n][e] * sigmoidf_(v[bj][n][e]);
                } else if (mode == 3) {
#pragma unroll
                    for (int bj = 0; bj < 2; ++bj)
#pragma unroll
                        for (int n = 0; n < 2; ++n)
#pragma unroll
                            for (int e = 0; e < 4; ++e) v[bj][n][e] = sigmoidf_(v[bj][n][e]);
                }
#pragma unroll
                for (int bj = 0; bj < 2; ++bj) {
                    u32x4 w; w.x = pk2(v[bj][0][0], v[bj][0][1]); w.y = pk2(v[bj][0][2], v[bj][0][3]); w.z = pk2(v[bj][1][0], v[bj][1][1]); w.w = pk2(v[bj][1][2], v[bj][1][3]);
                    if (c64 < 52) {
                        const int col = c64 * 64 + 32 * bj + 8 * fq;
                        if (!meta) { const int prow = r + 128 * ((r >> 13) + 1); *(u32x4*)(P + (size_t)prow * PP + col) = w; }
                        else { const int i = r - MTOK; if (i < 128) { const int tp = (i + 112) & 127; *(u32x4*)(P + (size_t)tp * PP + col) = w; *(u32x4*)(P + (size_t)(LP + tp) * PP + col) = w; } }
                    } else if (!meta) {
                        *(u32x4*)(G + (size_t)r * GW + (c64 - 52) * 64 + 32 * bj + 8 * fq) = w;
                    }
                }
            }
    }
};

struct EpiUp {
    static constexpr bool PERM = true, AFTER_DRAIN = false, TWO_SEG = true, INIT_ACC = false;
    const bf16_t* G; bf16_t* MIX;
    __device__ __forceinline__ void mid(f32x4 (&acc)[2][2][4][2], const pg8::Unit& u, int wr, int wc, int fr, int fq) const {
#pragma unroll
        for (int ai = 0; ai < 2; ++ai)
#pragma unroll
            for (int m = 0; m < 4; ++m) { const int r = u.pm * 256 + ai * 128 + wr * 64 + m * 16 + fr;
#pragma unroll
                for (int bj = 0; bj < 2; ++bj) { const int c0 = u.pn * 256 + 128 * bj + 32 * wc + 8 * fq;
                    const u32x4 ga = *(const u32x4*)(G + (size_t)r * GW + c0), gb = *(const u32x4*)(G + (size_t)r * GW + DM + c0);
                    f32x4& a = acc[ai][bj][m][0]; f32x4& b = acc[ai][bj][m][1];
#define RAT(x, y) ((x) * __builtin_amdgcn_rcpf(fmaxf((y), 1e-30f)))
                    a[0] *= RAT(bflo(ga.x), bflo(gb.x)); a[1] *= RAT(bfhi(ga.x), bfhi(gb.x)); a[2] *= RAT(bflo(ga.y), bflo(gb.y)); a[3] *= RAT(bfhi(ga.y), bfhi(gb.y));
                    b[0] *= RAT(bflo(ga.z), bflo(gb.z)); b[1] *= RAT(bfhi(ga.z), bfhi(gb.z)); b[2] *= RAT(bflo(ga.w), bflo(gb.w)); b[3] *= RAT(bfhi(ga.w), bfhi(gb.w));
#undef RAT
                } }
    }
    __device__ __forceinline__ void operator()(const f32x4 (&acc)[2][2][4][2], const pg8::Unit& u, int wr, int wc, int fr, int fq) const {
#pragma unroll
        for (int ai = 0; ai < 2; ++ai)
#pragma unroll
            for (int m = 0; m < 4; ++m) { const int r = u.pm * 256 + ai * 128 + wr * 64 + m * 16 + fr;
#pragma unroll
                for (int bj = 0; bj < 2; ++bj) { const int c0 = u.pn * 256 + 128 * bj + 32 * wc + 8 * fq;
                    const u32x4 g = *(const u32x4*)(G + (size_t)r * GW + DM + c0);
                    const f32x4 a = acc[ai][bj][m][0], b = acc[ai][bj][m][1];
                    u32x4 w; w.x = pk2(a[0] * bflo(g.x), a[1] * bfhi(g.x)); w.y = pk2(a[2] * bflo(g.y), a[3] * bfhi(g.y)); w.z = pk2(b[0] * bflo(g.z), b[1] * bfhi(g.z)); w.w = pk2(b[2] * bflo(g.w), b[3] * bfhi(g.w));
                    *(u32x4*)(MIX + (size_t)r * DM + c0) = w; } }
    }
};
struct EpiOut {
    static constexpr bool PERM = true, AFTER_DRAIN = false, TWO_SEG = false, INIT_ACC = true;
    const float* X; float* O;
    __device__ __forceinline__ void init(f32x4 (&acc)[2][2][4][2], const pg8::Unit& u, int wr, int wc, int fr, int fq) const {
#pragma unroll
        for (int ai = 0; ai < 2; ++ai)
#pragma unroll
            for (int m = 0; m < 4; ++m) { const int r = u.pm * 256 + ai * 128 + wr * 64 + m * 16 + fr;
#pragma unroll
                for (int bj = 0; bj < 2; ++bj) { const float* xp = X + (size_t)r * DM + u.pn * 256 + 128 * bj + 32 * wc + 8 * fq;
                    acc[ai][bj][m][0] = __builtin_nontemporal_load((const f32x4*)xp); acc[ai][bj][m][1] = __builtin_nontemporal_load((const f32x4*)(xp + 4)); } }
    }
    __device__ __forceinline__ void operator()(const f32x4 (&acc)[2][2][4][2], const pg8::Unit& u, int wr, int wc, int fr, int fq) const {
#pragma unroll
        for (int ai = 0; ai < 2; ++ai)
#pragma unroll
            for (int m = 0; m < 4; ++m) { const int r = u.pm * 256 + ai * 128 + wr * 64 + m * 16 + fr;
#pragma unroll
                for (int bj = 0; bj < 2; ++bj) { float* op = O + (size_t)r * DM + u.pn * 256 + 128 * bj + 32 * wc + 8 * fq;
                    __builtin_nontemporal_store(acc[ai][bj][m][0], (f32x4*)op); __builtin_nontemporal_store(acc[ai][bj][m][1], (f32x4*)(op + 4)); } }
    }
};

#define MFMA32(a, b, c) __builtin_amdgcn_mfma_f32_32x32x16_bf16(a, b, c, 0, 0, 0)
#define SBAR() __builtin_amdgcn_sched_barrier(0)
typedef short v4i16_t __attribute__((ext_vector_type(4)));
__device__ __forceinline__ int crow(int r, int hi) { return (r & 3) + 8 * (r >> 2) + 4 * hi; }
__device__ __forceinline__ s16x4 vtr(const LAS unsigned char* p) { return __builtin_bit_cast(s16x4, __builtin_amdgcn_ds_read_tr16_b64_v4i16((LAS v4i16_t*)p)); }
__device__ __forceinline__ bf16x8 cat8(s16x4 lo, s16x4 hi) { return (bf16x8){lo[0], lo[1], lo[2], lo[3], hi[0], hi[1], hi[2], hi[3]}; }
__device__ __forceinline__ bf16x8 pack8(const f32x16& p, int b) {
    u32x4 w; w.x = pk2(p[b], p[b + 1]); w.y = pk2(p[b + 2], p[b + 3]); w.z = pk2(p[b + 4], p[b + 5]); w.w = pk2(p[b + 6], p[b + 7]); return __builtin_bit_cast(bf16x8, w); }
constexpr int ATT_SCR = 98304;

#define B_QK_INIT(N0, N1, T) do { float sl_ = slope2; asm volatile("" : "+v"(sl_));     \
    const float tb_ = sl_ * (float)(64 * (T) - (128 * qb + 32 * wq)) + abase; \
      \
    _Pragma("unroll") for (int r = 0; r < 16; ++r) { float a_ = fmaf(sl_, (float)((r & 3) + 8 * (r >> 2)), tb_), b_ = fmaf(sl_, (float)((r & 3) + 8 * (r >> 2) + 32), tb_); \
        asm("" : "+v"(a_)); asm("" : "+v"(b_)); N0[r] = a_; N1[r] = b_; } } while (0)
#define B_EXP4(C, B) do { C[B] = fast_exp2(C[B]); C[B + 1] = fast_exp2(C[B + 1]); C[B + 2] = fast_exp2(C[B + 2]); C[B + 3] = fast_exp2(C[B + 3]); } while (0)
#define B_STEP(C0, C1, N0, N1, T) do { \
    const int t_ = (T); const bool has1 = (t_ + 1 <= t1), has2 = (t_ + 2 <= t1), has3 = (t_ + 3 <= t1); \
    const int r0_ = (t_ - t0) % 3, r1_ = (r0_ == 2) ? 0 : r0_ + 1, r2_ = (r1_ == 2) ? 0 : r1_ + 1;     \
    if (has3) { const size_t go = (size_t)(t_ + 3) * 64 * PP; const int kn_ = r0_ * 16384 + w * 1024; GLDS16(k0src + go, lds + kn_); GLDS16(k1src + go, lds + kn_ + 8192); } \
    if (has2) { const size_t go = (size_t)(t_ + 2) * 64 * PP; const int vn_ = 49152 + r2_ * 16384 + vdw; GLDS16(vsrc + go, lds + vn_); GLDS16(vsrc + go + 64, lds + vn_ + 8192); } \
    if (has1) { \
        const LAS unsigned char* kb = lds + r1_ * 16384 + map * 8192; \
        bf16x8 kf[8]; \
        _Pragma("unroll") for (int d0 = 0; d0 < 4; ++d0) { kf[2 * d0] = *(const LAS bf16x8*)(kb + koff[d0]); kf[2 * d0 + 1] = *(const LAS bf16x8*)(kb + koff[d0] + 4096); } \
        B_QK_INIT(N0, N1, t_ + 1); \
        SBAR(); \
        N0 = MFMA32(kf[0], qr[0], N0); B_EXP4(C0, 0); SBAR(); \
        N1 = MFMA32(kf[1], qr[0], N1); B_EXP4(C1, 0); SBAR(); \
        N0 = MFMA32(kf[2], qr[1], N0); B_EXP4(C0, 4); SBAR(); \
        N1 = MFMA32(kf[3], qr[1], N1); B_EXP4(C1, 4); SBAR(); \
        N0 = MFMA32(kf[4], qr[2], N0); B_EXP4(C0, 8); SBAR(); \
        N1 = MFMA32(kf[5], qr[2], N1); B_EXP4(C1, 8); SBAR(); \
        N0 = MFMA32(kf[6], qr[3], N0); B_EXP4(C0, 12); SBAR(); \
        N1 = MFMA32(kf[7], qr[3], N1); B_EXP4(C1, 12); SBAR(); \
    } else { \
        _Pragma("unroll") for (int r = 0; r < 16; ++r) { C0[r] = fast_exp2(C0[r]); C1[r] = fast_exp2(C1[r]); } \
    } \
    const LAS unsigned char* vb = lds + 49152 + r0_ * 16384 + vlane; \
    s16x4 va[8], vc[8];                                             \
    _Pragma("unroll") for (int d = 0; d < 4; ++d) { va[2 * d] = vtr(vb + d * 4096); va[2 * d + 1] = vtr(vb + d * 4096 + 512); } \
    if (t_ == 1 || t_ >= 2 * qb) {                                  \
        _Pragma("unroll") for (int r = 0; r < 16; ++r) { const int k0t = 64 * t_ + crow(r, hi), k1t = k0t + 32; \
            if (k0t > qt || k0t < 112) C0[r] = 0.f; if (k1t > qt || k1t < 112) C1[r] = 0.f; } \
    } \
      \
    const bf16x8 pw0 = pack8(C0, 0); \
    _Pragma("unroll") for (int d = 0; d < 4; ++d) { vc[2 * d] = vtr(vb + d * 4096 + 1024); vc[2 * d + 1] = vtr(vb + d * 4096 + 1536); } \
    SBAR(); \
    o[0] = MFMA32(pw0, cat8(va[0], va[1]), o[0]); o[1] = MFMA32(pw0, cat8(va[2], va[3]), o[1]); \
    o[2] = MFMA32(pw0, cat8(va[4], va[5]), o[2]); o[3] = MFMA32(pw0, cat8(va[6], va[7]), o[3]); \
    const bf16x8 pw1 = pack8(C0, 8); \
    float a_ = ((C0[0] + C0[1]) + (C0[2] + C0[3])) + ((C0[4] + C0[5]) + (C0[6] + C0[7])); \
    SBAR(); \
    _Pragma("unroll") for (int d = 0; d < 4; ++d) { va[2 * d] = vtr(vb + d * 4096 + 2048); va[2 * d + 1] = vtr(vb + d * 4096 + 2560); } \
    o[0] = MFMA32(pw1, cat8(vc[0], vc[1]), o[0]); o[1] = MFMA32(pw1, cat8(vc[2], vc[3]), o[1]); \
    o[2] = MFMA32(pw1, cat8(vc[4], vc[5]), o[2]); o[3] = MFMA32(pw1, cat8(vc[6], vc[7]), o[3]); \
    const bf16x8 pw2 = pack8(C1, 0); \
    a_ += ((C0[8] + C0[9]) + (C0[10] + C0[11])) + ((C0[12] + C0[13]) + (C0[14] + C0[15])); \
    SBAR(); \
    _Pragma("unroll") for (int d = 0; d < 4; ++d) { vc[2 * d] = vtr(vb + d * 4096 + 3072); vc[2 * d + 1] = vtr(vb + d * 4096 + 3584); } \
    o[0] = MFMA32(pw2, cat8(va[0], va[1]), o[0]); o[1] = MFMA32(pw2, cat8(va[2], va[3]), o[1]); \
    o[2] = MFMA32(pw2, cat8(va[4], va[5]), o[2]); o[3] = MFMA32(pw2, cat8(va[6], va[7]), o[3]); \
    const bf16x8 pw3 = pack8(C1, 8); \
    a_ += ((C1[0] + C1[1]) + (C1[2] + C1[3])) + ((C1[4] + C1[5]) + (C1[6] + C1[7])); \
    SBAR(); \
    o[0] = MFMA32(pw3, cat8(vc[0], vc[1]), o[0]); o[1] = MFMA32(pw3, cat8(vc[2], vc[3]), o[1]); \
    o[2] = MFMA32(pw3, cat8(vc[4], vc[5]), o[2]); o[3] = MFMA32(pw3, cat8(vc[6], vc[7]), o[3]); \
    a_ += ((C1[8] + C1[9]) + (C1[10] + C1[11])) + ((C1[12] + C1[13]) + (C1[14] + C1[15])); \
    lsum += a_; \
    SBAR(); \
      \
      \
    if (has3 && has2) asm volatile("s_waitcnt vmcnt(4) lgkmcnt(0)\n\ts_barrier" ::: "memory"); \
    else asm volatile("s_waitcnt vmcnt(0) lgkmcnt(0)\n\ts_barrier" ::: "memory"); \
} while (0)

__device__ __forceinline__ void attn_b_core(const bf16_t* __restrict__ P, float kmax, int b, int h, int qb, int t0, int t1, LAS unsigned char* lds, f32x16 (&o)[4], float& lsum) {
    int tid = threadIdx.x; asm volatile("" : "+v"(tid));
    const int lane = tid & 63, r32 = lane & 31, hi = lane >> 5; const int w = __builtin_amdgcn_readfirstlane(tid >> 6);
    const int map = w >> 2, wq = w & 3;
    const size_t rowbase = (size_t)b * LP;
    const float slope2 = exp2f(-2.0f * (float)(h + 1)) * LOG2E;
    const int krow = 8 * w + (lane >> 3);
    const bf16_t* k0src = P + (rowbase + krow) * PP + 1792 + h * 128 + (((lane & 7) ^ ((krow >> 1) & 7)) << 3);
    const bf16_t* k1src = k0src + 64;
    const bf16_t* vsrc = P + (rowbase + 16 * (w & 3) + (lane >> 2)) * PP + 2304 + h * 128 + (w >> 2) * 32 + (lane & 3) * 8;
    const int vdw = (w >> 2) * 4096 + (w & 3) * 1024;
    int koff[4];
#pragma unroll
    for (int d0 = 0; d0 < 4; ++d0) koff[d0] = r32 * 128 + ((((2 * d0 + hi) ^ ((r32 >> 1) & 7))) << 4);
#define GLDS16(gp, lp) __builtin_amdgcn_global_load_lds((const unsigned*)(gp), (LAS unsigned*)(lp), 16, 0, 0)
    const int qt = 128 * qb + 32 * wq + r32;
    bf16x8 qr[4];
    { const bf16_t* qp = P + (rowbase + qt) * PP + 1280 + h * 128 + map * 64 + 8 * hi;
#pragma unroll
      for (int d0 = 0; d0 < 4; ++d0) qr[d0] = *(const bf16x8*)(qp + 16 * d0); }
    float qss = 0.f;
#pragma unroll
    for (int d0 = 0; d0 < 4; ++d0)
#pragma unroll
        for (int e = 0; e < 8; ++e) { const float f = bf2f((unsigned short)qr[d0][e]); qss += f * f; }
    qss += __shfl_xor(qss, 32);
    const float mrow = sqrtf(qss) * kmax;
    const float abase = -slope2 * (float)(r32 - 4 * hi) - mrow;
#pragma unroll
    for (int d = 0; d < 4; ++d) o[d] = f32x16{};
    lsum = 0.f;
    const int vlane = ((lane >> 4) & 1) * 32 + (lane & 3) * 8 + (4 * hi + ((lane & 15) >> 2)) * 64;
    { const size_t go = (size_t)t0 * 64 * PP, g1 = (size_t)64 * PP;
      GLDS16(k0src + go, lds + w * 1024); GLDS16(k1src + go, lds + 8192 + w * 1024); GLDS16(vsrc + go, lds + 49152 + vdw); GLDS16(vsrc + go + 64, lds + 49152 + vdw + 8192);
      if (t0 + 1 <= t1) { GLDS16(k0src + go + g1, lds + 16384 + w * 1024); GLDS16(k1src + go + g1, lds + 16384 + 8192 + w * 1024);
                          GLDS16(vsrc + go + g1, lds + 49152 + 16384 + vdw); GLDS16(vsrc + go + g1 + 64, lds + 49152 + 16384 + vdw + 8192); }
      if (t0 + 2 <= t1) { GLDS16(k0src + go + 2 * g1, lds + 32768 + w * 1024); GLDS16(k1src + go + 2 * g1, lds + 32768 + 8192 + w * 1024); } }
    asm volatile("s_waitcnt vmcnt(0)" ::: "memory");
    __syncthreads();
    f32x16 sA0, sA1, sB0, sB1;
    { const LAS unsigned char* kb = lds + map * 8192;
      B_QK_INIT(sA0, sA1, t0);
#pragma unroll
      for (int d0 = 0; d0 < 4; ++d0) { const bf16x8 k0 = *(const LAS bf16x8*)(kb + koff[d0]), k1 = *(const LAS bf16x8*)(kb + koff[d0] + 4096);
          sA0 = MFMA32(k0, qr[d0], sA0); sA1 = MFMA32(k1, qr[d0], sA1); } }
    __syncthreads();
    for (int t = t0; t <= t1; t += 2) {
        B_STEP(sA0, sA1, sB0, sB1, t);
        if (t + 1 <= t1) B_STEP(sB0, sB1, sA0, sA1, t + 1);
    }
}
#undef B_STEP
#undef GLDS16
#undef B_EXP4
#undef B_QK_INIT
__device__ __forceinline__ void attn_b_finalize(const bf16_t* __restrict__ P, bf16_t* __restrict__ YB, const float* __restrict__ subln, float lam, int b, int h, int qb, LAS unsigned char* lds, f32x16 (&o)[4], float lsum) {
    int tid = threadIdx.x; asm volatile("" : "+v"(tid));
    const int lane = tid & 63, r32 = lane & 31, hi = lane >> 5; const int w = __builtin_amdgcn_readfirstlane(tid >> 6);
    const int map = w >> 2, wq = w & 3;
    const size_t rowbase = (size_t)b * LP;
    lsum += __shfl_xor(lsum, 32);
    LAS float* scr = (LAS float*)(lds + ATT_SCR) + w * 32;
    { float inv = 1.0f / lsum; if (map == 1) inv *= lam; if (hi == 0) scr[r32] = inv; }
    float rl[16];
#pragma unroll
    for (int r = 0; r < 16; ++r) rl[r] = scr[crow(r, hi)];
#pragma unroll
    for (int d0 = 0; d0 < 4; ++d0)
#pragma unroll
        for (int r = 0; r < 16; ++r) o[d0][r] *= rl[r];
    LAS float* X = (LAS float*)lds;
    if (map == 1) {
#pragma unroll
        for (int d0 = 0; d0 < 4; ++d0)
#pragma unroll
            for (int r = 0; r < 16; ++r) X[((wq * 4 + d0) * 16 + r) * 64 + lane] = o[d0][r];
    }
    __syncthreads();
    LAS unsigned short* Y = (LAS unsigned short*)(lds + 65536);
    if (map == 0) {
        float rn[16];
#pragma unroll
        for (int r = 0; r < 16; ++r) { float ss = 0.f;
#pragma unroll
            for (int d0 = 0; d0 < 4; ++d0) { o[d0][r] -= X[((wq * 4 + d0) * 16 + r) * 64 + lane]; ss += o[d0][r] * o[d0][r]; }
            ss += __shfl_xor(ss, 1); ss += __shfl_xor(ss, 2); ss += __shfl_xor(ss, 4); ss += __shfl_xor(ss, 8); ss += __shfl_xor(ss, 16);
            rn[r] = (1.0f - LAM_INIT) / sqrtf(ss * (1.f / 128.f) + RMS_EPS); }
#pragma unroll
        for (int d0 = 0; d0 < 4; ++d0) { const float sg = subln[32 * d0 + r32];
#pragma unroll
            for (int r = 0; r < 16; ++r) Y[(32 * wq + crow(r, hi)) * 128 + 32 * d0 + r32] = (unsigned short)f2bf(o[d0][r] * rn[r] * sg); }
    }
    __syncthreads();
    { u32x4 yv[4], zv[4];
#pragma unroll
      for (int i = 0; i < 4; ++i) { const int x = tid + 512 * i, row = x >> 4, c = x & 15;
          yv[i] = *(const LAS u32x4*)(Y + row * 128 + c * 8);
          zv[i] = *(const u32x4*)(P + (rowbase + 128 * qb + row) * PP + 2816 + h * 128 + c * 8); }
#pragma unroll
      for (int i = 0; i < 4; ++i) { const int x = tid + 512 * i, row = x >> 4, c = x & 15;
          u32x4 ov; ov.x = pk2(bflo(yv[i].x) * bflo(zv[i].x), bfhi(yv[i].x) * bfhi(zv[i].x)); ov.y = pk2(bflo(yv[i].y) * bflo(zv[i].y), bfhi(yv[i].y) * bfhi(zv[i].y));
          ov.z = pk2(bflo(yv[i].z) * bflo(zv[i].z), bfhi(yv[i].z) * bfhi(zv[i].z)); ov.w = pk2(bflo(yv[i].w) * bflo(zv[i].w), bfhi(yv[i].w) * bfhi(zv[i].w));
          __builtin_nontemporal_store(ov, (u32x4*)(YB + ((size_t)b * SEQ + 128 * (qb - 1) + row) * BW + h * 128 + c * 8)); } }
    __syncthreads();
}

__device__ __forceinline__ void attn_a_unit(const bf16_t* __restrict__ P, bf16_t* __restrict__ YA, const float* __restrict__ sink, float kmax, int b, int kvh, int qb, LAS unsigned char* lds) {
    int tid = threadIdx.x; asm volatile("" : "+v"(tid));
    const int lane = tid & 63, r32 = lane & 31, hi = lane >> 5; const int w = __builtin_amdgcn_readfirstlane(tid >> 6);
    const size_t rowbase = (size_t)b * LP; const int kt0 = 128 * (qb - 1);
    { u32x4 kk[4], vv[4];
#pragma unroll
      for (int j = 0; j < 4; ++j) { kk[j] = *(const u32x4*)(P + (rowbase + kt0 + 64 * j + lane) * PP + 512 + kvh * 64 + w * 8);
                                    vv[j] = *(const u32x4*)(P + (rowbase + kt0 + 64 * j + (tid >> 3)) * PP + 640 + kvh * 64 + (tid & 7) * 8); }
#pragma unroll
      for (int j = 0; j < 4; ++j) { *(LAS u32x4*)(lds + j * 8192 + w * 1024 + lane * 16) = kk[j];
                                    *(LAS u32x4*)(lds + 32768 + j * 8192 + ((tid & 7) >> 2) * 4096 + (tid >> 3) * 64 + (tid & 3) * 16) = vv[j]; } }
    __syncthreads();
    const int g = w >> 1, hq = kvh * 4 + g;
    const float slope2 = exp2f(-(float)(hq + 1)) * LOG2E, sink2 = sink[hq] * LOG2E;
    const int vlane = ((lane >> 4) & 1) * 32 + (lane & 3) * 8 + (4 * hi + ((lane & 15) >> 2)) * 64;
    LAS float* scr = (LAS float*)(lds + ATT_SCR) + w * 32;
    for (int sub = 0; sub < 2; ++sub) {
        const int q0 = 64 * (w & 1) + 32 * sub; const int qrel = 128 + q0 + r32;
        bf16x8 qr[4];
        { const bf16_t* qp = P + (rowbase + kt0 + qrel) * PP + hq * 64 + 8 * hi;
#pragma unroll
          for (int d0 = 0; d0 < 4; ++d0) qr[d0] = *(const bf16x8*)(qp + 16 * d0); }
        float qss = 0.f;
#pragma unroll
        for (int d0 = 0; d0 < 4; ++d0)
#pragma unroll
            for (int e = 0; e < 8; ++e) { const float f = bf2f((unsigned short)qr[d0][e]); qss += f * f; }
        qss += __shfl_xor(qss, 32);
        const float cref = fmaxf(sqrtf(qss) * kmax, sink2);
        f32x16 o[2]; o[0] = f32x16{}; o[1] = f32x16{}; float lsum = 0.f;
        for (int jj = 0; jj < 3; ++jj) { const int j = (w & 1) + jj;
            f32x16 s0, s1;
#pragma unroll
            for (int r = 0; r < 16; ++r) { const int d0_ = qrel - (64 * j + crow(r, hi)); s0[r] = -slope2 * (float)d0_ - cref; s1[r] = -slope2 * (float)(d0_ - 32) - cref; }
            const LAS unsigned char* kb = lds + j * 8192 + hi * 1024 + r32 * 16;
#pragma unroll
            for (int d0 = 0; d0 < 4; ++d0) {
                const bf16x8 k0 = *(const LAS bf16x8*)(kb + d0 * 2048), k1 = *(const LAS bf16x8*)(kb + d0 * 2048 + 512);
                s0 = MFMA32(k0, qr[d0], s0); s1 = MFMA32(k1, qr[d0], s1); }
#pragma unroll
            for (int r = 0; r < 16; ++r) { const int kr = 64 * j + crow(r, hi); const int da = qrel - kr, db = da - 32;
                const float e0 = fast_exp2(s0[r]), e1 = fast_exp2(s1[r]);
                s0[r] = (da >= 0 && da < 128 && kt0 + kr >= 112) ? e0 : 0.f;
                s1[r] = (db >= 0 && db < 128 && kt0 + kr + 32 >= 112) ? e1 : 0.f; }
            { float a = 0.f;
#pragma unroll
              for (int r = 0; r < 16; ++r) a += s0[r] + s1[r];
              lsum += a; }
            const bf16x8 pw0 = pack8(s0, 0), pw1 = pack8(s0, 8), pw2 = pack8(s1, 0), pw3 = pack8(s1, 8);
            const LAS unsigned char* vb = lds + 32768 + j * 8192 + vlane;
#pragma unroll
            for (int d0 = 0; d0 < 2; ++d0) {
                o[d0] = MFMA32(pw0, cat8(vtr(vb + d0 * 4096), vtr(vb + d0 * 4096 + 512)), o[d0]);
                o[d0] = MFMA32(pw1, cat8(vtr(vb + d0 * 4096 + 1024), vtr(vb + d0 * 4096 + 1536)), o[d0]);
                o[d0] = MFMA32(pw2, cat8(vtr(vb + d0 * 4096 + 2048), vtr(vb + d0 * 4096 + 2560)), o[d0]);
                o[d0] = MFMA32(pw3, cat8(vtr(vb + d0 * 4096 + 3072), vtr(vb + d0 * 4096 + 3584)), o[d0]);
            }
        }
        lsum += __shfl_xor(lsum, 32);
        { const float inv = 1.0f / (lsum + fast_exp2(sink2 - cref)); if (hi == 0) scr[r32] = inv; }
        float rl[16];
#pragma unroll
        for (int r = 0; r < 16; ++r) rl[r] = scr[crow(r, hi)];
        LAS unsigned short* Yw = (LAS unsigned short*)(lds + 65536) + w * 2048;
#pragma unroll
        for (int d0 = 0; d0 < 2; ++d0)
#pragma unroll
            for (int r = 0; r < 16; ++r) Yw[crow(r, hi) * 64 + 32 * d0 + r32] = (unsigned short)f2bf(o[d0][r] * rl[r]);
        { u32x4 yv[4], zv[4];
#pragma unroll
          for (int i = 0; i < 4; ++i) { const int row = i * 8 + (lane >> 3), c = lane & 7;
              yv[i] = *(const LAS u32x4*)(Yw + row * 64 + c * 8);
              zv[i] = *(const u32x4*)(P + (rowbase + kt0 + 128 + q0 + row) * PP + 768 + hq * 64 + c * 8); }
#pragma unroll
          for (int i = 0; i < 4; ++i) { const int row = i * 8 + (lane >> 3), c = lane & 7;
              u32x4 ov; ov.x = pk2(bflo(yv[i].x) * bflo(zv[i].x), bfhi(yv[i].x) * bfhi(zv[i].x)); ov.y = pk2(bflo(yv[i].y) * bflo(zv[i].y), bfhi(yv[i].y) * bfhi(zv[i].y));
              ov.z = pk2(bflo(yv[i].z) * bflo(zv[i].z), bfhi(yv[i].z) * bfhi(zv[i].z)); ov.w = pk2(bflo(yv[i].w) * bflo(zv[i].w), bfhi(yv[i].w) * bfhi(zv[i].w));
              __builtin_nontemporal_store(ov, (u32x4*)(YA + ((size_t)b * SEQ + kt0 + q0 + row) * AW + hq * 64 + c * 8)); } }
    }
    __syncthreads();
}

constexpr size_t WS_SLOT = 219 * MiB; constexpr int SLOT_BYTES = 133120, SLOT_MAX = 280;
constexpr int TAB_OFF = 102400;
constexpr int CW_QUEUE = 8192;
__device__ __forceinline__ void unit_decode(int j, int& b, int& h, int& qb) { h = 3 - (j >> 7); const int jj = j & 127; qb = 64 - (jj >> 1); b = jj & 1; }
__device__ __forceinline__ int b_window(int h, float mmax) {
    const float slope2 = exp2f(-2.0f * (float)(h + 1)) * LOG2E;
    const float need = 24.0f + 2.0f * mmax + log2f(1.0f / (slope2 * 0.69314718f));
    const float d = ceilf(need / slope2) + 1.0f;
    return d > 1.0e6f ? 1000000 : (int)d;
}
__device__ __forceinline__ int b_tmin(int qb, int dh) { const int k = 128 * qb - dh; return k < 128 ? 1 : (k >> 6); }
__device__ __forceinline__ void b_store_partial(unsigned char* ws, int slot, const f32x16 (&o)[4], float lsum) {
    int tid = threadIdx.x; asm volatile("" : "+v"(tid));
    const int lane = tid & 63; const int w = __builtin_amdgcn_readfirstlane(tid >> 6);
    float* S = (float*)(ws + WS_SLOT + (size_t)slot * SLOT_BYTES);
#pragma unroll
    for (int d0 = 0; d0 < 4; ++d0)
#pragma unroll
        for (int r = 0; r < 16; ++r) S[((w * 4 + d0) * 16 + r) * 64 + lane] = o[d0][r];
    S[32768 + w * 64 + lane] = lsum;
}
__device__ __forceinline__ void b_load_partials(const unsigned char* ws, int slot0, int nc, f32x16 (&o)[4], float& lsum) {
    int tid = threadIdx.x; asm volatile("" : "+v"(tid));
    const int lane = tid & 63; const int w = __builtin_amdgcn_readfirstlane(tid >> 6);
#pragma unroll
    for (int d = 0; d < 4; ++d) o[d] = f32x16{};
    lsum = 0.f;
    for (int c = 0; c < nc; ++c) { const float* S = (const float*)(ws + WS_SLOT + (size_t)(slot0 + c) * SLOT_BYTES);
#pragma unroll
        for (int d0 = 0; d0 < 4; ++d0)
#pragma unroll
            for (int r = 0; r < 16; ++r) o[d0][r] += S[((w * 4 + d0) * 16 + r) * 64 + lane];
        lsum += S[32768 + w * 64 + lane]; }
}

#define GAS __attribute__((address_space(1)))
typedef GAS unsigned gu32;
typedef GAS unsigned long long gu64;
#define RLX_AGENT __ATOMIC_RELAXED, __HIP_MEMORY_SCOPE_AGENT
#define LDS_WAIT() asm volatile("s_waitcnt lgkmcnt(0)" ::: "memory")
#define VM_WAIT() asm volatile("s_waitcnt vmcnt(0)" ::: "memory")
__device__ __forceinline__ unsigned long long rt() { return __builtin_amdgcn_s_memrealtime(); }
#define XB_TMO      128
#define XB_XCNT(j)  (256  + 64 * (j))
#define XB_XSUB(j)  (1280 + 64 * (j))
#define XB_XGEN(j)  (2304 + 64 * (j))
#define XB_TOP      3328
#define XB_TOPGEN   3392
#define XCD_BAR_WORDS 3456
#define XB_SPIN_CAP (1u << 18)

__device__ __forceinline__ unsigned xb_ld(unsigned* p)              { return __hip_atomic_load(p, __ATOMIC_RELAXED, __HIP_MEMORY_SCOPE_AGENT); }
__device__ __forceinline__ unsigned xb_add(unsigned* p, unsigned v) { return __hip_atomic_fetch_add(p, v, __ATOMIC_RELAXED, __HIP_MEMORY_SCOPE_AGENT); }
__device__ __forceinline__ unsigned xb_xcc_id() { return (unsigned)__builtin_amdgcn_s_getreg((3 << 11) | 20) & 0xFu; }
#define XB_SPIN(cond, bar) do { unsigned _sp = 0; while (cond) { __builtin_amdgcn_s_sleep(1); \
    if ((++_sp & 255u) == 0u) { if (xb_ld(&(bar)[XB_TMO])) break; if (_sp > XB_SPIN_CAP) { atomicAdd(&(bar)[XB_TMO], 1u); break; } } } } while (0)

struct XcdBarrier {
    unsigned* bar; unsigned x;
    volatile LAS unsigned* st;
};

__device__ __forceinline__ XcdBarrier xcd_barrier_post(unsigned* bar, volatile LAS unsigned* st) {
    XcdBarrier b; b.bar = bar; b.x = xb_xcc_id(); b.st = st;
    if (threadIdx.x == 0) (void)xb_add(&bar[XB_XCNT(b.x)], 1u);
    return b;
}
__device__ __forceinline__ void xcd_barrier_complete(unsigned* bar, unsigned x, unsigned& nloc, unsigned& nx) {
    const unsigned G = gridDim.x * gridDim.y * gridDim.z;
    unsigned sum, cnt, mine, sp = 0u;
    for (;;) {
        sum = 0u; cnt = 0u; mine = 0u;
#pragma unroll
        for (unsigned j = 0; j < 16; ++j) { const unsigned c = xb_ld(&bar[XB_XCNT(j)]); sum += c; cnt += (c > 0u) ? 1u : 0u; mine = (j == x) ? c : mine; }
        if (sum == G) break;
        __builtin_amdgcn_s_sleep(1);
        if ((++sp & 255u) == 0u) { if (xb_ld(&bar[XB_TMO])) break; if (sp > XB_SPIN_CAP) { atomicAdd(&bar[XB_TMO], 1u); break; } }
    }
    nloc = mine > 0u ? mine : 1u; nx = cnt > 0u ? cnt : 1u;
}

__device__ __forceinline__ void xcd_barrier(const XcdBarrier& b) {
    asm volatile("s_waitcnt vmcnt(0)" ::: "memory");
    __syncthreads();
    if (threadIdx.x == 0) {
        unsigned* bar = b.bar;
        __builtin_amdgcn_s_waitcnt(0);
        unsigned nloc = b.st[0], nx = b.st[1];
        if (nloc == 0u) { xcd_barrier_complete(bar, b.x, nloc, nx); b.st[0] = nloc; b.st[1] = nx; }
        const unsigned old = xb_add(&bar[XB_XSUB(b.x)], 1u);
        const unsigned gen = old / nloc;
        if (old + 1u == (gen + 1u) * nloc) {
            __builtin_amdgcn_fence(__ATOMIC_RELEASE, "agent");
            asm volatile("s_waitcnt vmcnt(0)" ::: "memory");
            const unsigned og = xb_add(&bar[XB_TOP], 1u);
            const unsigned tg = og / nx;
            if (og + 1u == (tg + 1u) * nx) xb_add(&bar[XB_TOPGEN], 1u);
            else XB_SPIN(xb_ld(&bar[XB_TOPGEN]) == tg, bar);
            __builtin_amdgcn_fence(__ATOMIC_ACQUIRE, "agent");
            xb_add(&bar[XB_XGEN(b.x)], 1u);
            asm volatile("s_waitcnt vmcnt(0)" ::: "memory");
        } else {
            XB_SPIN(xb_ld(&bar[XB_XGEN(b.x)]) == gen, bar);
            __builtin_amdgcn_fence(__ATOMIC_ACQUIRE, "agent");
            asm volatile("s_waitcnt vmcnt(0)" ::: "memory");
        }
    }
    __syncthreads();
}

struct Args { const float* in[17]; float* out; unsigned char* ws; int ph_lo, ph_hi; };

__global__ void __launch_bounds__(NWAVES * 64, 2) hybrid_fwd(Args args) {
    extern __shared__ __attribute__((aligned(16))) unsigned char lds_raw[];
    LAS unsigned char* lds = (LAS unsigned char*)lds_raw;
    cg::grid_group grid = cg::this_grid();
    const int tid = threadIdx.x, lane = tid & 63; const int wave = __builtin_amdgcn_readfirstlane(tid >> 6);
    const int G = gridDim.x; const int bx = blockIdx.x; const int vcu = (G % 8 == 0) ? (bx % 8) * (G / 8) + bx / 8 : bx;
    unsigned char* ws = args.ws;
    bf16_t* WinT = (bf16_t*)(ws + WS_WIN); bf16_t* WuaT = (bf16_t*)(ws + WS_WUA); bf16_t* WubT = (bf16_t*)(ws + WS_WUB); bf16_t* WoT = (bf16_t*)(ws + WS_WO);
    bf16_t* XN = (bf16_t*)(ws + WS_XN);
    bf16_t* YA = (bf16_t*)args.out; bf16_t* YB = YA + (size_t)MTOK * AW;
    bf16_t* Pb = (bf16_t*)(ws + WS_P); float* T = (float*)(ws + WS_T); bf16_t* MIX = (bf16_t*)(ws + WS_MIX); bf16_t* Gt = (bf16_t*)(ws + WS_G);
    const int lo = args.ph_lo, hi = args.ph_hi;
    volatile LAS unsigned* bst = (volatile LAS unsigned*)(lds + 131072 + 352);
    if (tid < 2) bst[tid] = 0u;
    __syncthreads();
    XcdBarrier bar = xcd_barrier_post((unsigned*)ws + 4096, bst);
    if (hi > 1000) grid.sync();
#define IN(k) (lo <= (k) && (k) < hi)
#define SEAM(k) do { if (IN(k) && IN((k) + 1)) xcd_barrier(bar); } while (0)

    if (IN(0)) {
        LAS float* scr = (LAS float*)(lds + wave * 16384);
        const int gw = vcu * NWAVES + wave, NGW = G * NWAVES;
        constexpr int I_IN = (DM / 64) * (NIN / 32), I_UP = (AW / 64) * (DM / 32), I_O = (DM / 64) * (DM / 32);
        constexpr int NITEMS = I_IN + 2 * I_UP + I_O;
        for (int it = gw; it < NITEMS; it += NGW) {
            int r = it;
            if (r < I_IN) { p0_transpose_item<true>(args.in[3], DM, NIN, WinT, scr, r, lane); continue; } r -= I_IN;
            if (r < I_UP) { p0_transpose_item<false>(args.in[14], AW, DM, WuaT, scr, r, lane); continue; } r -= I_UP;
            if (r < I_UP) { p0_transpose_item<false>(args.in[15], BW, DM, WubT, scr, r, lane); continue; } r -= I_UP;
            p0_transpose_item<false>(args.in[16], DM, DM, WoT, scr, r, lane);
        }
        for (int m = gw; m < M1; m += 2 * NGW) {
            const int m2 = m + NGW; const bool has2 = (m2 < M1);
            const float* s0 = (m < MTOK) ? args.in[0] + (size_t)m * DM : ((m < MTOK + 16) ? args.in[1] + (size_t)(m - MTOK) * DM : nullptr);
            const float* s1 = !has2 ? nullptr : (m2 < MTOK) ? args.in[0] + (size_t)m2 * DM : ((m2 < MTOK + 16) ? args.in[1] + (size_t)(m2 - MTOK) * DM : nullptr);
            rms_rows2_to_bf16(s0, s1, args.in[2], XN + (size_t)m * DM, has2 ? XN + (size_t)m2 * DM : nullptr, lane);
        }
    }
    SEAM(0);
    const int p1_full = pg8::InOrder::NUNITS / G;
    const bool p1_split = (p1_full * G >= pg8::InOrder::NNG + pg8::InOrder::NMETA) && (pg8::InOrder::NUNITS % G != 0);
    if (IN(1)) {
        pg8::Gemm g{XN, WinT, M1, NIN, DM}; pg8::InOrder S{G, bx, 0, p1_split ? p1_full * G : pg8::InOrder::NUNITS};
        EpiIn E{Pb, Gt, args.in[4], args.in[5], args.in[7], args.in[8]};
        pg8::gemm_phase<EpiIn, pg8::InOrder, PG8_ALIGN, PG8_SP2>(lds, g, S, E);
    }
    SEAM(1);
    if (IN(2) && p1_split) {
        pg8::Gemm g{XN, WinT, M1, NIN, DM}; pg8::InOrder S{G, bx, p1_full, pg8::InOrder::NUNITS};
        EpiIn E{Pb, Gt, args.in[4], args.in[5], args.in[7], args.in[8]};
        pg8::gemm_phase<EpiIn, pg8::InOrder, PG8_ALIGN, PG8_SP2>(lds, g, S, E);
    }
    if (IN(2)) {
#define SCAL(x) __builtin_bit_cast(float, __builtin_amdgcn_readfirstlane(__builtin_bit_cast(int, (x))))
        const float knB = wave_max(fabsf(args.in[8][lane])), qnB = wave_max(fabsf(args.in[7][lane]));
        const float kmaxB = SCAL(8.0f * 1.02f * knB);
        const float kmaxA = SCAL(8.0f * 1.02f * wave_max(fabsf(args.in[5][lane])));
        const float lam = SCAL(__expf(wave_sum(args.in[9][lane] * args.in[10][lane])) - __expf(wave_sum(args.in[11][lane] * args.in[12][lane])) + LAM_INIT);
        const float mmaxB = SCAL(qnB * LOG2E * 1.02f * kmaxB);
        LAS int* incl = (LAS int*)(lds + TAB_OFF); LAS int* sincl = incl + 512; LAS int* order = sincl + 512; LAS int* keys = order + 512; LAS int* misc = keys + 512;
        int C = 1 << 20, myn, mync;
        { int ub, uh, uqb; unit_decode(tid, ub, uh, uqb); myn = 2 * uqb + 2 - b_tmin(uqb, b_window(uh, mmaxB)); }
        {
#pragma unroll 1
            for (int ci = 0; ci < 7; ++ci) {
                const int cd = ci < 4 ? 44 + 4 * ci : (ci == 4 ? 64 : (ci == 5 ? 88 : 176));
                const int nc_ = (myn + cd - 1) / cd;
                int v = nc_ > 1 ? nc_ : 0;
#pragma unroll
                for (int o_ = 1; o_ < 64; o_ <<= 1) v += __shfl_xor(v, o_);
                if (lane == 0) misc[8 + wave] = v;
                __syncthreads();
                int tot = 0;
#pragma unroll
                for (int k = 0; k < 8; ++k) tot += misc[8 + k];
                __syncthreads();
                if (tot <= SLOT_MAX) { C = cd; break; }
            }
        }
        {
            mync = (myn + C - 1) / C;
            const int myper = (myn + mync - 1) / mync, mykey = myper * 512 + (511 - tid);
            keys[tid] = mykey;
            __syncthreads();
            int rank = 0;
            for (int k = 0; k < 128; ++k) { const u32x4 kv = ((const LAS u32x4*)keys)[k]; rank += ((int)kv.x > mykey ? 1 : 0) + ((int)kv.y > mykey ? 1 : 0) + ((int)kv.z > mykey ? 1 : 0) + ((int)kv.w > mykey ? 1 : 0); }
            order[rank] = tid; incl[rank] = mync; sincl[rank] = mync > 1 ? mync : 0;
            __syncthreads();
            for (int d = 1; d < 512; d <<= 1) { const int a = tid >= d ? incl[tid - d] : 0, c = tid >= d ? sincl[tid - d] : 0; __syncthreads(); incl[tid] += a; sincl[tid] += c; __syncthreads(); }
        }
        const int NI = incl[511];
        unsigned* qctr = (unsigned*)ws + CW_QUEUE;
        for (;;) {
            if (tid == 0) misc[0] = (int)__hip_atomic_fetch_add(qctr, 1u, __ATOMIC_RELAXED, __HIP_MEMORY_SCOPE_AGENT);
            __syncthreads();
            const int it = misc[0];
            __syncthreads();
            if (it >= NI + 256) break;
            if (it < NI) {
                int lo_ = 0, hi_ = 511;
                while (lo_ < hi_) { const int mid = (lo_ + hi_) >> 1; if (incl[mid] > it) hi_ = mid; else lo_ = mid + 1; }
                const int p = lo_, jn = incl[p] - (p ? incl[p - 1] : 0), c = it - (incl[p] - jn);
                int ub, uh, uqb; unit_decode(order[p], ub, uh, uqb);
                const int tmin = b_tmin(uqb, b_window(uh, mmaxB)), n = 2 * uqb + 2 - tmin, per = (n + jn - 1) / jn;
                const int t0 = tmin + c * per, t1 = min(t0 + per - 1, 2 * uqb + 1);
                f32x16 o[4]; float lsum;
                attn_b_core(Pb, kmaxB, ub, uh, uqb, t0, t1, lds, o, lsum);
                if (jn == 1) attn_b_finalize(Pb, YB, args.in[13], lam, ub, uh, uqb, lds, o, lsum);
                else b_store_partial(ws, sincl[p] - jn + c, o, lsum);
            } else {
                const int au = it - NI, bk = au >> 6;
                attn_a_unit(Pb, YA, args.in[6], kmaxA, bk >> 1, bk & 1, 1 + (au & 63), lds);
            }
        }
        if (sincl[511] > 0) {
            xcd_barrier(bar);
            for (int p = bx; p < 512; p += G) {
                const int jn = incl[p] - (p ? incl[p - 1] : 0);
                if (jn > 1) { int ub, uh, uqb; unit_decode(order[p], ub, uh, uqb);
                    f32x16 o[4]; float lsum;
                    b_load_partials(ws, sincl[p] - jn, jn, o, lsum);
                    attn_b_finalize(Pb, YB, args.in[13], lam, ub, uh, uqb, lds, o, lsum); }
            }
        }
    }
    SEAM(2);
    if (IN(3)) {
        pg8::Gemm g{YA, WuaT, MTOK, DM, AW, YB, WubT}; pg8::StaticOrder2 S; S.init(MTOK, DM, G, bx); EpiUp E{Gt, MIX};
        pg8::gemm_phase<EpiUp, pg8::StaticOrder2, PG8_ALIGN, PG8_SP2>(lds, g, S, E);
    }
    SEAM(3);
    if (IN(4)) {
        pg8::Gemm g{MIX, WoT, MTOK, DM, DM}; pg8::StaticOrder S; S.init(MTOK, DM, G, bx); EpiOut E{args.in[0], args.out};
        pg8::gemm_phase<EpiOut, pg8::StaticOrder, PG8_ALIGN, PG8_SP2>(lds, g, S, E);
    }
#undef IN
#undef SEAM
}

extern "C" void kernel_launch(void* const* d_in, const int* in_sizes, int n_in, void* d_out, int out_size, void* d_ws, size_t ws_size, hipStream_t stream) {
    static int grid = 0;
    if (grid == 0) {
        if (n_in != 17 || ws_size < WS_END) { fprintf(stderr, "kernel_launch: unexpected inputs (n_in %d, ws %zu)\n", n_in, ws_size); grid = -1; return; }
        int dev = 0, cus = 0, per_cu = 0;
        hipGetDevice(&dev); hipDeviceGetAttribute(&cus, hipDeviceAttributeMultiprocessorCount, dev);
        if (hipFuncSetAttribute((const void*)hybrid_fwd, hipFuncAttributeMaxDynamicSharedMemorySize, LDS_BYTES) != hipSuccess) { fprintf(stderr, "kernel_launch: hipFuncSetAttribute failed\n"); grid = -1; return; }
        if (hipOccupancyMaxActiveBlocksPerMultiprocessor(&per_cu, (const void*)hybrid_fwd, NWAVES * 64, LDS_BYTES) != hipSuccess || per_cu < 1) { fprintf(stderr, "kernel_launch: occupancy query says %d\n", per_cu); per_cu = 1; }
        (void)hipGetLastError();
        grid = cus * 1;
        if (grid <= 0) grid = 256;
    }
    if (grid < 0) return;
    if (hipMemsetAsync(d_ws, 0, 65536, stream) != hipSuccess) { fprintf(stderr, "kernel_launch: memset failed\n"); return; }
    Args a{};
    for (int i = 0; i < 17; ++i) a.in[i] = (const float*)d_in[i];
    a.out = (float*)d_out; a.ws = (unsigned char*)d_ws;
#if MK_SPLIT
    for (int p = 0; p < 5; ++p) { a.ph_lo = p; a.ph_hi = p + 1; void* kargs[] = {&a};
        hipError_t e = hipLaunchCooperativeKernel((const void*)hybrid_fwd, dim3(grid), dim3(NWAVES * 64), kargs, LDS_BYTES, stream);
        if (e != hipSuccess) fprintf(stderr, "kernel_launch: launch %d failed: %s\n", p, hipGetErrorString(e)); }
#else
    a.ph_lo = 0; a.ph_hi = 5; void* kargs[] = {&a};
    hipError_t e = hipLaunchCooperativeKernel((const void*)hybrid_fwd, dim3(grid), dim3(NWAVES * 64), kargs, LDS_BYTES, stream);
    if (e != hipSuccess) fprintf(stderr, "kernel_launch: cooperative launch failed: %s (grid %d)\n", hipGetErrorString(e), grid);
#endif
}
```

```cpp
#include <hip/hip_cooperative_groups.h>
#include <hip/hip_runtime.h>
#include <cstdio>
#include <cstdint>
namespace pg8 {
#define PG8_LAS __attribute__((address_space(3)))
typedef unsigned short bf16_t;
typedef short bf16x8 __attribute__((ext_vector_type(8)));
typedef float f32x4 __attribute__((ext_vector_type(4)));
typedef unsigned u32x4 __attribute__((ext_vector_type(4)));
constexpr int BM = 256, BK = 64, HALF = 128, HTB = HALF * BK * 2  , STAGE_BYTES = 8 * HTB, NXCD = 8, WGM = 8;

__host__ __device__ __forceinline__ int lds_byte(int r, int c) { const int st = (r >> 4) * 2 + (c >> 5), rr = r & 15, cc = c & 31, ob = rr * 64 + cc * 2; return st * 1024 + (ob ^ (((ob >> 9) & 1) << 5)); }
__host__ __device__ __forceinline__ void stage_rc(int b, int& R, int& C) { const int st = b / 1024, sb = b % 1024, swz = sb ^ (((sb >> 9) & 1) << 5); R = (st >> 1) * 16 + swz / 64; C = (st & 1) * 32 + (swz % 64) / 2; }
__host__ __device__ __forceinline__ int perm32(int rho) { const int n = rho >> 4, i = rho & 15; return 8 * (i >> 2) + 4 * n + (i & 3); }

struct Unit { int pm, pn, seg; };
struct Gemm { const bf16_t* A; const bf16_t* Bt; int M, N, K; const bf16_t* A2; const bf16_t* Bt2; };

struct StaticOrder {
    int nM, nN, nwg, G, c;
    __host__ __device__ void init(int M, int N, int G_, int c_) { nM = M / BM; nN = N / BM; nwg = nM * nN; G = G_; c = c_; }
    __host__ __device__ bool next(int i, Unit& u) const {
        const long L = (long)i * G + c; if (L >= nwg) return false;
        int wgid = (int)L; { const int q = nwg / NXCD, r = nwg % NXCD, xcd = wgid % NXCD, off = wgid / NXCD; wgid = (xcd < r ? xcd * (q + 1) : r * (q + 1) + (xcd - r) * q) + off; }
        const int nig = WGM * nN, gid = wgid / nig, fm = gid * WGM, gsz = (nM - fm) < WGM ? (nM - fm) : WGM;
        u.pm = fm + ((wgid % nig) % gsz); u.pn = (wgid % nig) / gsz; u.seg = 0; return true;
    }
    __device__ __forceinline__ void a_ready(const Unit&) const {}
    __device__ __forceinline__ void done(const Unit&) const {}
};

struct InOrder { int G, c, i0, lim;
    static constexpr int NNG = 832, NMETA = 13, NGATE = 512, NUNITS = NNG + NMETA + NGATE;
    __host__ __device__ bool next(int i, Unit& u) const {
        const int L = (i + i0) * G + c; if (L >= lim) return false;
        u.seg = 0;
        if (L < NNG) { const int x = L & 7, k = L >> 3; u.pn = k >> 3; u.pm = x + 8 * (k & 7); }
        else if (L < NNG + NMETA) { u.pm = 64; u.pn = L - NNG; }
        else { const int L2 = L - (NNG + NMETA) + 5; const int x = L2 & 7; int k = L2 >> 3; if (k == 64) k = 0; u.pn = 13 + (k >> 3); u.pm = x + 8 * (k & 7); }
        return true;
    }
    __device__ __forceinline__ void a_ready(const Unit&) const {}
    __device__ __forceinline__ void done(const Unit&) const {}
};
struct StaticOrder2 { StaticOrder base;
    __host__ __device__ void init(int M, int N, int G_, int c_) { base.init(M, N, G_, c_); }
    __host__ __device__ bool next(int i, Unit& u) const { if (!base.next(i >> 1, u)) return false; u.seg = i & 1; return true; }
    __device__ __forceinline__ void a_ready(const Unit&) const {}
    __device__ __forceinline__ void done(const Unit&) const {}
};
__device__ __forceinline__ unsigned cvt_pk_bf16(float lo, float hi) { unsigned r; asm volatile("v_cvt_pk_bf16_f32 %0, %1, %2" : "=v"(r) : "v"(lo), "v"(hi)); return r; }
typedef float f32x2 __attribute__((ext_vector_type(2)));
__device__ __forceinline__ f32x2 gelu_pk(f32x2 v) {
    const f32x2 av = __builtin_elementwise_abs(v), d = av * 0.2316418882f + 1.0f;
    f32x2 t; t.x = __builtin_amdgcn_rcpf(d.x); t.y = __builtin_amdgcn_rcpf(d.y);
    f32x2 q = t * 0.5307027145f + (-0.7265760135f); q = q * t + 0.7107068705f; q = q * t + (-0.142248368f); q = q * t + 0.127414796f; q = q * t;
    const f32x2 s = (v * v) * (-0.72134752044f);
    f32x2 e; e.x = __builtin_amdgcn_exp2f(s.x); e.y = __builtin_amdgcn_exp2f(s.y);
    const f32x2 m = v * (q * e), r = v - m;
    f32x2 o; o.x = v.x < 0.f ? m.x : r.x; o.y = v.y < 0.f ? m.y : r.y; return o;
}

template <int ACT  > struct EpiBf16 {
    static constexpr bool PERM = true, AFTER_DRAIN = false, TWO_SEG = false, INIT_ACC = false; static_assert(ACT == 0 || ACT == 1, "EpiBf16: ACT is 0 (none) or 1 (gelu_pk)");
    bf16_t* O; int ldc; const float* bias; int split_cols; size_t split_stride; float scale0;
    __device__ __forceinline__ void operator()(const f32x4 (&acc)[2][2][4][2], const Unit& u, int wr, int wc, int fr, int fq) const {
        const int row0 = u.pm * BM + wr * 64 + fr; int colt = u.pn * BM; bf16_t* base = O;
        float sc = 1.f; if (split_cols) { const int t = colt / split_cols; base += (size_t)t * split_stride; colt -= t * split_cols; if (t == 0) sc = scale0; }
        const int col0 = colt + wc * 32 + 8 * fq, bcol0 = u.pn * BM + wc * 32 + 8 * fq;
        f32x4 bv[2][2];
#pragma unroll
        for (int bj = 0; bj < 2; ++bj)
#pragma unroll
            for (int n = 0; n < 2; ++n) bv[bj][n] = bias ? *(const f32x4*)(bias + bcol0 + bj * HALF + 4 * n) : (f32x4){0.f, 0.f, 0.f, 0.f};
#pragma unroll
        for (int ai = 0; ai < 2; ++ai)
#pragma unroll
            for (int m = 0; m < 4; ++m) { bf16_t* rowp = base + (size_t)(row0 + ai * HALF + m * 16) * ldc + col0;
#pragma unroll
                for (int bj = 0; bj < 2; ++bj) { f32x4 v0 = acc[ai][bj][m][0] + bv[bj][0], v1 = acc[ai][bj][m][1] + bv[bj][1];
                    if (ACT == 1) { f32x2 a = gelu_pk((f32x2){v0[0], v0[1]}), b = gelu_pk((f32x2){v0[2], v0[3]}), c = gelu_pk((f32x2){v1[0], v1[1]}), d = gelu_pk((f32x2){v1[2], v1[3]});
                        v0 = (f32x4){a.x, a.y, b.x, b.y}; v1 = (f32x4){c.x, c.y, d.x, d.y}; }
                    v0 = v0 * sc; v1 = v1 * sc; u32x4 w; w.x = cvt_pk_bf16(v0[0], v0[1]); w.y = cvt_pk_bf16(v0[2], v0[3]); w.z = cvt_pk_bf16(v1[0], v1[1]); w.w = cvt_pk_bf16(v1[2], v1[3]);
                    *(u32x4*)(rowp + bj * HALF) = w; } }
    }
};

template <class Epi, class Sched, bool ALIGN_EPI = false, bool SP2 = false>
__device__ __forceinline__ void gemm_phase(PG8_LAS unsigned char* lds, const Gemm g, const Sched& S, const Epi& E) {
    const int tid = threadIdx.x, wid = __builtin_amdgcn_readfirstlane(tid >> 6), lane = tid & 63, wr = wid >> 2, wc = wid & 3, fr = lane & 15, fq = lane >> 4;
    const int K = g.K, nt = K / BK;
    unsigned voffA[2], voffB[2];
#pragma unroll
    for (int i = 0; i < 2; ++i) { int R, C; stage_rc(tid * 16 + i * 8192, R, C); const int Rb = Epi::PERM ? ((R & ~31) + perm32(R & 31)) : R;
        voffA[i] = (unsigned)(R * K + C) * 2u; voffB[i] = (unsigned)(Rb * K + C) * 2u; }
    const size_t kstep = (size_t)(BK * 2);
    const size_t hstep = (size_t)HALF * K * 2;
    const size_t tstep = 2 * hstep;
    const unsigned ldsw = (unsigned)wid * 1024u;
    const int aoff = lds_byte(wr * 64 + fr, fq * 8), boff = lds_byte(wc * 32 + fr, fq * 8);
#define PG8_SA(b, h) (((b) * 2 + (h)) * HTB)
#define PG8_SB(b, h) ((4 + (b) * 2 + (h)) * HTB)
#define PG8_STAGE(bufoff, gbase, voff) do { _Pragma("unroll") for (int _i = 0; _i < 2; ++_i) \
        __builtin_amdgcn_global_load_lds((const unsigned*)((const char*)(gbase) + (voff)[_i]), (PG8_LAS unsigned*)(lds + (bufoff) + ldsw + _i * 8192), 16, 0, 0); } while (0)
#define PG8_LDA(dst, b, h) do { _Pragma("unroll") for (int m = 0; m < 4; ++m) _Pragma("unroll") for (int k = 0; k < 2; ++k) dst[m][k] = *(const PG8_LAS bf16x8*)(lds + PG8_SA(b, h) + aoff + m * 2048 + k * 1024); } while (0)
#define PG8_LDB(dst, b, h) do { _Pragma("unroll") for (int n = 0; n < 2; ++n) _Pragma("unroll") for (int k = 0; k < 2; ++k) dst[n][k] = *(const PG8_LAS bf16x8*)(lds + PG8_SB(b, h) + boff + n * 2048 + k * 1024); } while (0)
#define PG8_MMA(ai, bj, At, Bt) do { __builtin_amdgcn_s_setprio(1); _Pragma("unroll") for (int m = 0; m < 4; ++m) _Pragma("unroll") for (int n = 0; n < 2; ++n) _Pragma("unroll") for (int k = 0; k < 2; ++k) \
        acc[ai][bj][m][n] = __builtin_amdgcn_mfma_f32_16x16x32_bf16(Bt[n][k], At[m][k], acc[ai][bj][m][n], 0, 0, 0); __builtin_amdgcn_s_setprio(0); } while (0)
#define PG8_WAIT_V(n) asm volatile("s_waitcnt vmcnt(" #n ")" ::: "memory")
#define PG8_WAIT_L(n) asm volatile("s_waitcnt lgkmcnt(" #n ")" ::: "memory")
#define PG8_BAR __builtin_amdgcn_s_barrier()
#define PG8_SCHED __builtin_amdgcn_sched_barrier(0)
    Unit cur, nxt; int ui = 0;
    if (!S.next(0, cur)) return;
    f32x4 acc[2][2][4][2];
    if constexpr (Epi::INIT_ACC) E.init(acc, cur, wr, wc, fr, fq);
    else
#pragma unroll
    for (int a = 0; a < 2; ++a)
#pragma unroll
        for (int b = 0; b < 2; ++b)
#pragma unroll
            for (int m = 0; m < 4; ++m)
#pragma unroll
                for (int n = 0; n < 2; ++n) acc[a][b][m][n] = (f32x4){0.f, 0.f, 0.f, 0.f};
    bf16x8 At[4][2], B0[2][2], B1[2][2];
    const char* cA = (const char*)(cur.seg ? g.A2 : g.A) + (size_t)cur.pm * tstep; const char* cB = (const char*)(cur.seg ? g.Bt2 : g.Bt) + (size_t)cur.pn * tstep;
    S.a_ready(cur);
    if constexpr (SP2) {
        PG8_STAGE(PG8_SB(0, 0), cB, voffB); PG8_STAGE(PG8_SB(0, 1), cB + hstep, voffB); PG8_STAGE(PG8_SA(0, 0), cA, voffA); PG8_STAGE(PG8_SA(0, 1), cA + hstep, voffA);
        if (wr == 1) PG8_BAR;
        PG8_WAIT_V(2); PG8_BAR;
        PG8_STAGE(PG8_SB(1, 0), cB + kstep, voffB); PG8_STAGE(PG8_SA(1, 0), cA + kstep, voffA); PG8_STAGE(PG8_SB(1, 1), cB + hstep + kstep, voffB);
        PG8_WAIT_V(6); PG8_BAR;
    } else {
        PG8_STAGE(PG8_SB(0, 0), cB, voffB); PG8_STAGE(PG8_SA(0, 0), cA, voffA); PG8_STAGE(PG8_SB(0, 1), cB + hstep, voffB); PG8_STAGE(PG8_SA(0, 1), cA + hstep, voffA);
        if (wr == 1) PG8_BAR;
        PG8_WAIT_V(4); PG8_BAR;
        PG8_STAGE(PG8_SB(1, 0), cB + kstep, voffB); PG8_STAGE(PG8_SA(1, 0), cA + kstep, voffA); PG8_STAGE(PG8_SB(1, 1), cB + hstep + kstep, voffB);
        PG8_WAIT_V(6); PG8_BAR;
    }
    for (;;) {
        const bool has_next = S.next(ui + 1, nxt);
        const char* nA = has_next ? (const char*)(nxt.seg ? g.A2 : g.A) + (size_t)nxt.pm * tstep : cA; const char* nB = has_next ? (const char*)(nxt.seg ? g.Bt2 : g.Bt) + (size_t)nxt.pn * tstep : cB;
        for (int t = 0; t < nt; t += 2) {
            const bool last = (t == nt - 2);
            const char* a1 = cA + (size_t)(t + 1) * kstep;
            const char* a2 = last ? nA : cA + (size_t)(t + 2) * kstep; const char* b2 = last ? nB : cB + (size_t)(t + 2) * kstep;
            const char* a3 = a2 + kstep; const char* b3 = b2 + kstep;
            if (last && has_next) S.a_ready(nxt);
            if constexpr (SP2) {
            PG8_LDB(B0, 0, 0); PG8_LDB(B1, 0, 1); PG8_SCHED; PG8_LDA(At, 0, 0); PG8_STAGE(PG8_SA(1, 1), a1 + hstep, voffA);
            PG8_WAIT_V(8); PG8_WAIT_L(0); PG8_BAR; PG8_MMA(0, 0, At, B0); PG8_MMA(0, 1, At, B1); PG8_BAR; PG8_SCHED;
            PG8_LDA(At, 0, 1); PG8_STAGE(PG8_SB(0, 0), b2, voffB); PG8_STAGE(PG8_SB(0, 1), b2 + hstep, voffB); PG8_STAGE(PG8_SA(0, 0), a2, voffA);
            PG8_WAIT_V(8); PG8_WAIT_L(0); PG8_BAR; PG8_MMA(1, 0, At, B0); PG8_MMA(1, 1, At, B1); PG8_BAR; PG8_SCHED;
            PG8_LDB(B0, 1, 0); PG8_LDB(B1, 1, 1); PG8_SCHED; PG8_LDA(At, 1, 0); PG8_STAGE(PG8_SA(0, 1), a2 + hstep, voffA);
            PG8_WAIT_V(8); PG8_WAIT_L(0); PG8_BAR; PG8_MMA(0, 0, At, B0); PG8_MMA(0, 1, At, B1); PG8_BAR; PG8_SCHED;
            PG8_LDA(At, 1, 1); PG8_STAGE(PG8_SB(1, 0), b3, voffB); PG8_STAGE(PG8_SB(1, 1), b3 + hstep, voffB); PG8_STAGE(PG8_SA(1, 0), a3, voffA);
            PG8_WAIT_V(8); PG8_WAIT_L(0); PG8_BAR; PG8_MMA(1, 0, At, B0); PG8_MMA(1, 1, At, B1); PG8_BAR; PG8_SCHED;
            } else {
            PG8_LDB(B0, 0, 0); PG8_SCHED; PG8_LDA(At, 0, 0); PG8_STAGE(PG8_SA(1, 1), a1 + hstep, voffA);
            PG8_WAIT_L(8); PG8_BAR; PG8_WAIT_L(0); PG8_MMA(0, 0, At, B0); PG8_BAR; PG8_SCHED;
            PG8_LDB(B1, 0, 1); PG8_STAGE(PG8_SB(0, 0), b2, voffB);
            PG8_BAR; PG8_WAIT_L(0); PG8_MMA(0, 1, At, B1); PG8_BAR;
            PG8_LDA(At, 0, 1); PG8_STAGE(PG8_SA(0, 0), a2, voffA);
            PG8_BAR; PG8_WAIT_L(0); PG8_MMA(1, 0, At, B0); PG8_BAR; PG8_SCHED;
            PG8_STAGE(PG8_SB(0, 1), b2 + hstep, voffB);
            PG8_WAIT_V(6); PG8_BAR; PG8_MMA(1, 1, At, B1); PG8_BAR;
            PG8_LDB(B0, 1, 0); PG8_SCHED; PG8_LDA(At, 1, 0); PG8_STAGE(PG8_SA(0, 1), a2 + hstep, voffA);
            PG8_WAIT_L(8); PG8_BAR; PG8_WAIT_L(0); PG8_MMA(0, 0, At, B0); PG8_BAR; PG8_SCHED;
            PG8_LDB(B1, 1, 1); PG8_STAGE(PG8_SB(1, 0), b3, voffB);
            PG8_BAR; PG8_WAIT_L(0); PG8_MMA(0, 1, At, B1); PG8_BAR;
            PG8_LDA(At, 1, 1); PG8_STAGE(PG8_SA(1, 0), a3, voffA);
            PG8_BAR; PG8_WAIT_L(0); PG8_MMA(1, 0, At, B0); PG8_BAR; PG8_SCHED;
            PG8_STAGE(PG8_SB(1, 1), b3 + hstep, voffB);
            PG8_WAIT_V(6); PG8_BAR; PG8_MMA(1, 1, At, B1); PG8_BAR;
            }
        }
        if constexpr (ALIGN_EPI) { if (wr == 0) PG8_BAR; }
        bool keep = false;
        if constexpr (Epi::TWO_SEG) { if (cur.seg == 0) { E.mid(acc, cur, wr, wc, fr, fq); keep = true; } }
        if (!keep) if constexpr (!Epi::AFTER_DRAIN) { E(acc, cur, wr, wc, fr, fq); S.done(cur); }
        if (!has_next) break;
        if constexpr (Epi::INIT_ACC) { if (!keep) E.init(acc, nxt, wr, wc, fr, fq); }
        else if (!keep)
#pragma unroll
        for (int a = 0; a < 2; ++a)
#pragma unroll
            for (int b = 0; b < 2; ++b)
#pragma unroll
                for (int m = 0; m < 4; ++m)
#pragma unroll
                    for (int n = 0; n < 2; ++n) acc[a][b][m][n] = (f32x4){0.f, 0.f, 0.f, 0.f};
        cur = nxt; cA = nA; cB = nB; ++ui;
        if constexpr (ALIGN_EPI) { if (wr == 1) PG8_BAR; }
    }
    PG8_WAIT_V(0);
    if constexpr (!ALIGN_EPI) { if (wr == 0) PG8_BAR; }
    PG8_BAR;
    if constexpr (Epi::AFTER_DRAIN) { E.fused(acc, cur, wr, wc, fr, fq, lds, wid, lane); S.done(cur); }
#undef PG8_SA
#undef PG8_SB
#undef PG8_STAGE
#undef PG8_LDA
#undef PG8_LDB
#undef PG8_MMA
#undef PG8_WAIT_V
#undef PG8_WAIT_L
#undef PG8_BAR
#undef PG8_SCHED
}
}

#ifndef PG8_SP2
#define PG8_SP2 true
#endif
#ifndef PG8_ALIGN
#define PG8_ALIGN true
#endif

namespace cg = cooperative_groups;
#define LAS __attribute__((address_space(3)))
typedef unsigned short bf16_t;
typedef short bf16x8 __attribute__((ext_vector_type(8)));
typedef short s16x4 __attribute__((ext_vector_type(4)));
typedef float f32x4 __attribute__((ext_vector_type(4)));
typedef float f32x16 __attribute__((ext_vector_type(16)));
typedef unsigned u32x4 __attribute__((ext_vector_type(4)));
typedef unsigned u32x2 __attribute__((ext_vector_type(2)));
typedef float f32x2_t __attribute__((ext_vector_type(2)));
typedef __bf16 bf16x2_t __attribute__((ext_vector_type(2)));

#ifndef MK_SPLIT
#define MK_SPLIT 0
#endif

constexpr int NWAVES = 8;
constexpr int DM = 1024, SEQ = 8192, NBATCH = 2, LP = 8320, MTOK = 16384, M1 = 16640, NIN = 5376, PP = 3328, GW = 2048;
constexpr int AW = 512, BW = 512;
constexpr float RMS_EPS = 1e-6f, LOG2E = 1.4426950408889634f;
constexpr float QSCALE = 0.125f * LOG2E;
constexpr float LAM_INIT = 0.2f;

constexpr size_t MiB = 1u << 20;
constexpr size_t WS_WIN = 1 * MiB, WS_WUA = 12 * MiB, WS_WUB = 13 * MiB, WS_WO = 14 * MiB;
constexpr size_t WS_XN = 16 * MiB, WS_YA = 16 * MiB, WS_YB = 32 * MiB;
constexpr size_t WS_P = 49 * MiB, WS_T = 49 * MiB, WS_MIX = 113 * MiB;
constexpr size_t WS_G = 155 * MiB, WS_END = 219 * MiB;
static_assert(WS_XN + (size_t)M1 * DM * 2 <= WS_P && WS_P + (size_t)M1 * PP * 2 <= WS_G && WS_MIX + (size_t)MTOK * DM * 2 <= WS_G, "ws map");

constexpr int LDS_BYTES = 147456;

__device__ __forceinline__ unsigned f2bf(float f) { unsigned u = __builtin_bit_cast(unsigned, f); return (u + 0x7fffu + ((u >> 16) & 1u)) >> 16; }
__device__ __forceinline__ unsigned pk2(float lo, float hi) { f32x2_t v = {lo, hi}; bf16x2_t b = __builtin_convertvector(v, bf16x2_t); return __builtin_bit_cast(unsigned, b); }
__device__ __forceinline__ float bf2f(unsigned short u) { return __builtin_bit_cast(float, (unsigned)u << 16); }
__device__ __forceinline__ float bflo(unsigned u) { return __builtin_bit_cast(float, u << 16); }
__device__ __forceinline__ float bfhi(unsigned u) { return __builtin_bit_cast(float, u & 0xffff0000u); }
__device__ __forceinline__ float wave_sum(float v) {
#pragma unroll
    for (int o = 1; o < 64; o <<= 1) v += __shfl_xor(v, o);
    return v;
}
__device__ __forceinline__ float wave_max(float v) {
#pragma unroll
    for (int o = 1; o < 64; o <<= 1) v = fmaxf(v, __shfl_xor(v, o));
    return v;
}
__device__ __forceinline__ float fast_exp2(float x) { return __builtin_amdgcn_exp2f(x); }
__device__ __forceinline__ float sigmoidf_(float x) { return __builtin_amdgcn_rcpf(1.0f + fast_exp2(-x * LOG2E)); }

__device__ __forceinline__ int perm_in_col(int c) { const int pn = c >> 8, rem = c & 255, wc = rem >> 6, bj = (rem >> 5) & 1, j = rem & 31; return (pn << 8) + 128 * bj + 32 * wc + j; }

template <bool PERMCOL>
__device__ __forceinline__ void p0_transpose_item(const float* W, int K, int N, bf16_t* WT, LAS float* scr, int item, int lane) {
    const int nblk = N / 32, kb = item / nblk, nb = item % nblk, k0 = 64 * kb, n0 = 32 * nb;
    { f32x4 wv[8];
#pragma unroll
      for (int i = 0; i < 8; ++i) wv[i] = __builtin_nontemporal_load((const f32x4*)(W + (size_t)(k0 + 8 * i + (lane >> 3)) * N + n0 + 4 * (lane & 7)));
#pragma unroll
      for (int i = 0; i < 8; ++i) { LAS float* d = scr + (8 * i + (lane >> 3)) * 33 + 4 * (lane & 7); d[0] = wv[i].x; d[1] = wv[i].y; d[2] = wv[i].z; d[3] = wv[i].w; } }
    asm volatile("s_waitcnt lgkmcnt(0)" ::: "memory");
    const int c = lane & 7;
#pragma unroll
    for (int j = 0; j < 4; ++j) { const int n = (lane >> 3) + 8 * j; const LAS float* s = scr + (8 * c) * 33 + n;
        u32x4 o; o.x = pk2(s[0 * 33], s[1 * 33]); o.y = pk2(s[2 * 33], s[3 * 33]); o.z = pk2(s[4 * 33], s[5 * 33]); o.w = pk2(s[6 * 33], s[7 * 33]);
        const int drow = PERMCOL ? perm_in_col(n0 + n) : (n0 + n);
        *(u32x4*)(WT + (size_t)drow * K + k0 + 8 * c) = o; }
    asm volatile("s_waitcnt lgkmcnt(0)" ::: "memory");
}
__device__ __forceinline__ void rms_rows2_to_bf16(const float* x0, const float* x1, const float* g, bf16_t* o0, bf16_t* o1, int lane) {
    const f32x4 z4 = {0.f, 0.f, 0.f, 0.f};
    f32x4 v0[4], v1[4];
#pragma unroll
    for (int j = 0; j < 4; ++j) { v0[j] = x0 ? __builtin_nontemporal_load((const f32x4*)x0 + lane + 64 * j) : z4; v1[j] = x1 ? __builtin_nontemporal_load((const f32x4*)x1 + lane + 64 * j) : z4; }
    float s0 = 0.f, s1 = 0.f;
#pragma unroll
    for (int j = 0; j < 4; ++j) { s0 += (v0[j].x * v0[j].x + v0[j].y * v0[j].y) + (v0[j].z * v0[j].z + v0[j].w * v0[j].w); s1 += (v1[j].x * v1[j].x + v1[j].y * v1[j].y) + (v1[j].z * v1[j].z + v1[j].w * v1[j].w); }
#pragma unroll
    for (int o = 1; o < 64; o <<= 1) { s0 += __shfl_xor(s0, o); s1 += __shfl_xor(s1, o); }
    const float r0 = 1.0f / sqrtf(s0 * (1.f / DM) + RMS_EPS), r1 = 1.0f / sqrtf(s1 * (1.f / DM) + RMS_EPS);
    unsigned long long* p0 = (unsigned long long*)o0 + lane; unsigned long long* p1 = (unsigned long long*)o1 + lane;
#pragma unroll
    for (int j = 0; j < 4; ++j) { const f32x4 gg = ((const f32x4*)g)[lane + 64 * j]; const f32x4 y0 = v0[j] * r0 * gg, y1 = v1[j] * r1 * gg;
        p0[64 * j] = (unsigned long long)pk2(y0.x, y0.y) | ((unsigned long long)pk2(y0.z, y0.w) << 32);
        if (o1) p1[64 * j] = (unsigned long long)pk2(y1.x, y1.y) | ((unsigned long long)pk2(y1.z, y1.w) << 32); }
}

struct EpiIn {
    static constexpr bool PERM = true, AFTER_DRAIN = false, TWO_SEG = false, INIT_ACC = false;
    bf16_t* P; bf16_t* G; const float* aqn; const float* akn; const float* bqn; const float* bkn;
    __device__ __forceinline__ void operator()(const f32x4 (&acc)[2][2][4][2], const pg8::Unit& u, int wr, int wc, int fr, int fq) const {
        const int c64 = u.pn * 4 + wc;
        const float* gp = nullptr; float gscale = 1.f;
        if (c64 < 8) { gp = aqn; gscale = QSCALE; } else if (c64 < 10) gp = akn; else if (c64 >= 20 && c64 < 28) { gp = bqn; gscale = QSCALE; } else if (c64 >= 28 && c64 < 36) gp = bkn;
        const int mode = gp ? 1 : (((c64 >= 12 && c64 < 20) || (c64 >= 44 && c64 < 52)) ? 2 : (c64 >= 52 ? 3 : 0));
        f32x4 gv[2][2];
#pragma unroll
        for (int bj = 0; bj < 2; ++bj)
#pragma unroll
            for (int n = 0; n < 2; ++n) gv[bj][n] = gp ? *(const f32x4*)(gp + 32 * bj + 8 * fq + 4 * n) * gscale : (f32x4){1.f, 1.f, 1.f, 1.f};
        const bool meta = (u.pm >= 64);
#pragma unroll
        for (int ai = 0; ai < 2; ++ai)
#pragma unroll
            for (int m = 0; m < 4; ++m) {
                const int r = u.pm * 256 + ai * 128 + wr * 64 + m * 16 + fr;
                f32x4 v[2][2];
#pragma unroll
                for (int bj = 0; bj < 2; ++bj)
#pragma unroll
                    for (int n = 0; n < 2; ++n) v[bj][n] = acc[ai][bj][m][n];
                if (mode == 1) {
                    float ss = 0.f;
#pragma unroll
                    for (int bj = 0; bj < 2; ++bj)
#pragma unroll
                        for (int n = 0; n < 2; ++n) { const f32x4 x = v[bj][n]; ss += (x[0] * x[0] + x[1] * x[1]) + (x[2] * x[2] + x[3] * x[3]); }
                    ss += __shfl_xor(ss, 16); ss += __shfl_xor(ss, 32);
                    const float rs = 1.0f / sqrtf(ss * (1.f / 64.f) + RMS_EPS);
#pragma unroll
                    for (int bj = 0; bj < 2; ++bj)
#pragma unroll
                        for (int n = 0; n < 2; ++n) v[bj][n] = v[bj][n] * rs * gv[bj][n];
                } else if (mode == 2) {
#pragma unroll
                    for (int bj = 0; bj < 2; ++bj)
#pragma unroll
                        for (int n = 0; n < 2; ++n)
#pragma unroll
                            for (int e = 0; e < 4; ++e) v[bj][n][e] = v[bj][n][e] * sigmoidf_(v[bj][n][e]);
                } else if (mode == 3) {
#pragma unroll
                    for (int bj = 0; bj < 2; ++bj)
#pragma unroll
                        for (int n = 0; n < 2; ++n)
#pragma unroll
                            for (int e = 0; e < 4; ++e) v[bj][n][e] = sigmoidf_(v[bj][n][e]);
                }
#pragma unroll
                for (int bj = 0; bj < 2; ++bj) {
                    u32x4 w; w.x = pk2(v[bj][0][0], v[bj][0][1]); w.y = pk2(v[bj][0][2], v[bj][0][3]); w.z = pk2(v[bj][1][0], v[bj][1][1]); w.w = pk2(v[bj][1][2], v[bj][1][3]);
                    if (c64 < 52) {
                        const int col = c64 * 64 + 32 * bj + 8 * fq;
                        if (!meta) { const int prow = r + 128 * ((r >> 13) + 1); *(u32x4*)(P + (size_t)prow * PP + col) = w; }
                        else { const int i = r - MTOK; if (i < 128) { const int tp = (i + 112) & 127; *(u32x4*)(P + (size_t)tp * PP + col) = w; *(u32x4*)(P + (size_t)(LP + tp) * PP + col) = w; } }
                    } else if (!meta) {
                        *(u32x4*)(G + (size_t)r * GW + (c64 - 52) * 64 + 32 * bj + 8 * fq) = w;
                    }
                }
            }
    }
};

struct EpiUp {
    static constexpr bool PERM = true, AFTER_DRAIN = false, TWO_SEG = true, INIT_ACC = false;
    const bf16_t* G; bf16_t* MIX;
    __device__ __forceinline__ void mid(f32x4 (&acc)[2][2][4][2], const pg8::Unit& u, int wr, int wc, int fr, int fq) const {
#pragma unroll
        for (int ai = 0; ai < 2; ++ai)
#pragma unroll
            for (int m = 0; m < 4; ++m) { const int r = u.pm * 256 + ai * 128 + wr * 64 + m * 16 + fr;
#pragma unroll
                for (int bj = 0; bj < 2; ++bj) { const int c0 = u.pn * 256 + 128 * bj + 32 * wc + 8 * fq;
                    const u32x4 ga = *(const u32x4*)(G + (size_t)r * GW + c0), gb = *(const u32x4*)(G + (size_t)r * GW + DM + c0);
                    f32x4& a = acc[ai][bj][m][0]; f32x4& b = acc[ai][bj][m][1];
#define RAT(x, y) ((x) * __builtin_amdgcn_rcpf(fmaxf((y), 1e-30f)))
                    a[0] *= RAT(bflo(ga.x), bflo(gb.x)); a[1] *= RAT(bfhi(ga.x), bfhi(gb.x)); a[2] *= RAT(bflo(ga.y), bflo(gb.y)); a[3] *= RAT(bfhi(ga.y), bfhi(gb.y));
                    b[0] *= RAT(bflo(ga.z), bflo(gb.z)); b[1] *= RAT(bfhi(ga.z), bfhi(gb.z)); b[2] *= RAT(bflo(ga.w), bflo(gb.w)); b[3] *= RAT(bfhi(ga.w), bfhi(gb.w));
#undef RAT
                } }
    }
    __device__ __forceinline__ void operator()(const f32x4 (&acc)[2][2][4][2], const pg8::Unit& u, int wr, int wc, int fr, int fq) const {
#pragma unroll
        for (int ai = 0; ai < 2; ++ai)
#pragma unroll
            for (int m = 0; m < 4; ++m) { const int r = u.pm * 256 + ai * 128 + wr * 64 + m * 16 + fr;
#pragma unroll
                for (int bj = 0; bj < 2; ++bj) { const int c0 = u.pn * 256 + 128 * bj + 32 * wc + 8 * fq;
                    const u32x4 g = *(const u32x4*)(G + (size_t)r * GW + DM + c0);
                    const f32x4 a = acc[ai][bj][m][0], b = acc[ai][bj][m][1];
                    u32x4 w; w.x = pk2(a[0] * bflo(g.x), a[1] * bfhi(g.x)); w.y = pk2(a[2] * bflo(g.y), a[3] * bfhi(g.y)); w.z = pk2(b[0] * bflo(g.z), b[1] * bfhi(g.z)); w.w = pk2(b[2] * bflo(g.w), b[3] * bfhi(g.w));
                    *(u32x4*)(MIX + (size_t)r * DM + c0) = w; } }
    }
};
struct EpiOut {
    static constexpr bool PERM = true, AFTER_DRAIN = false, TWO_SEG = false, INIT_ACC = true;
    const float* X; float* O;
    __device__ __forceinline__ void init(f32x4 (&acc)[2][2][4][2], const pg8::Unit& u, int wr, int wc, int fr, int fq) const {
#pragma unroll
        for (int ai = 0; ai < 2; ++ai)
#pragma unroll
            for (int m = 0; m < 4; ++m) { const int r = u.pm * 256 + ai * 128 + wr * 64 + m * 16 + fr;
#pragma unroll
                for (int bj = 0; bj < 2; ++bj) { const float* xp = X + (size_t)r * DM + u.pn * 256 + 128 * bj + 32 * wc + 8 * fq;
                    acc[ai][bj][m][0] = __builtin_nontemporal_load((const f32x4*)xp); acc[ai][bj][m][1] = __builtin_nontemporal_load((const f32x4*)(xp + 4)); } }
    }
    __device__ __forceinline__ void operator()(const f32x4 (&acc)[2][2][4][2], const pg8::Unit& u, int wr, int wc, int fr, int fq) const {
#pragma unroll
        for (int ai = 0; ai < 2; ++ai)
#pragma unroll
            for (int m = 0; m < 4; ++m) { const int r = u.pm * 256 + ai * 128 + wr * 64 + m * 16 + fr;
#pragma unroll
                for (int bj = 0; bj < 2; ++bj) { float* op = O + (size_t)r * DM + u.pn * 256 + 128 * bj + 32 * wc + 8 * fq;
                    __builtin_nontemporal_store(acc[ai][bj][m][0], (f32x4*)op); __builtin_nontemporal_store(acc[ai][bj][m][1], (f32x4*)(op + 4)); } }
    }
};

#define MFMA32(a, b, c) __builtin_amdgcn_mfma_f32_32x32x16_bf16(a, b, c, 0, 0, 0)
#define SBAR() __builtin_amdgcn_sched_barrier(0)
typedef short v4i16_t __attribute__((ext_vector_type(4)));
__device__ __forceinline__ int crow(int r, int hi) { return (r & 3) + 8 * (r >> 2) + 4 * hi; }
__device__ __forceinline__ s16x4 vtr(const LAS unsigned char* p) { return __builtin_bit_cast(s16x4, __builtin_amdgcn_ds_read_tr16_b64_v4i16((LAS v4i16_t*)p)); }
__device__ __forceinline__ bf16x8 cat8(s16x4 lo, s16x4 hi) { return (bf16x8){lo[0], lo[1], lo[2], lo[3], hi[0], hi[1], hi[2], hi[3]}; }
__device__ __forceinline__ bf16x8 pack8(const f32x16& p, int b) {
    u32x4 w; w.x = pk2(p[b], p[b + 1]); w.y = pk2(p[b + 2], p[b + 3]); w.z = pk2(p[b + 4], p[b + 5]); w.w = pk2(p[b + 6], p[b + 7]); return __builtin_bit_cast(bf16x8, w); }
constexpr int ATT_SCR = 98304;

#define B_QK_INIT(N0, N1, T) do { float sl_ = slope2; asm volatile("" : "+v"(sl_));     \
    const float tb_ = sl_ * (float)(64 * (T) - (128 * qb + 32 * wq)) + abase; \
      \
    _Pragma("unroll") for (int r = 0; r < 16; ++r) { float a_ = fmaf(sl_, (float)((r & 3) + 8 * (r >> 2)), tb_), b_ = fmaf(sl_, (float)((r & 3) + 8 * (r >> 2) + 32), tb_); \
        asm("" : "+v"(a_)); asm("" : "+v"(b_)); N0[r] = a_; N1[r] = b_; } } while (0)
#define B_EXP4(C, B) do { C[B] = fast_exp2(C[B]); C[B + 1] = fast_exp2(C[B + 1]); C[B + 2] = fast_exp2(C[B + 2]); C[B + 3] = fast_exp2(C[B + 3]); } while (0)
#define B_STEP(C0, C1, N0, N1, T) do { \
    const int t_ = (T); const bool has1 = (t_ + 1 <= t1), has2 = (t_ + 2 <= t1), has3 = (t_ + 3 <= t1); \
    const int r0_ = (t_ - t0) % 3, r1_ = (r0_ == 2) ? 0 : r0_ + 1, r2_ = (r1_ == 2) ? 0 : r1_ + 1;     \
    if (has3) { const size_t go = (size_t)(t_ + 3) * 64 * PP; const int kn_ = r0_ * 16384 + w * 1024; GLDS16(k0src + go, lds + kn_); GLDS16(k1src + go, lds + kn_ + 8192); } \
    if (has2) { const size_t go = (size_t)(t_ + 2) * 64 * PP; const int vn_ = 49152 + r2_ * 16384 + vdw; GLDS16(vsrc + go, lds + vn_); GLDS16(vsrc + go + 64, lds + vn_ + 8192); } \
    if (has1) { \
        const LAS unsigned char* kb = lds + r1_ * 16384 + map * 8192; \
        bf16x8 kf[8]; \
        _Pragma("unroll") for (int d0 = 0; d0 < 4; ++d0) { kf[2 * d0] = *(const LAS bf16x8*)(kb + koff[d0]); kf[2 * d0 + 1] = *(const LAS bf16x8*)(kb + koff[d0] + 4096); } \
        B_QK_INIT(N0, N1, t_ + 1); \
        SBAR(); \
        N0 = MFMA32(kf[0], qr[0], N0); B_EXP4(C0, 0); SBAR(); \
        N1 = MFMA32(kf[1], qr[0], N1); B_EXP4(C1, 0); SBAR(); \
        N0 = MFMA32(kf[2], qr[1], N0); B_EXP4(C0, 4); SBAR(); \
        N1 = MFMA32(kf[3], qr[1], N1); B_EXP4(C1, 4); SBAR(); \
        N0 = MFMA32(kf[4], qr[2], N0); B_EXP4(C0, 8); SBAR(); \
        N1 = MFMA32(kf[5], qr[2], N1); B_EXP4(C1, 8); SBAR(); \
        N0 = MFMA32(kf[6], qr[3], N0); B_EXP4(C0, 12); SBAR(); \
        N1 = MFMA32(kf[7], qr[3], N1); B_EXP4(C1, 12); SBAR(); \
    } else { \
        _Pragma("unroll") for (int r = 0; r < 16; ++r) { C0[r] = fast_exp2(C0[r]); C1[r] = fast_exp2(C1[r]); } \
    } \
    const LAS unsigned char* vb = lds + 49152 + r0_ * 16384 + vlane; \
    s16x4 va[8], vc[8];                                             \
    _Pragma("unroll") for (int d = 0; d < 4; ++d) { va[2 * d] = vtr(vb + d * 4096); va[2 * d + 1] = vtr(vb + d * 4096 + 512); } \
    if (t_ == 1 || t_ >= 2 * qb) {                                  \
        _Pragma("unroll") for (int r = 0; r < 16; ++r) { const int k0t = 64 * t_ + crow(r, hi), k1t = k0t + 32; \
            if (k0t > qt || k0t < 112) C0[r] = 0.f; if (k1t > qt || k1t < 112) C1[r] = 0.f; } \
    } \
      \
    const bf16x8 pw0 = pack8(C0, 0); \
    _Pragma("unroll") for (int d = 0; d < 4; ++d) { vc[2 * d] = vtr(vb + d * 4096 + 1024); vc[2 * d + 1] = vtr(vb + d * 4096 + 1536); } \
    SBAR(); \
    o[0] = MFMA32(pw0, cat8(va[0], va[1]), o[0]); o[1] = MFMA32(pw0, cat8(va[2], va[3]), o[1]); \
    o[2] = MFMA32(pw0, cat8(va[4], va[5]), o[2]); o[3] = MFMA32(pw0, cat8(va[6], va[7]), o[3]); \
    const bf16x8 pw1 = pack8(C0, 8); \
    float a_ = ((C0[0] + C0[1]) + (C0[2] + C0[3])) + ((C0[4] + C0[5]) + (C0[6] + C0[7])); \
    SBAR(); \
    _Pragma("unroll") for (int d = 0; d < 4; ++d) { va[2 * d] = vtr(vb + d * 4096 + 2048); va[2 * d + 1] = vtr(vb + d * 4096 + 2560); } \
    o[0] = MFMA32(pw1, cat8(vc[0], vc[1]), o[0]); o[1] = MFMA32(pw1, cat8(vc[2], vc[3]), o[1]); \
    o[2] = MFMA32(pw1, cat8(vc[4], vc[5]), o[2]); o[3] = MFMA32(pw1, cat8(vc[6], vc[7]), o[3]); \
    const bf16x8 pw2 = pack8(C1, 0); \
    a_ += ((C0[8] + C0[9]) + (C0[10] + C0[11])) + ((C0[12] + C0[13]) + (C0[14] + C0[15])); \
    SBAR(); \
    _Pragma("unroll") for (int d = 0; d < 4; ++d) { vc[2 * d] = vtr(vb + d * 4096 + 3072); vc[2 * d + 1] = vtr(vb + d * 4096 + 3584); } \
    o[0] = MFMA32(pw2, cat8(va[0], va[1]), o[0]); o[1] = MFMA32(pw2, cat8(va[2], va[3]), o[1]); \
    o[2] = MFMA32(pw2, cat8(va[4], va[5]), o[2]); o[3] = MFMA32(pw2, cat8(va[6], va[7]), o[3]); \
    const bf16x8 pw3 = pack8(C1, 8); \
    a_ += ((C1[0] + C1[1]) + (C1[2] + C1[3])) + ((C1[4] + C1[5]) + (C1[6] + C1[7])); \
    SBAR(); \
    o[0] = MFMA32(pw3, cat8(vc[0], vc[1]), o[0]); o[1] = MFMA32(pw3, cat8(vc[2], vc[3]), o[1]); \
    o[2] = MFMA32(pw3, cat8(vc[4], vc[5]), o[2]); o[3] = MFMA32(pw3, cat8(vc[6], vc[7]), o[3]); \
    a_ += ((C1[8] + C1[9]) + (C1[10] + C1[11])) + ((C1[12] + C1[13]) + (C1[14] + C1[15])); \
    lsum += a_; \
    SBAR(); \
      \
      \
    if (has3 && has2) asm volatile("s_waitcnt vmcnt(4) lgkmcnt(0)\n\ts_barrier" ::: "memory"); \
    else asm volatile("s_waitcnt vmcnt(0) lgkmcnt(0)\n\ts_barrier" ::: "memory"); \
} while (0)

__device__ __forceinline__ void attn_b_core(const bf16_t* __restrict__ P, float kmax, int b, int h, int qb, int t0, int t1, LAS unsigned char* lds, f32x16 (&o)[4], float& lsum) {
    int tid = threadIdx.x; asm volatile("" : "+v"(tid));
    const int lane = tid & 63, r32 = lane & 31, hi = lane >> 5; const int w = __builtin_amdgcn_readfirstlane(tid >> 6);
    const int map = w >> 2, wq = w & 3;
    const size_t rowbase = (size_t)b * LP;
    const float slope2 = exp2f(-2.0f * (float)(h + 1)) * LOG2E;
    const int krow = 8 * w + (lane >> 3);
    const bf16_t* k0src = P + (rowbase + krow) * PP + 1792 + h * 128 + (((lane & 7) ^ ((krow >> 1) & 7)) << 3);
    const bf16_t* k1src = k0src + 64;
    const bf16_t* vsrc = P + (rowbase + 16 * (w & 3) + (lane >> 2)) * PP + 2304 + h * 128 + (w >> 2) * 32 + (lane & 3) * 8;
    const int vdw = (w >> 2) * 4096 + (w & 3) * 1024;
    int koff[4];
#pragma unroll
    for (int d0 = 0; d0 < 4; ++d0) koff[d0] = r32 * 128 + ((((2 * d0 + hi) ^ ((r32 >> 1) & 7))) << 4);
#define GLDS16(gp, lp) __builtin_amdgcn_global_load_lds((const unsigned*)(gp), (LAS unsigned*)(lp), 16, 0, 0)
    const int qt = 128 * qb + 32 * wq + r32;
    bf16x8 qr[4];
    { const bf16_t* qp = P + (rowbase + qt) * PP + 1280 + h * 128 + map * 64 + 8 * hi;
#pragma unroll
      for (int d0 = 0; d0 < 4; ++d0) qr[d0] = *(const bf16x8*)(qp + 16 * d0); }
    float qss = 0.f;
#pragma unroll
    for (int d0 = 0; d0 < 4; ++d0)
#pragma unroll
        for (int e = 0; e < 8; ++e) { const float f = bf2f((unsigned short)qr[d0][e]); qss += f * f; }
    qss += __shfl_xor(qss, 32);
    const float mrow = sqrtf(qss) * kmax;
    const float abase = -slope2 * (float)(r32 - 4 * hi) - mrow;
#pragma unroll
    for (int d = 0; d < 4; ++d) o[d] = f32x16{};
    lsum = 0.f;
    const int vlane = ((lane >> 4) & 1) * 32 + (lane & 3) * 8 + (4 * hi + ((lane & 15) >> 2)) * 64;
    { const size_t go = (size_t)t0 * 64 * PP, g1 = (size_t)64 * PP;
      GLDS16(k0src + go, lds + w * 1024); GLDS16(k1src + go, lds + 8192 + w * 1024); GLDS16(vsrc + go, lds + 49152 + vdw); GLDS16(vsrc + go + 64, lds + 49152 + vdw + 8192);
      if (t0 + 1 <= t1) { GLDS16(k0src + go + g1, lds + 16384 + w * 1024); GLDS16(k1src + go + g1, lds + 16384 + 8192 + w * 1024);
                          GLDS16(vsrc + go + g1, lds + 49152 + 16384 + vdw); GLDS16(vsrc + go + g1 + 64, lds + 49152 + 16384 + vdw + 8192); }
      if (t0 + 2 <= t1) { GLDS16(k0src + go + 2 * g1, lds + 32768 + w * 1024); GLDS16(k1src + go + 2 * g1, lds + 32768 + 8192 + w * 1024); } }
    asm volatile("s_waitcnt vmcnt(0)" ::: "memory");
    __syncthreads();
    f32x16 sA0, sA1, sB0, sB1;
    { const LAS unsigned char* kb = lds + map * 8192;
      B_QK_INIT(sA0, sA1, t0);
#pragma unroll
      for (int d0 = 0; d0 < 4; ++d0) { const bf16x8 k0 = *(const LAS bf16x8*)(kb + koff[d0]), k1 = *(const LAS bf16x8*)(kb + koff[d0] + 4096);
          sA0 = MFMA32(k0, qr[d0], sA0); sA1 = MFMA32(k1, qr[d0], sA1); } }
    __syncthreads();
    for (int t = t0; t <= t1; t += 2) {
        B_STEP(sA0, sA1, sB0, sB1, t);
        if (t + 1 <= t1) B_STEP(sB0, sB1, sA0, sA1, t + 1);
    }
}
#undef B_STEP
#undef GLDS16
#undef B_EXP4
#undef B_QK_INIT
__device__ __forceinline__ void attn_b_finalize(const bf16_t* __restrict__ P, bf16_t* __restrict__ YB, const float* __restrict__ subln, float lam, int b, int h, int qb, LAS unsigned char* lds, f32x16 (&o)[4], float lsum) {
    int tid = threadIdx.x; asm volatile("" : "+v"(tid));
    const int lane = tid & 63, r32 = lane & 31, hi = lane >> 5; const int w = __builtin_amdgcn_readfirstlane(tid >> 6);
    const int map = w >> 2, wq = w & 3;
    const size_t rowbase = (size_t)b * LP;
    lsum += __shfl_xor(lsum, 32);
    LAS float* scr = (LAS float*)(lds + ATT_SCR) + w * 32;
    { float inv = 1.0f / lsum; if (map == 1) inv *= lam; if (hi == 0) scr[r32] = inv; }
    float rl[16];
#pragma unroll
    for (int r = 0; r < 16; ++r) rl[r] = scr[crow(r, hi)];
#pragma unroll
    for (int d0 = 0; d0 < 4; ++d0)
#pragma unroll
        for (int r = 0; r < 16; ++r) o[d0][r] *= rl[r];
    LAS float* X = (LAS float*)lds;
    if (map == 1) {
#pragma unroll
        for (int d0 = 0; d0 < 4; ++d0)
#pragma unroll
            for (int r = 0; r < 16; ++r) X[((wq * 4 + d0) * 16 + r) * 64 + lane] = o[d0][r];
    }
    __syncthreads();
    LAS unsigned short* Y = (LAS unsigned short*)(lds + 65536);
    if (map == 0) {
        float rn[16];
#pragma unroll
        for (int r = 0; r < 16; ++r) { float ss = 0.f;
#pragma unroll
            for (int d0 = 0; d0 < 4; ++d0) { o[d0][r] -= X[((wq * 4 + d0) * 16 + r) * 64 + lane]; ss += o[d0][r] * o[d0][r]; }
            ss += __shfl_xor(ss, 1); ss += __shfl_xor(ss, 2); ss += __shfl_xor(ss, 4); ss += __shfl_xor(ss, 8); ss += __shfl_xor(ss, 16);
            rn[r] = (1.0f - LAM_INIT) / sqrtf(ss * (1.f / 128.f) + RMS_EPS); }
#pragma unroll
        for (int d0 = 0; d0 < 4; ++d0) { const float sg = subln[32 * d0 + r32];
#pragma unroll
            for (int r = 0; r < 16; ++r) Y[(32 * wq + crow(r, hi)) * 128 + 32 * d0 + r32] = (unsigned short)f2bf(o[d0][r] * rn[r] * sg); }
    }
    __syncthreads();
    { u32x4 yv[4], zv[4];
#pragma unroll
      for (int i = 0; i < 4; ++i) { const int x = tid + 512 * i, row = x >> 4, c = x & 15;
          yv[i] = *(const LAS u32x4*)(Y + row * 128 + c * 8);
          zv[i] = *(const u32x4*)(P + (rowbase + 128 * qb + row) * PP + 2816 + h * 128 + c * 8); }
#pragma unroll
      for (int i = 0; i < 4; ++i) { const int x = tid + 512 * i, row = x >> 4, c = x & 15;
          u32x4 ov; ov.x = pk2(bflo(yv[i].x) * bflo(zv[i].x), bfhi(yv[i].x) * bfhi(zv[i].x)); ov.y = pk2(bflo(yv[i].y) * bflo(zv[i].y), bfhi(yv[i].y) * bfhi(zv[i].y));
          ov.z = pk2(bflo(yv[i].z) * bflo(zv[i].z), bfhi(yv[i].z) * bfhi(zv[i].z)); ov.w = pk2(bflo(yv[i].w) * bflo(zv[i].w), bfhi(yv[i].w) * bfhi(zv[i].w));
          __builtin_nontemporal_store(ov, (u32x4*)(YB + ((size_t)b * SEQ + 128 * (qb - 1) + row) * BW + h * 128 + c * 8)); } }
    __syncthreads();
}

__device__ __forceinline__ void attn_a_unit(const bf16_t* __restrict__ P, bf16_t* __restrict__ YA, const float* __restrict__ sink, float kmax, int b, int kvh, int qb, LAS unsigned char* lds) {
    int tid = threadIdx.x; asm volatile("" : "+v"(tid));
    const int lane = tid & 63, r32 = lane & 31, hi = lane >> 5; const int w = __builtin_amdgcn_readfirstlane(tid >> 6);
    const size_t rowbase = (size_t)b * LP; const int kt0 = 128 * (qb - 1);
    { u32x4 kk[4], vv[4];
#pragma unroll
      for (int j = 0; j < 4; ++j) { kk[j] = *(const u32x4*)(P + (rowbase + kt0 + 64 * j + lane) * PP + 512 + kvh * 64 + w * 8);
                                    vv[j] = *(const u32x4*)(P + (rowbase + kt0 + 64 * j + (tid >> 3)) * PP + 640 + kvh * 64 + (tid & 7) * 8); }
#pragma unroll
      for (int j = 0; j < 4; ++j) { *(LAS u32x4*)(lds + j * 8192 + w * 1024 + lane * 16) = kk[j];
                                    *(LAS u32x4*)(lds + 32768 + j * 8192 + ((tid & 7) >> 2) * 4096 + (tid >> 3) * 64 + (tid & 3) * 16) = vv[j]; } }
    __syncthreads();
    const int g = w >> 1, hq = kvh * 4 + g;
    const float slope2 = exp2f(-(float)(hq + 1)) * LOG2E, sink2 = sink[hq] * LOG2E;
    const int vlane = ((lane >> 4) & 1) * 32 + (lane & 3) * 8 + (4 * hi + ((lane & 15) >> 2)) * 64;
    LAS float* scr = (LAS float*)(lds + ATT_SCR) + w * 32;
    for (int sub = 0; sub < 2; ++sub) {
        const int q0 = 64 * (w & 1) + 32 * sub; const int qrel = 128 + q0 + r32;
        bf16x8 qr[4];
        { const bf16_t* qp = P + (rowbase + kt0 + qrel) * PP + hq * 64 + 8 * hi;
#pragma unroll
          for (int d0 = 0; d0 < 4; ++d0) qr[d0] = *(const bf16x8*)(qp + 16 * d0); }
        float qss = 0.f;
#pragma unroll
        for (int d0 = 0; d0 < 4; ++d0)
#pragma unroll
            for (int e = 0; e < 8; ++e) { const float f = bf2f((unsigned short)qr[d0][e]); qss += f * f; }
        qss += __shfl_xor(qss, 32);
        const float cref = fmaxf(sqrtf(qss) * kmax, sink2);
        f32x16 o[2]; o[0] = f32x16{}; o[1] = f32x16{}; float lsum = 0.f;
        for (int jj = 0; jj < 3; ++jj) { const int j = (w & 1) + jj;
            f32x16 s0, s1;
#pragma unroll
            for (int r = 0; r < 16; ++r) { const int d0_ = qrel - (64 * j + crow(r, hi)); s0[r] = -slope2 * (float)d0_ - cref; s1[r] = -slope2 * (float)(d0_ - 32) - cref; }
            const LAS unsigned char* kb = lds + j * 8192 + hi * 1024 + r32 * 16;
#pragma unroll
            for (int d0 = 0; d0 < 4; ++d0) {
                const bf16x8 k0 = *(const LAS bf16x8*)(kb + d0 * 2048), k1 = *(const LAS bf16x8*)(kb + d0 * 2048 + 512);
                s0 = MFMA32(k0, qr[d0], s0); s1 = MFMA32(k1, qr[d0], s1); }
#pragma unroll
            for (int r = 0; r < 16; ++r) { const int kr = 64 * j + crow(r, hi); const int da = qrel - kr, db = da - 32;
                const float e0 = fast_exp2(s0[r]), e1 = fast_exp2(s1[r]);
                s0[r] = (da >= 0 && da < 128 && kt0 + kr >= 112) ? e0 : 0.f;
                s1[r] = (db >= 0 && db < 128 && kt0 + kr + 32 >= 112) ? e1 : 0.f; }
            { float a = 0.f;
#pragma unroll
              for (int r = 0; r < 16; ++r) a += s0[r] + s1[r];
              lsum += a; }
            const bf16x8 pw0 = pack8(s0, 0), pw1 = pack8(s0, 8), pw2 = pack8(s1, 0), pw3 = pack8(s1, 8);
            const LAS unsigned char* vb = lds + 32768 + j * 8192 + vlane;
#pragma unroll
            for (int d0 = 0; d0 < 2; ++d0) {
                o[d0] = MFMA32(pw0, cat8(vtr(vb + d0 * 4096), vtr(vb + d0 * 4096 + 512)), o[d0]);
                o[d0] = MFMA32(pw1, cat8(vtr(vb + d0 * 4096 + 1024), vtr(vb + d0 * 4096 + 1536)), o[d0]);
                o[d0] = MFMA32(pw2, cat8(vtr(vb + d0 * 4096 + 2048), vtr(vb + d0 * 4096 + 2560)), o[d0]);
                o[d0] = MFMA32(pw3, cat8(vtr(vb + d0 * 4096 + 3072), vtr(vb + d0 * 4096 + 3584)), o[d0]);
            }
        }
        lsum += __shfl_xor(lsum, 32);
        { const float inv = 1.0f / (lsum + fast_exp2(sink2 - cref)); if (hi == 0) scr[r32] = inv; }
        float rl[16];
#pragma unroll
        for (int r = 0; r < 16; ++r) rl[r] = scr[crow(r, hi)];
        LAS unsigned short* Yw = (LAS unsigned short*)(lds + 65536) + w * 2048;
#pragma unroll
        for (int d0 = 0; d0 < 2; ++d0)
#pragma unroll
            for (int r = 0; r < 16; ++r) Yw[crow(r, hi) * 64 + 32 * d0 + r32] = (unsigned short)f2bf(o[d0][r] * rl[r]);
        { u32x4 yv[4], zv[4];
#pragma unroll
          for (int i = 0; i < 4; ++i) { const int row = i * 8 + (lane >> 3), c = lane & 7;
              yv[i] = *(const LAS u32x4*)(Yw + row * 64 + c * 8);
              zv[i] = *(const u32x4*)(P + (rowbase + kt0 + 128 + q0 + row) * PP + 768 + hq * 64 + c * 8); }
#pragma unroll
          for (int i = 0; i < 4; ++i) { const int row = i * 8 + (lane >> 3), c = lane & 7;
              u32x4 ov; ov.x = pk2(bflo(yv[i].x) * bflo(zv[i].x), bfhi(yv[i].x) * bfhi(zv[i].x)); ov.y = pk2(bflo(yv[i].y) * bflo(zv[i].y), bfhi(yv[i].y) * bfhi(zv[i].y));
              ov.z = pk2(bflo(yv[i].z) * bflo(zv[i].z), bfhi(yv[i].z) * bfhi(zv[i].z)); ov.w = pk2(bflo(yv[i].w) * bflo(zv[i].w), bfhi(yv[i].w) * bfhi(zv[i].w));
              __builtin_nontemporal_store(ov, (u32x4*)(YA + ((size_t)b * SEQ + kt0 + q0 + row) * AW + hq * 64 + c * 8)); } }
    }
    __syncthreads();
}

constexpr size_t WS_SLOT = 219 * MiB; constexpr int SLOT_BYTES = 133120, SLOT_MAX = 280;
constexpr int TAB_OFF = 102400;
constexpr int CW_QUEUE = 8192;
__device__ __forceinline__ void unit_decode(int j, int& b, int& h, int& qb) { h = 3 - (j >> 7); const int jj = j & 127; qb = 64 - (jj >> 1); b = jj & 1; }
__device__ __forceinline__ int b_window(int h, float mmax) {
    const float slope2 = exp2f(-2.0f * (float)(h + 1)) * LOG2E;
    const float need = 24.0f + 2.0f * mmax + log2f(1.0f / (slope2 * 0.69314718f));
    const float d = ceilf(need / slope2) + 1.0f;
    return d > 1.0e6f ? 1000000 : (int)d;
}
__device__ __forceinline__ int b_tmin(int qb, int dh) { const int k = 128 * qb - dh; return k < 128 ? 1 : (k >> 6); }
__device__ __forceinline__ void b_store_partial(unsigned char* ws, int slot, const f32x16 (&o)[4], float lsum) {
    int tid = threadIdx.x; asm volatile("" : "+v"(tid));
    const int lane = tid & 63; const int w = __builtin_amdgcn_readfirstlane(tid >> 6);
    float* S = (float*)(ws + WS_SLOT + (size_t)slot * SLOT_BYTES);
#pragma unroll
    for (int d0 = 0; d0 < 4; ++d0)
#pragma unroll
        for (int r = 0; r < 16; ++r) S[((w * 4 + d0) * 16 + r) * 64 + lane] = o[d0][r];
    S[32768 + w * 64 + lane] = lsum;
}
__device__ __forceinline__ void b_load_partials(const unsigned char* ws, int slot0, int nc, f32x16 (&o)[4], float& lsum) {
    int tid = threadIdx.x; asm volatile("" : "+v"(tid));
    const int lane = tid & 63; const int w = __builtin_amdgcn_readfirstlane(tid >> 6);
#pragma unroll
    for (int d = 0; d < 4; ++d) o[d] = f32x16{};
    lsum = 0.f;
    for (int c = 0; c < nc; ++c) { const float* S = (const float*)(ws + WS_SLOT + (size_t)(slot0 + c) * SLOT_BYTES);
#pragma unroll
        for (int d0 = 0; d0 < 4; ++d0)
#pragma unroll
            for (int r = 0; r < 16; ++r) o[d0][r] += S[((w * 4 + d0) * 16 + r) * 64 + lane];
        lsum += S[32768 + w * 64 + lane]; }
}

#define GAS __attribute__((address_space(1)))
typedef GAS unsigned gu32;
typedef GAS unsigned long long gu64;
#define RLX_AGENT __ATOMIC_RELAXED, __HIP_MEMORY_SCOPE_AGENT
#define LDS_WAIT() asm volatile("s_waitcnt lgkmcnt(0)" ::: "memory")
#define VM_WAIT() asm volatile("s_waitcnt vmcnt(0)" ::: "memory")
__device__ __forceinline__ unsigned long long rt() { return __builtin_amdgcn_s_memrealtime(); }
#define XB_TMO      128
#define XB_XCNT(j)  (256  + 64 * (j))
#define XB_XSUB(j)  (1280 + 64 * (j))
#define XB_XGEN(j)  (2304 + 64 * (j))
#define XB_TOP      3328
#define XB_TOPGEN   3392
#define XCD_BAR_WORDS 3456
#define XB_SPIN_CAP (1u << 18)

__device__ __forceinline__ unsigned xb_ld(unsigned* p)              { return __hip_atomic_load(p, __ATOMIC_RELAXED, __HIP_MEMORY_SCOPE_AGENT); }
__device__ __forceinline__ unsigned xb_add(unsigned* p, unsigned v) { return __hip_atomic_fetch_add(p, v, __ATOMIC_RELAXED, __HIP_MEMORY_SCOPE_AGENT); }
__device__ __forceinline__ unsigned xb_xcc_id() { return (unsigned)__builtin_amdgcn_s_getreg((3 << 11) | 20) & 0xFu; }
#define XB_SPIN(cond, bar) do { unsigned _sp = 0; while (cond) { __builtin_amdgcn_s_sleep(1); \
    if ((++_sp & 255u) == 0u) { if (xb_ld(&(bar)[XB_TMO])) break; if (_sp > XB_SPIN_CAP) { atomicAdd(&(bar)[XB_TMO], 1u); break; } } } } while (0)

struct XcdBarrier {
    unsigned* bar; unsigned x;
    volatile LAS unsigned* st;
};

__device__ __forceinline__ XcdBarrier xcd_barrier_post(unsigned* bar, volatile LAS unsigned* st) {
    XcdBarrier b; b.bar = bar; b.x = xb_xcc_id(); b.st = st;
    if (threadIdx.x == 0) (void)xb_add(&bar[XB_XCNT(b.x)], 1u);
    return b;
}
__device__ __forceinline__ void xcd_barrier_complete(unsigned* bar, unsigned x, unsigned& nloc, unsigned& nx) {
    const unsigned G = gridDim.x * gridDim.y * gridDim.z;
    unsigned sum, cnt, mine, sp = 0u;
    for (;;) {
        sum = 0u; cnt = 0u; mine = 0u;
#pragma unroll
        for (unsigned j = 0; j < 16; ++j) { const unsigned c = xb_ld(&bar[XB_XCNT(j)]); sum += c; cnt += (c > 0u) ? 1u : 0u; mine = (j == x) ? c : mine; }
        if (sum == G) break;
        __builtin_amdgcn_s_sleep(1);
        if ((++sp & 255u) == 0u) { if (xb_ld(&bar[XB_TMO])) break; if (sp > XB_SPIN_CAP) { atomicAdd(&bar[XB_TMO], 1u); break; } }
    }
    nloc = mine > 0u ? mine : 1u; nx = cnt > 0u ? cnt : 1u;
}

__device__ __forceinline__ void xcd_barrier(const XcdBarrier& b) {
    asm volatile("s_waitcnt vmcnt(0)" ::: "memory");
    __syncthreads();
    if (threadIdx.x == 0) {
        unsigned* bar = b.bar;
        __builtin_amdgcn_s_waitcnt(0);
        unsigned nloc = b.st[0], nx = b.st[1];
        if (nloc == 0u) { xcd_barrier_complete(bar, b.x, nloc, nx); b.st[0] = nloc; b.st[1] = nx; }
        const unsigned old = xb_add(&bar[XB_XSUB(b.x)], 1u);
        const unsigned gen = old / nloc;
        if (old + 1u == (gen + 1u) * nloc) {
            __builtin_amdgcn_fence(__ATOMIC_RELEASE, "agent");
            asm volatile("s_waitcnt vmcnt(0)" ::: "memory");
            const unsigned og = xb_add(&bar[XB_TOP], 1u);
            const unsigned tg = og / nx;
            if (og + 1u == (tg + 1u) * nx) xb_add(&bar[XB_TOPGEN], 1u);
            else XB_SPIN(xb_ld(&bar[XB_TOPGEN]) == tg, bar);
            __builtin_amdgcn_fence(__ATOMIC_ACQUIRE, "agent");
            xb_add(&bar[XB_XGEN(b.x)], 1u);
            asm volatile("s_waitcnt vmcnt(0)" ::: "memory");
        } else {
            XB_SPIN(xb_ld(&bar[XB_XGEN(b.x)]) == gen, bar);
            __builtin_amdgcn_fence(__ATOMIC_ACQUIRE, "agent");
            asm volatile("s_waitcnt vmcnt(0)" ::: "memory");
        }
    }
    __syncthreads();
}

struct Args { const float* in[17]; float* out; unsigned char* ws; int ph_lo, ph_hi; };

__global__ void __launch_bounds__(NWAVES * 64, 2) hybrid_fwd(Args args) {
    extern __shared__ __attribute__((aligned(16))) unsigned char lds_raw[];
    LAS unsigned char* lds = (LAS unsigned char*)lds_raw;
    cg::grid_group grid = cg::this_grid();
    const int tid = threadIdx.x, lane = tid & 63; const int wave = __builtin_amdgcn_readfirstlane(tid >> 6);
    const int G = gridDim.x; const int bx = blockIdx.x; const int vcu = (G % 8 == 0) ? (bx % 8) * (G / 8) + bx / 8 : bx;
    unsigned char* ws = args.ws;
    bf16_t* WinT = (bf16_t*)(ws + WS_WIN); bf16_t* WuaT = (bf16_t*)(ws + WS_WUA); bf16_t* WubT = (bf16_t*)(ws + WS_WUB); bf16_t* WoT = (bf16_t*)(ws + WS_WO);
    bf16_t* XN = (bf16_t*)(ws + WS_XN);
    bf16_t* YA = (bf16_t*)args.out; bf16_t* YB = YA + (size_t)MTOK * AW;
    bf16_t* Pb = (bf16_t*)(ws + WS_P); float* T = (float*)(ws + WS_T); bf16_t* MIX = (bf16_t*)(ws + WS_MIX); bf16_t* Gt = (bf16_t*)(ws + WS_G);
    const int lo = args.ph_lo, hi = args.ph_hi;
    volatile LAS unsigned* bst = (volatile LAS unsigned*)(lds + 131072 + 352);
    if (tid < 2) bst[tid] = 0u;
    __syncthreads();
    XcdBarrier bar = xcd_barrier_post((unsigned*)ws + 4096, bst);
    if (hi > 1000) grid.sync();
#define IN(k) (lo <= (k) && (k) < hi)
#define SEAM(k) do { if (IN(k) && IN((k) + 1)) xcd_barrier(bar); } while (0)

    if (IN(0)) {
        LAS float* scr = (LAS float*)(lds + wave * 16384);
        const int gw = vcu * NWAVES + wave, NGW = G * NWAVES;
        constexpr int I_IN = (DM / 64) * (NIN / 32), I_UP = (AW / 64) * (DM / 32), I_O = (DM / 64) * (DM / 32);
        constexpr int NITEMS = I_IN + 2 * I_UP + I_O;
        for (int it = gw; it < NITEMS; it += NGW) {
            int r = it;
            if (r < I_IN) { p0_transpose_item<true>(args.in[3], DM, NIN, WinT, scr, r, lane); continue; } r -= I_IN;
            if (r < I_UP) { p0_transpose_item<false>(args.in[14], AW, DM, WuaT, scr, r, lane); continue; } r -= I_UP;
            if (r < I_UP) { p0_transpose_item<false>(args.in[15], BW, DM, WubT, scr, r, lane); continue; } r -= I_UP;
            p0_transpose_item<false>(args.in[16], DM, DM, WoT, scr, r, lane);
        }
        for (int m = gw; m < M1; m += 2 * NGW) {
            const int m2 = m + NGW; const bool has2 = (m2 < M1);
            const float* s0 = (m < MTOK) ? args.in[0] + (size_t)m * DM : ((m < MTOK + 16) ? args.in[1] + (size_t)(m - MTOK) * DM : nullptr);
            const float* s1 = !has2 ? nullptr : (m2 < MTOK) ? args.in[0] + (size_t)m2 * DM : ((m2 < MTOK + 16) ? args.in[1] + (size_t)(m2 - MTOK) * DM : nullptr);
            rms_rows2_to_bf16(s0, s1, args.in[2], XN + (size_t)m * DM, has2 ? XN + (size_t)m2 * DM : nullptr, lane);
        }
    }
    SEAM(0);
    const int p1_full = pg8::InOrder::NUNITS / G;
    const bool p1_split = (p1_full * G >= pg8::InOrder::NNG + pg8::InOrder::NMETA) && (pg8::InOrder::NUNITS % G != 0);
    if (IN(1)) {
        pg8::Gemm g{XN, WinT, M1, NIN, DM}; pg8::InOrder S{G, bx, 0, p1_split ? p1_full * G : pg8::InOrder::NUNITS};
        EpiIn E{Pb, Gt, args.in[4], args.in[5], args.in[7], args.in[8]};
        pg8::gemm_phase<EpiIn, pg8::InOrder, PG8_ALIGN, PG8_SP2>(lds, g, S, E);
    }
    SEAM(1);
    if (IN(2) && p1_split) {
        pg8::Gemm g{XN, WinT, M1, NIN, DM}; pg8::InOrder S{G, bx, p1_full, pg8::InOrder::NUNITS};
        EpiIn E{Pb, Gt, args.in[4], args.in[5], args.in[7], args.in[8]};
        pg8::gemm_phase<EpiIn, pg8::InOrder, PG8_ALIGN, PG8_SP2>(lds, g, S, E);
    }
    if (IN(2)) {
#define SCAL(x) __builtin_bit_cast(float, __builtin_amdgcn_readfirstlane(__builtin_bit_cast(int, (x))))
        const float knB = wave_max(fabsf(args.in[8][lane])), qnB = wave_max(fabsf(args.in[7][lane]));
        const float kmaxB = SCAL(8.0f * 1.02f * knB);
        const float kmaxA = SCAL(8.0f * 1.02f * wave_max(fabsf(args.in[5][lane])));
        const float lam = SCAL(__expf(wave_sum(args.in[9][lane] * args.in[10][lane])) - __expf(wave_sum(args.in[11][lane] * args.in[12][lane])) + LAM_INIT);
        const float mmaxB = SCAL(qnB * LOG2E * 1.02f * kmaxB);
        LAS int* incl = (LAS int*)(lds + TAB_OFF); LAS int* sincl = incl + 512; LAS int* order = sincl + 512; LAS int* keys = order + 512; LAS int* misc = keys + 512;
        int C = 1 << 20, myn, mync;
        { int ub, uh, uqb; unit_decode(tid, ub, uh, uqb); myn = 2 * uqb + 2 - b_tmin(uqb, b_window(uh, mmaxB)); }
        {
#pragma unroll 1
            for (int ci = 0; ci < 7; ++ci) {
                const int cd = ci < 4 ? 44 + 4 * ci : (ci == 4 ? 64 : (ci == 5 ? 88 : 176));
                const int nc_ = (myn + cd - 1) / cd;
                int v = nc_ > 1 ? nc_ : 0;
#pragma unroll
                for (int o_ = 1; o_ < 64; o_ <<= 1) v += __shfl_xor(v, o_);
                if (lane == 0) misc[8 + wave] = v;
                __syncthreads();
                int tot = 0;
#pragma unroll
                for (int k = 0; k < 8; ++k) tot += misc[8 + k];
                __syncthreads();
                if (tot <= SLOT_MAX) { C = cd; break; }
            }
        }
        {
            mync = (myn + C - 1) / C;
            const int myper = (myn + mync - 1) / mync, mykey = myper * 512 + (511 - tid);
            keys[tid] = mykey;
            __syncthreads();
            int rank = 0;
            for (int k = 0; k < 128; ++k) { const u32x4 kv = ((const LAS u32x4*)keys)[k]; rank += ((int)kv.x > mykey ? 1 : 0) + ((int)kv.y > mykey ? 1 : 0) + ((int)kv.z > mykey ? 1 : 0) + ((int)kv.w > mykey ? 1 : 0); }
            order[rank] = tid; incl[rank] = mync; sincl[rank] = mync > 1 ? mync : 0;
            __syncthreads();
            for (int d = 1; d < 512; d <<= 1) { const int a = tid >= d ? incl[tid - d] : 0, c = tid >= d ? sincl[tid - d] : 0; __syncthreads(); incl[tid] += a; sincl[tid] += c; __syncthreads(); }
        }
        const int NI = incl[511];
        unsigned* qctr = (unsigned*)ws + CW_QUEUE;
        for (;;) {
            if (tid == 0) misc[0] = (int)__hip_atomic_fetch_add(qctr, 1u, __ATOMIC_RELAXED, __HIP_MEMORY_SCOPE_AGENT);
            __syncthreads();
            const int it = misc[0];
            __syncthreads();
            if (it >= NI + 256) break;
            if (it < NI) {
                int lo_ = 0, hi_ = 511;
                while (lo_ < hi_) { const int mid = (lo_ + hi_) >> 1; if (incl[mid] > it) hi_ = mid; else lo_ = mid + 1; }
                const int p = lo_, jn = incl[p] - (p ? incl[p - 1] : 0), c = it - (incl[p] - jn);
                int ub, uh, uqb; unit_decode(order[p], ub, uh, uqb);
                const int tmin = b_tmin(uqb, b_window(uh, mmaxB)), n = 2 * uqb + 2 - tmin, per = (n + jn - 1) / jn;
                const int t0 = tmin + c * per, t1 = min(t0 + per - 1, 2 * uqb + 1);
                f32x16 o[4]; float lsum;
                attn_b_core(Pb, kmaxB, ub, uh, uqb, t0, t1, lds, o, lsum);
                if (jn == 1) attn_b_finalize(Pb, YB, args.in[13], lam, ub, uh, uqb, lds, o, lsum);
                else b_store_partial(ws, sincl[p] - jn + c, o, lsum);
            } else {
                const int au = it - NI, bk = au >> 6;
                attn_a_unit(Pb, YA, args.in[6], kmaxA, bk >> 1, bk & 1, 1 + (au & 63), lds);
            }
        }
        if (sincl[511] > 0) {
            xcd_barrier(bar);
            for (int p = bx; p < 512; p += G) {
                const int jn = incl[p] - (p ? incl[p - 1] : 0);
                if (jn > 1) { int ub, uh, uqb; unit_decode(order[p], ub, uh, uqb);
                    f32x16 o[4]; float lsum;
                    b_load_partials(ws, sincl[p] - jn, jn, o, lsum);
                    attn_b_finalize(Pb, YB, args.in[13], lam, ub, uh, uqb, lds, o, lsum); }
            }
        }
    }
    SEAM(2);
    if (IN(3)) {
        pg8::Gemm g{YA, WuaT, MTOK, DM, AW, YB, WubT}; pg8::StaticOrder2 S; S.init(MTOK, DM, G, bx); EpiUp E{Gt, MIX};
        pg8::gemm_phase<EpiUp, pg8::StaticOrder2, PG8_ALIGN, PG8_SP2>(lds, g, S, E);
    }
    SEAM(3);
    if (IN(4)) {
        pg8::Gemm g{MIX, WoT, MTOK, DM, DM}; pg8::StaticOrder S; S.init(MTOK, DM, G, bx); EpiOut E{args.in[0], args.out};
        pg8::gemm_phase<EpiOut, pg8::StaticOrder, PG8_ALIGN, PG8_SP2>(lds, g, S, E);
    }
#undef IN
#undef SEAM
}

extern "C" void kernel_launch(void* const* d_in, const int* in_sizes, int n_in, void* d_out, int out_size, void* d_ws, size_t ws_size, hipStream_t stream) {
    static int grid = 0;
    if (grid == 0) {
        if (n_in != 17 || ws_size < WS_END) { fprintf(stderr, "kernel_launch: unexpected inputs (n_in %d, ws %zu)\n", n_in, ws_size); grid = -1; return; }
        int dev = 0, cus = 0, per_cu = 0;
        hipGetDevice(&dev); hipDeviceGetAttribute(&cus, hipDeviceAttributeMultiprocessorCount, dev);
        if (hipFuncSetAttribute((const void*)hybrid_fwd, hipFuncAttributeMaxDynamicSharedMemorySize, LDS_BYTES) != hipSuccess) { fprintf(stderr, "kernel_launch: hipFuncSetAttribute failed\n"); grid = -1; return; }
        if (hipOccupancyMaxActiveBlocksPerMultiprocessor(&per_cu, (const void*)hybrid_fwd, NWAVES * 64, LDS_BYTES) != hipSuccess || per_cu < 1) { fprintf(stderr, "kernel_launch: occupancy query says %d\n", per_cu); per_cu = 1; }
        (void)hipGetLastError();
        grid = cus * 1;
        if (grid <= 0) grid = 256;
    }
    if (grid < 0) return;
    if (hipMemsetAsync((char*)d_ws + 16384, 0, 20480, stream) != hipSuccess)     { fprintf(stderr, "kernel_launch: memset failed\n"); return; }
    Args a{};
    for (int i = 0; i < 17; ++i) a.in[i] = (const float*)d_in[i];
    a.out = (float*)d_out; a.ws = (unsigned char*)d_ws;
#if MK_SPLIT
    for (int p = 0; p < 5; ++p) { a.ph_lo = p; a.ph_hi = p + 1; void* kargs[] = {&a};
        hipError_t e = hipLaunchCooperativeKernel((const void*)hybrid_fwd, dim3(grid), dim3(NWAVES * 64), kargs, LDS_BYTES, stream);
        if (e != hipSuccess) fprintf(stderr, "kernel_launch: launch %d failed: %s\n", p, hipGetErrorString(e)); }
#else
    a.ph_lo = 0; a.ph_hi = 5; void* kargs[] = {&a};
    hipError_t e = hipLaunchCooperativeKernel((const void*)hybrid_fwd, dim3(grid), dim3(NWAVES * 64), kargs, LDS_BYTES, stream);
    if (e != hipSuccess) fprintf(stderr, "kernel_launch: cooperative launch failed: %s (grid %d)\n", hipGetErrorString(e), grid);
#endif
}
```
